# Optimizing an MI355X kernel written in HIP

```python
import jax
import jax.numpy as jnp
from jax import lax
import numpy as np

D_MODEL = 1024
BATCH = 8
SEQ = 4096
DEPTH = 4

N_MIXERS = 4
N_RET = (DEPTH + 3) // N_MIXERS
N_GLA = (DEPTH + 2) // N_MIXERS
N_LRU = (DEPTH + 1) // N_MIXERS
N_NSA = DEPTH // N_MIXERS
D_FF = 4 * D_MODEL
NORM_EPS = 1e-6
NEG_INF = -1e30

RET_HEADS = 4
RET_DK = D_MODEL // RET_HEADS
RET_DV = 2 * RET_DK
RET_CHUNK = 128
RET_IN = 2 * RET_HEADS * RET_DK + 2 * RET_HEADS * RET_DV

GLA_HEADS = 4
GLA_DK = D_MODEL // (2 * GLA_HEADS)
GLA_DV = D_MODEL // GLA_HEADS
GLA_RANK = 16
GLA_TAU = 16.0
GLA_CHUNK = 64
GLA_IN = 2 * GLA_HEADS * GLA_DK + 2 * GLA_HEADS * GLA_DV + GLA_RANK

LRU_WIDTH = D_MODEL
LRU_BLOCKS = 8
LRU_BS = LRU_WIDTH // LRU_BLOCKS
CONV_W = 4
LRU_C = 8.0

NSA_HEADS = 16
NSA_GROUPS = 2
NSA_HPG = NSA_HEADS // NSA_GROUPS
NSA_DK = 64
NSA_DV = 64
CMP_L = 32
CMP_STRIDE = 16
CMP_HID = 2 * NSA_DK
SLC_L = 64
SLC_TOP = 16
WIN = 512
NSA_QBLK = 64
FORCE_SCORE = 1e6
NSA_IN = NSA_HEADS * NSA_DK + 3 * NSA_GROUPS * (NSA_DK + NSA_DV) + 3 * NSA_HEADS

kernel_name = 'hybrid_ret_gla_rglru_nsa_trunk'


def rmsnorm(x, g):
    xf = x.astype(jnp.float32)
    y = xf * lax.rsqrt(jnp.mean(xf * xf, axis=-1, keepdims=True) + NORM_EPS)
    return (y * g.astype(jnp.float32)).astype(x.dtype)


def head_norm(o, g, center):
    of = o.astype(jnp.float32)
    if center:
        of = of - jnp.mean(of, axis=-1, keepdims=True)
    y = of * lax.rsqrt(jnp.mean(of * of, axis=-1, keepdims=True) + NORM_EPS)
    return y.reshape(*o.shape[:-2], -1) * g.astype(jnp.float32)


def masked_softmax(s, mask):
    s = jnp.where(mask, s.astype(jnp.float32), NEG_INF)
    m = jnp.max(s, axis=-1, keepdims=True)
    e = jnp.where(mask, jnp.exp(s - m), 0.0)
    return e / jnp.maximum(jnp.sum(e, axis=-1, keepdims=True), 1e-30)


def retention(h, w_in, gn, w_out):
    B, S, _ = h.shape
    H, DK, DV, C = RET_HEADS, RET_DK, RET_DV, RET_CHUNK
    n = S // C
    q, k, v, g = jnp.split(h @ w_in, [H * DK, 2 * H * DK, 2 * H * DK + H * DV], axis=-1)

    def to_chunks(t, d):
        return t.astype(jnp.float32).reshape(B, n, C, H, d).transpose(1, 0, 3, 2, 4)

    q = to_chunks(q, DK)
    k = to_chunks(k, DK) * DK ** -0.5
    v = to_chunks(v, DV)
    log_gamma = jnp.log1p(-jnp.exp2(-5.0 - jnp.arange(H, dtype=jnp.float32)))
    pos = jnp.arange(C, dtype=jnp.float32)
    diff = pos[:, None] - pos[None, :]
    decay_intra = jnp.where(diff >= 0, jnp.exp(log_gamma[:, None, None] * jnp.maximum(diff, 0.0)), 0.0)
    decay_q = jnp.exp(log_gamma[:, None] * (pos + 1.0))[None, :, :, None]
    decay_k = jnp.exp(log_gamma[:, None] * (C - 1.0 - pos))[None, :, :, None]
    decay_chunk = jnp.exp(log_gamma * C)[None, :, None, None]

    def step(state, inp):
        qc, kc, vc = inp
        scores = jnp.einsum('bhid,bhjd->bhij', qc, kc) * decay_intra
        o = jnp.einsum('bhij,bhje->bhie', scores, vc) + jnp.einsum('bhid,bhde->bhie', qc, state) * decay_q
        state = state * decay_chunk + jnp.einsum('bhjd,bhje->bhde', kc * decay_k, vc)
        return state, o

    _, o = lax.scan(step, jnp.zeros((B, H, DK, DV), jnp.float32), (q, k, v))
    o = o.transpose(1, 0, 3, 2, 4).reshape(B, S, H, DV)
    o = head_norm(o, gn, True) * jax.nn.silu(g.astype(jnp.float32))
    return (o @ w_out).astype(h.dtype)


def gla(h, w_in, w_gate_up, b_gate, gn, w_out):
    B, S, _ = h.shape
    H, DK, DV, C = GLA_HEADS, GLA_DK, GLA_DV, GLA_CHUNK
    n = S // C
    cuts = np.cumsum([H * DK, H * DK, H * DV, H * DV]).tolist()
    q, k, v, r, gl = jnp.split(h @ w_in, cuts, axis=-1)
    log_alpha = jax.nn.log_sigmoid((gl @ w_gate_up + b_gate).astype(jnp.float32)) / GLA_TAU

    def to_chunks(t, d):
        return t.astype(jnp.float32).reshape(B, n, C, H, d).transpose(1, 0, 3, 2, 4)

    q = to_chunks(q, DK) * DK ** -0.5
    k = to_chunks(k, DK)
    v = to_chunks(v, DV)
    la = to_chunks(log_alpha, DK)
    causal = jnp.tril(jnp.ones((C, C), dtype=bool))[:, :, None]

    def step(state, inp):
        qc, kc, vc, lac = inp
        b = jnp.cumsum(lac, axis=2)
        rel = jnp.where(causal, b[:, :, :, None, :] - b[:, :, None, :, :], -jnp.inf)
        A = jnp.einsum('bhid,bhjd,bhijd->bhij', qc, kc, jnp.exp(rel))
        b_last = b[:, :, -1:, :]
        o = jnp.einsum('bhij,bhje->bhie', A, vc) + jnp.einsum('bhid,bhde->bhie', qc * jnp.exp(b), state)
        state = state * jnp.exp(b_last)[:, :, 0, :, None] + jnp.einsum('bhjd,bhje->bhde', kc * jnp.exp(b_last - b), vc)
        return state, o

    _, o = lax.scan(step, jnp.zeros((B, H, DK, DV), jnp.float32), (q, k, v, la))
    o = o.transpose(1, 0, 3, 2, 4).reshape(B, S, H, DV)
    o = head_norm(o, gn, False) * jax.nn.silu(r.astype(jnp.float32))
    return (o @ w_out).astype(h.dtype)


def rglru_block(h, w_in, conv_w, conv_b, w_a, b_a, w_x, b_x, lam, w_out):
    B, S, _ = h.shape
    xb, yb = jnp.split(h @ w_in, 2, axis=-1)
    y = jax.nn.gelu(yb.astype(jnp.float32))
    xp = jnp.pad(xb, ((0, 0), (CONV_W - 1, 0), (0, 0)))
    xc = conv_b
    for tap in range(CONV_W):
        xc = xc + xp[:, tap:tap + S] * conv_w[tap]
    xr = xc.reshape(B, S, LRU_BLOCKS, LRU_BS)
    gate_r = jax.nn.sigmoid(jnp.einsum('bsnc,ncd->bsnd', xr, w_a).reshape(B, S, LRU_WIDTH) + b_a).astype(jnp.float32)
    gate_i = jax.nn.sigmoid(jnp.einsum('bsnc,ncd->bsnd', xr, w_x).reshape(B, S, LRU_WIDTH) + b_x).astype(jnp.float32)
    log_a = -LRU_C * gate_r * jax.nn.softplus(-lam.astype(jnp.float32))
    a = jnp.exp(log_a)
    u = jnp.sqrt(-jnp.expm1(2.0 * log_a)) * gate_i * xc.astype(jnp.float32)

    def combine(left, right):
        a1, b1 = left
        a2, b2 = right
        return a1 * a2, a2 * b1 + b2

    _, hs = lax.associative_scan(combine, (a, u), axis=1)
    return ((hs * y) @ w_out).astype(h.dtype)


def nsa(h, w_in, pe_k, w1_k, w2_k, pe_v, w1_v, w2_v, w_out):
    B, S, _ = h.shape
    H, G, HPG, DK, DV, QB = NSA_HEADS, NSA_GROUPS, NSA_HPG, NSA_DK, NSA_DV, NSA_QBLK
    sizes = [H * DK] + [G * DK, G * DV] * 3 + [3 * H]
    cuts = np.cumsum(sizes)[:-1].tolist()
    q, kc, vc, ks, vs, kw, vw, gl = jnp.split(h @ w_in, cuts, axis=-1)
    q = q.reshape(B, S, G, HPG, DK).transpose(0, 2, 3, 1, 4)
    gates = jax.nn.sigmoid(gl.astype(jnp.float32)).reshape(B, S, 3, G, HPG).transpose(0, 3, 4, 1, 2)

    def heads(t, d):
        return t.reshape(B, S, G, d).transpose(0, 2, 1, 3)

    n_cmp = (S - CMP_L) // CMP_STRIDE + 1
    cmp_start = jnp.arange(n_cmp) * CMP_STRIDE
    tok_idx = cmp_start[:, None] + jnp.arange(CMP_L)[None, :]

    def compress(t, pe, w1, w2, d):
        blocks = heads(t, d)[:, :, tok_idx] + pe
        return jax.nn.gelu(blocks.reshape(B, G, n_cmp, CMP_L * d) @ w1) @ w2

    k_cmp = compress(kc, pe_k, w1_k, w2_k, DK)
    v_cmp = compress(vc, pe_v, w1_v, w2_v, DV)
    cmp_end = cmp_start + CMP_L - 1

    n_slc = S // SLC_L
    k_slc = heads(ks, DK).reshape(B, G, n_slc, SLC_L, DK)
    v_slc = heads(vs, DV).reshape(B, G, n_slc, SLC_L, DV)
    slc_start = jnp.arange(n_slc) * SLC_L
    overlap = ((cmp_start[:, None] < slc_start[None, :] + SLC_L)
               & (cmp_start[:, None] + CMP_L > slc_start[None, :])).astype(jnp.float32)
    n_top = min(SLC_TOP, n_slc)
    blk_ids = jnp.arange(n_slc)

    k_win = jnp.pad(heads(kw, DK), ((0, 0), (0, 0), (WIN, 0), (0, 0)))
    v_win = jnp.pad(heads(vw, DV), ((0, 0), (0, 0), (WIN, 0), (0, 0)))

    slopes = jnp.exp2(-8.0 * (jnp.arange(H, dtype=jnp.float32) + 1.0) / H).reshape(1, G, HPG, 1, 1)
    scale = DK ** -0.5
    bi = jnp.arange(B)[:, None, None, None]
    gi = jnp.arange(G)[None, :, None, None]

    def block(i):
        q0 = i * QB
        qb = lax.dynamic_slice_in_dim(q, q0, QB, axis=3)
        t = q0 + jnp.arange(QB)
        dist_c = (t[:, None] - cmp_end[None, :]).astype(jnp.float32)
        s_c = jnp.einsum('bghqd,bgnd->bghqn', qb, k_cmp) * scale - slopes * dist_c
        p_c = masked_softmax(s_c, cmp_end[None, :] <= t[:, None])
        o_c = jnp.einsum('bghqn,bgnd->bghqd', p_c, v_cmp)
        imp = jnp.einsum('bghqn,nj->bgqj', p_c, overlap)
        cur = t // SLC_L
        forced = (blk_ids[None, :] == 0) | (blk_ids[None, :] == cur[:, None]) | (blk_ids[None, :] == cur[:, None] - 1)
        imp = jnp.where(forced, FORCE_SCORE, imp)
        imp = jnp.where(blk_ids[None, :] <= cur[:, None], imp, -1.0)
        _, idx = lax.top_k(imp, n_top)
        kg = k_slc[bi, gi, idx]
        vg = v_slc[bi, gi, idx].reshape(B, G, QB, n_top * SLC_L, DV)
        pos = idx[..., None] * SLC_L + jnp.arange(SLC_L)
        dist_s = (t[:, None, None] - pos).astype(jnp.float32)[:, :, None]
        s_s = jnp.einsum('bghqd,bgqkld->bghqkl', qb, kg) * scale - slopes[..., None] * dist_s
        m_s = (pos <= t[:, None, None]).reshape(B, G, QB, n_top * SLC_L)[:, :, None]
        p_s = masked_softmax(s_s.reshape(B, G, HPG, QB, n_top * SLC_L), m_s)
        o_s = jnp.einsum('bghqm,bgqmd->bghqd', p_s, vg)
        kwb = lax.dynamic_slice_in_dim(k_win, q0, WIN + QB, axis=2)
        vwb = lax.dynamic_slice_in_dim(v_win, q0, WIN + QB, axis=2)
        spos = q0 - WIN + jnp.arange(WIN + QB)
        dist_w = t[:, None] - spos[None, :]
        m_w = (spos[None, :] >= 0) & (dist_w >= 0) & (dist_w < WIN)
        s_w = jnp.einsum('bghqd,bgsd->bghqs', qb, kwb) * scale - slopes * dist_w.astype(jnp.float32)
        p_w = masked_softmax(s_w, m_w)
        o_w = jnp.einsum('bghqs,bgsd->bghqd', p_w, vwb)
        gb = lax.dynamic_slice_in_dim(gates, q0, QB, axis=3)
        return gb[..., 0:1] * o_c + gb[..., 1:2] * o_s + gb[..., 2:3] * o_w

    o = lax.map(block, jnp.arange(S // QB))
    o = o.transpose(1, 0, 4, 2, 3, 5).reshape(B, S, H * DV)
    return (o @ w_out).astype(h.dtype)


def setup_inputs(seed: int = 0) -> dict:
    key = jax.random.key(seed)
    ks = iter(jax.random.split(key, 40))

    def w(shape, fan_in):
        return jax.random.normal(next(ks), shape, jnp.float32) * fan_in ** -0.5

    def gain(shape):
        return 1.0 + 0.02 * jax.random.normal(next(ks), shape, jnp.float32)

    def small(shape, s):
        return s * jax.random.normal(next(ks), shape, jnp.float32)

    x = jax.random.normal(next(ks), (BATCH, SEQ, D_MODEL), jnp.float32)
    u = jax.random.uniform(next(ks), (N_LRU, LRU_WIDTH), jnp.float32, 0.9, 0.999)
    a_base = u ** (1.0 / LRU_C)
    lru_lambda = jnp.log(a_base) - jnp.log1p(-a_base)
    return {
        'x': x,
        'norm_mix_pre': gain((DEPTH, D_MODEL)),
        'norm_mix_post': gain((DEPTH, D_MODEL)),
        'norm_mlp_pre': gain((DEPTH, D_MODEL)),
        'norm_mlp_post': gain((DEPTH, D_MODEL)),
        'mlp_w_up': w((DEPTH, D_MODEL, D_FF), D_MODEL),
        'mlp_w_down': w((DEPTH, D_FF, D_MODEL), D_FF),
        'ret_w_in': w((N_RET, D_MODEL, RET_IN), D_MODEL),
        'ret_gn': gain((N_RET, RET_HEADS * RET_DV)),
        'ret_w_out': w((N_RET, RET_HEADS * RET_DV, D_MODEL), RET_HEADS * RET_DV),
        'gla_w_in': w((N_GLA, D_MODEL, GLA_IN), D_MODEL),
        'gla_w_gate_up': w((N_GLA, GLA_RANK, GLA_HEADS * GLA_DK), GLA_RANK),
        'gla_b_gate': small((N_GLA, GLA_HEADS * GLA_DK), 0.5),
        'gla_gn': gain((N_GLA, GLA_HEADS * GLA_DV)),
        'gla_w_out': w((N_GLA, GLA_HEADS * GLA_DV, D_MODEL), GLA_HEADS * GLA_DV),
        'lru_w_in': w((N_LRU, D_MODEL, 2 * LRU_WIDTH), D_MODEL),
        'lru_conv_w': w((N_LRU, CONV_W, LRU_WIDTH), CONV_W),
        'lru_conv_b': small((N_LRU, LRU_WIDTH), 0.01),
        'lru_w_a': w((N_LRU, LRU_BLOCKS, LRU_BS, LRU_BS), LRU_BS),
        'lru_b_a': small((N_LRU, LRU_WIDTH), 0.01),
        'lru_w_x': w((N_LRU, LRU_BLOCKS, LRU_BS, LRU_BS), LRU_BS),
        'lru_b_x': small((N_LRU, LRU_WIDTH), 0.01),
        'lru_lambda': lru_lambda,
        'lru_w_out': w((N_LRU, LRU_WIDTH, D_MODEL), LRU_WIDTH),
        'nsa_w_in': w((N_NSA, D_MODEL, NSA_IN), D_MODEL),
        'nsa_pe_k': small((N_NSA, CMP_L, NSA_DK), 0.1),
        'nsa_w1_k': w((N_NSA, CMP_L * NSA_DK, CMP_HID), CMP_L * NSA_DK),
        'nsa_w2_k': w((N_NSA, CMP_HID, NSA_DK), CMP_HID),
        'nsa_pe_v': small((N_NSA, CMP_L, NSA_DV), 0.1),
        'nsa_w1_v': w((N_NSA, CMP_L * NSA_DV, CMP_HID), CMP_L * NSA_DV),
        'nsa_w2_v': w((N_NSA, CMP_HID, NSA_DV), CMP_HID),
        'nsa_w_out': w((N_NSA, NSA_HEADS * NSA_DV, D_MODEL), NSA_HEADS * NSA_DV),
    }


def reference(x, norm_mix_pre, norm_mix_post, norm_mlp_pre, norm_mlp_post, mlp_w_up, mlp_w_down,
              ret_w_in, ret_gn, ret_w_out,
              gla_w_in, gla_w_gate_up, gla_b_gate, gla_gn, gla_w_out,
              lru_w_in, lru_conv_w, lru_conv_b, lru_w_a, lru_b_a, lru_w_x, lru_b_x, lru_lambda, lru_w_out,
              nsa_w_in, nsa_pe_k, nsa_w1_k, nsa_w2_k, nsa_pe_v, nsa_w1_v, nsa_w2_v, nsa_w_out):
    for i in range(DEPTH):
        m, j = i % N_MIXERS, i // N_MIXERS
        h = rmsnorm(x, norm_mix_pre[i])
        if m == 0:
            h = retention(h, ret_w_in[j], ret_gn[j], ret_w_out[j])
        elif m == 1:
            h = gla(h, gla_w_in[j], gla_w_gate_up[j], gla_b_gate[j], gla_gn[j], gla_w_out[j])
        elif m == 2:
            h = rglru_block(h, lru_w_in[j], lru_conv_w[j], lru_conv_b[j], lru_w_a[j], lru_b_a[j],
                            lru_w_x[j], lru_b_x[j], lru_lambda[j], lru_w_out[j])
        else:
            h = nsa(h, nsa_w_in[j], nsa_pe_k[j], nsa_w1_k[j], nsa_w2_k[j],
                    nsa_pe_v[j], nsa_w1_v[j], nsa_w2_v[j], nsa_w_out[j])
        x = x + rmsnorm(h, norm_mix_post[i])
        h = rmsnorm(x, norm_mlp_pre[i])
        h = jnp.square(jax.nn.relu(h @ mlp_w_up[i])) @ mlp_w_down[i]
        x = x + rmsnorm(h, norm_mlp_post[i])
    return x
```

```cpp
#include <hip/hip_runtime.h>
#include <cstdio>
#include <cstdint>
#include <cmath>

namespace pg8 {
#define PG8_LAS __attribute__((address_space(3)))
typedef unsigned short bf16_t;
typedef short bf16x8 __attribute__((ext_vector_type(8)));
typedef float f32x4 __attribute__((ext_vector_type(4)));
typedef unsigned u32x4 __attribute__((ext_vector_type(4)));
typedef unsigned u32x2 __attribute__((ext_vector_type(2)));
constexpr int BM = 256, BK = 64, HALF = 128, HTB = HALF * BK * 2  , STAGE_BYTES = 8 * HTB, NXCD = 8, WGM = 8;

__host__ __device__ __forceinline__ int lds_byte(int r, int c) { const int st = (r >> 4) * 2 + (c >> 5), rr = r & 15, cc = c & 31, ob = rr * 64 + cc * 2; return st * 1024 + (ob ^ (((ob >> 9) & 1) << 5)); }
__host__ __device__ __forceinline__ void stage_rc(int b, int& R, int& C) { const int st = b / 1024, sb = b % 1024, swz = sb ^ (((sb >> 9) & 1) << 5); R = (st >> 1) * 16 + swz / 64; C = (st & 1) * 32 + (swz % 64) / 2; }
__host__ __device__ __forceinline__ int perm32(int rho) { const int n = rho >> 4, i = rho & 15; return 8 * (i >> 2) + 4 * n + (i & 3); }

struct Unit { int pm, pn; };
struct Gemm { const bf16_t* A; const bf16_t* Bt; int M, N, K, lda, ldb; size_t a_pn_step; };

struct StaticOrder {
    int nM, nN, nwg, G, c;
    __host__ __device__ void init(int M, int N, int G_, int c_) { nM = M / BM; nN = N / BM; nwg = nM * nN; G = G_; c = c_; }
    __host__ __device__ bool next(int i, Unit& u) const {
        const long L = (long)i * G + c; if (L >= nwg) return false;
        int wgid = (int)L; { const int q = nwg / NXCD, r = nwg % NXCD, xcd = wgid % NXCD, off = wgid / NXCD; wgid = (xcd < r ? xcd * (q + 1) : r * (q + 1) + (xcd - r) * q) + off; }
        const int nig = WGM * nN, gid = wgid / nig, fm = gid * WGM, gsz = (nM - fm) < WGM ? (nM - fm) : WGM;
        u.pm = fm + ((wgid % nig) % gsz); u.pn = (wgid % nig) / gsz; return true;
    }
    __device__ __forceinline__ void a_ready(const Unit&) const {}
    __device__ __forceinline__ void done(const Unit&) const {}
};

__device__ __forceinline__ unsigned cvt_pk_bf16(float lo, float hi) { unsigned r; asm volatile("v_cvt_pk_bf16_f32 %0, %1, %2" : "=v"(r) : "v"(lo), "v"(hi)); return r; }
__device__ __forceinline__ u32x4 pack8(const f32x4 v0, const f32x4 v1) { u32x4 w; w.x = cvt_pk_bf16(v0[0], v0[1]); w.y = cvt_pk_bf16(v0[2], v0[3]); w.z = cvt_pk_bf16(v1[0], v1[1]); w.w = cvt_pk_bf16(v1[2], v1[3]); return w; }
__device__ __forceinline__ float bf_lo(unsigned w) { return __uint_as_float(w << 16); }
__device__ __forceinline__ float bf_hi(unsigned w) { return __uint_as_float(w & 0xffff0000u); }

template <int ACT> struct EpiStore {
    static constexpr bool PERM = true, AFTER_DRAIN = false;
    bf16_t* O; int ldc;
    __device__ __forceinline__ void operator()(const f32x4 (&acc)[2][2][4][2], const Unit& u, int wr, int wc, int fr, int fq) const {
        const int row0 = u.pm * BM + wr * 64 + fr, col0 = u.pn * BM + wc * 32 + 8 * fq;
#pragma unroll
        for (int ai = 0; ai < 2; ++ai)
#pragma unroll
            for (int m = 0; m < 4; ++m) { bf16_t* rowp = O + (size_t)(row0 + ai * HALF + m * 16) * ldc + col0;
#pragma unroll
                for (int bj = 0; bj < 2; ++bj) { f32x4 v0 = acc[ai][bj][m][0], v1 = acc[ai][bj][m][1];
                    if (ACT == 1) {
#pragma unroll
                        for (int e = 0; e < 4; ++e) { const float a = fmaxf(v0[e], 0.f), b = fmaxf(v1[e], 0.f); v0[e] = a * a; v1[e] = b * b; } }
                    *(u32x4*)(rowp + bj * HALF) = pack8(v0, v1); } }
    }
};

struct EpiGla {
    static constexpr bool PERM = true, AFTER_DRAIN = false;
    bf16_t* O; int ldc; const float* bgate;
    __device__ __forceinline__ void operator()(const f32x4 (&acc)[2][2][4][2], const Unit& u, int wr, int wc, int fr, int fq) const {
        const int row0 = u.pm * BM + wr * 64 + fr, col0 = u.pn * BM + wc * 32 + 8 * fq;
        const bool gate = u.pn >= 12;
        f32x4 bv[2][2];
#pragma unroll
        for (int bj = 0; bj < 2; ++bj)
#pragma unroll
            for (int n = 0; n < 2; ++n) bv[bj][n] = gate ? *(const f32x4*)(bgate + (col0 - 3072) + bj * HALF + 4 * n) : (f32x4){0.f, 0.f, 0.f, 0.f};
#pragma unroll
        for (int ai = 0; ai < 2; ++ai)
#pragma unroll
            for (int m = 0; m < 4; ++m) { bf16_t* rowp = O + (size_t)(row0 + ai * HALF + m * 16) * ldc + col0;
#pragma unroll
                for (int bj = 0; bj < 2; ++bj) { f32x4 v0 = acc[ai][bj][m][0], v1 = acc[ai][bj][m][1];
                    if (gate) {
#pragma unroll
                        for (int e = 0; e < 4; ++e) {
                            const float z0 = v0[e] + bv[bj][0][e], z1 = v1[e] + bv[bj][1][e];
                            v0[e] = (fminf(z0, 0.f) - log1pf(__expf(-fabsf(z0)))) * 0.0625f;
                            v1[e] = (fminf(z1, 0.f) - log1pf(__expf(-fabsf(z1)))) * 0.0625f; } }
                    *(u32x4*)(rowp + bj * HALF) = pack8(v0, v1); } }
    }
};

struct EpiNsa {
    static constexpr bool PERM = true, AFTER_DRAIN = false;
    bf16_t* Q; bf16_t* KC; bf16_t* VC; bf16_t* KS; bf16_t* VST; bf16_t* KW; bf16_t* VWT; float* GATES;
    template <bool VTRANS> __device__ __forceinline__ void kv_store(const f32x4 (&acc)[2][2][4][2], bf16_t* Kt, bf16_t* Vt, int row0, int c8) const {
        const int g = c8 >> 6, d = c8 & 63;
#pragma unroll
        for (int ai = 0; ai < 2; ++ai)
#pragma unroll
            for (int m = 0; m < 4; ++m) {
                const int row = row0 + ai * HALF + m * 16, b = row >> 12, t = row & 4095;
                const size_t bg = (size_t)(b * 2 + g);
                *(u32x4*)(Kt + (bg * 4096 + t) * 64 + d) = pack8(acc[ai][0][m][0], acc[ai][0][m][1]);
                const u32x4 w = pack8(acc[ai][1][m][0], acc[ai][1][m][1]);
                if (!VTRANS) *(u32x4*)(Vt + (bg * 4096 + t) * 64 + d) = w;
                else {
                    bf16_t* vp = Vt + (bg * 64 + d) * 4096 + t;
                    vp[0 * 4096] = (bf16_t)(w.x & 0xffffu); vp[1 * 4096] = (bf16_t)(w.x >> 16);
                    vp[2 * 4096] = (bf16_t)(w.y & 0xffffu); vp[3 * 4096] = (bf16_t)(w.y >> 16);
                    vp[4 * 4096] = (bf16_t)(w.z & 0xffffu); vp[5 * 4096] = (bf16_t)(w.z >> 16);
                    vp[6 * 4096] = (bf16_t)(w.w & 0xffffu); vp[7 * 4096] = (bf16_t)(w.w >> 16);
                }
            }
    }
    __device__ __forceinline__ void operator()(const f32x4 (&acc)[2][2][4][2], const Unit& u, int wr, int wc, int fr, int fq) const {
        const int row0 = u.pm * BM + wr * 64 + fr, c8 = wc * 32 + 8 * fq;
        if (u.pn < 4) {
#pragma unroll
            for (int ai = 0; ai < 2; ++ai)
#pragma unroll
                for (int m = 0; m < 4; ++m) { bf16_t* rowp = Q + (size_t)(row0 + ai * HALF + m * 16) * 1024 + u.pn * BM + c8;
#pragma unroll
                    for (int bj = 0; bj < 2; ++bj) *(u32x4*)(rowp + bj * HALF) = pack8(acc[ai][bj][m][0], acc[ai][bj][m][1]); }
        } else if (u.pn == 4) { kv_store<false>(acc, KC, VC, row0, c8);
        } else if (u.pn == 5) { kv_store<true>(acc, KS, VST, row0, c8);
        } else if (u.pn == 6) { kv_store<true>(acc, KW, VWT, row0, c8);
        } else {
            if (c8 < 48) {
#pragma unroll
                for (int ai = 0; ai < 2; ++ai)
#pragma unroll
                    for (int m = 0; m < 4; ++m) { float* gp = GATES + (size_t)(row0 + ai * HALF + m * 16) * 48 + c8;
                        f32x4 v0 = acc[ai][0][m][0], v1 = acc[ai][0][m][1];
#pragma unroll
                        for (int e = 0; e < 4; ++e) { v0[e] = 1.f / (1.f + __expf(-v0[e])); v1[e] = 1.f / (1.f + __expf(-v1[e])); }
                        *(f32x4*)gp = v0; *(f32x4*)(gp + 4) = v1; }
            }
        }
    }
};

template <class Epi, class Sched, bool ALIGN_EPI = false, bool SP2 = false>
__device__ __forceinline__ void gemm_phase(PG8_LAS unsigned char* lds, const Gemm g, const Sched& S, const Epi& E) {
    const int tid = threadIdx.x, wid = __builtin_amdgcn_readfirstlane(tid >> 6), lane = tid & 63, wr = wid >> 2, wc = wid & 3, fr = lane & 15, fq = lane >> 4;
    const int K = g.K, nt = K / BK;
    unsigned voffA[2], voffB[2];
#pragma unroll
    for (int i = 0; i < 2; ++i) { int R, C; stage_rc(tid * 16 + i * 8192, R, C); const int Rb = Epi::PERM ? ((R & ~31) + perm32(R & 31)) : R;
        voffA[i] = (unsigned)(R * g.lda + C) * 2u; voffB[i] = (unsigned)(Rb * g.ldb + C) * 2u; }
    const size_t kstep = (size_t)(BK * 2);
    const size_t hstepA = (size_t)HALF * g.lda * 2, hstepB = (size_t)HALF * g.ldb * 2;
    const size_t tstepA = 2 * hstepA, tstepB = 2 * hstepB;
    const unsigned ldsw = (unsigned)wid * 1024u;
    const int aoff = lds_byte(wr * 64 + fr, fq * 8), boff = lds_byte(wc * 32 + fr, fq * 8);
#define PG8_SA(b, h) (((b) * 2 + (h)) * HTB)
#define PG8_SB(b, h) ((4 + (b) * 2 + (h)) * HTB)
#define PG8_STAGE(bufoff, gbase, voff) do { _Pragma("unroll") for (int _i = 0; _i < 2; ++_i) \
        __builtin_amdgcn_global_load_lds((const unsigned*)((const char*)(gbase) + (voff)[_i]), (PG8_LAS unsigned*)(lds + (bufoff) + ldsw + _i * 8192), 16, 0, 0); } while (0)
#define PG8_LDA(dst, b, h) do { _Pragma("unroll") for (int m = 0; m < 4; ++m) _Pragma("unroll") for (int k = 0; k < 2; ++k) dst[m][k] = *(const PG8_LAS bf16x8*)(lds + PG8_SA(b, h) + aoff + m * 2048 + k * 1024); } while (0)
#define PG8_LDB(dst, b, h) do { _Pragma("unroll") for (int n = 0; n < 2; ++n) _Pragma("unroll") for (int k = 0; k < 2; ++k) dst[n][k] = *(const PG8_LAS bf16x8*)(lds + PG8_SB(b, h) + boff + n * 2048 + k * 1024); } while (0)
#define PG8_MMA(ai, bj, At, Bt) do { __builtin_amdgcn_s_setprio(1); _Pragma("unroll") for (int m = 0; m < 4; ++m) _Pragma("unroll") for (int n = 0; n < 2; ++n) _Pragma("unroll") for (int k = 0; k < 2; ++k) \
        acc[ai][bj][m][n] = __builtin_amdgcn_mfma_f32_16x16x32_bf16(Bt[n][k], At[m][k], acc[ai][bj][m][n], 0, 0, 0); __builtin_amdgcn_s_setprio(0); } while (0)
#define PG8_WAIT_V(n) asm volatile("s_waitcnt vmcnt(" #n ")" ::: "memory")
#define PG8_WAIT_L(n) asm volatile("s_waitcnt lgkmcnt(" #n ")" ::: "memory")
#define PG8_BAR __builtin_amdgcn_s_barrier()
#define PG8_SCHED __builtin_amdgcn_sched_barrier(0)
    Unit cur, nxt; int ui = 0;
    if (!S.next(0, cur)) return;
    f32x4 acc[2][2][4][2];
#pragma unroll
    for (int a = 0; a < 2; ++a)
#pragma unroll
        for (int b = 0; b < 2; ++b)
#pragma unroll
            for (int m = 0; m < 4; ++m)
#pragma unroll
                for (int n = 0; n < 2; ++n) acc[a][b][m][n] = (f32x4){0.f, 0.f, 0.f, 0.f};
    bf16x8 At[4][2], B0[2][2], B1[2][2];
    const char* cA = (const char*)g.A + (size_t)cur.pm * tstepA + (size_t)cur.pn * g.a_pn_step; const char* cB = (const char*)g.Bt + (size_t)cur.pn * tstepB;
    S.a_ready(cur);
    if constexpr (SP2) {
        PG8_STAGE(PG8_SB(0, 0), cB, voffB); PG8_STAGE(PG8_SB(0, 1), cB + hstepB, voffB); PG8_STAGE(PG8_SA(0, 0), cA, voffA); PG8_STAGE(PG8_SA(0, 1), cA + hstepA, voffA);
        if (wr == 1) PG8_BAR;
        PG8_WAIT_V(2); PG8_BAR;
        PG8_STAGE(PG8_SB(1, 0), cB + kstep, voffB); PG8_STAGE(PG8_SA(1, 0), cA + kstep, voffA); PG8_STAGE(PG8_SB(1, 1), cB + hstepB + kstep, voffB);
        PG8_WAIT_V(6); PG8_BAR;
    } else {
        PG8_STAGE(PG8_SB(0, 0), cB, voffB); PG8_STAGE(PG8_SA(0, 0), cA, voffA); PG8_STAGE(PG8_SB(0, 1), cB + hstepB, voffB); PG8_STAGE(PG8_SA(0, 1), cA + hstepA, voffA);
        if (wr == 1) PG8_BAR;
        PG8_WAIT_V(4); PG8_BAR;
        PG8_STAGE(PG8_SB(1, 0), cB + kstep, voffB); PG8_STAGE(PG8_SA(1, 0), cA + kstep, voffA); PG8_STAGE(PG8_SB(1, 1), cB + hstepB + kstep, voffB);
        PG8_WAIT_V(6); PG8_BAR;
    }
    for (;;) {
        const bool has_next = S.next(ui + 1, nxt);
        const char* nA = has_next ? (const char*)g.A + (size_t)nxt.pm * tstepA + (size_t)nxt.pn * g.a_pn_step : cA; const char* nB = has_next ? (const char*)g.Bt + (size_t)nxt.pn * tstepB : cB;
        for (int t = 0; t < nt; t += 2) {
            const bool last = (t == nt - 2);
            const char* a1 = cA + (size_t)(t + 1) * kstep;
            const char* a2 = last ? nA : cA + (size_t)(t + 2) * kstep; const char* b2 = last ? nB : cB + (size_t)(t + 2) * kstep;
            const char* a3 = a2 + kstep; const char* b3 = b2 + kstep;
            if (last && has_next) S.a_ready(nxt);
            if constexpr (SP2) {
            PG8_LDB(B0, 0, 0); PG8_LDB(B1, 0, 1); PG8_SCHED; PG8_LDA(At, 0, 0); PG8_STAGE(PG8_SA(1, 1), a1 + hstepA, voffA);
            PG8_WAIT_V(8); PG8_WAIT_L(0); PG8_BAR; PG8_MMA(0, 0, At, B0); PG8_MMA(0, 1, At, B1); PG8_BAR; PG8_SCHED;
            PG8_LDA(At, 0, 1); PG8_STAGE(PG8_SB(0, 0), b2, voffB); PG8_STAGE(PG8_SB(0, 1), b2 + hstepB, voffB); PG8_STAGE(PG8_SA(0, 0), a2, voffA);
            PG8_WAIT_V(8); PG8_WAIT_L(0); PG8_BAR; PG8_MMA(1, 0, At, B0); PG8_MMA(1, 1, At, B1); PG8_BAR; PG8_SCHED;
            PG8_LDB(B0, 1, 0); PG8_LDB(B1, 1, 1); PG8_SCHED; PG8_LDA(At, 1, 0); PG8_STAGE(PG8_SA(0, 1), a2 + hstepA, voffA);
            PG8_WAIT_V(8); PG8_WAIT_L(0); PG8_BAR; PG8_MMA(0, 0, At, B0); PG8_MMA(0, 1, At, B1); PG8_BAR; PG8_SCHED;
            PG8_LDA(At, 1, 1); PG8_STAGE(PG8_SB(1, 0), b3, voffB); PG8_STAGE(PG8_SB(1, 1), b3 + hstepB, voffB); PG8_STAGE(PG8_SA(1, 0), a3, voffA);
            PG8_WAIT_V(8); PG8_WAIT_L(0); PG8_BAR; PG8_MMA(1, 0, At, B0); PG8_MMA(1, 1, At, B1); PG8_BAR; PG8_SCHED;
            } else {
            PG8_LDB(B0, 0, 0); PG8_SCHED; PG8_LDA(At, 0, 0); PG8_STAGE(PG8_SA(1, 1), a1 + hstepA, voffA);
            PG8_WAIT_L(8); PG8_BAR; PG8_WAIT_L(0); PG8_MMA(0, 0, At, B0); PG8_BAR; PG8_SCHED;
            PG8_LDB(B1, 0, 1); PG8_STAGE(PG8_SB(0, 0), b2, voffB);
            PG8_BAR; PG8_WAIT_L(0); PG8_MMA(0, 1, At, B1); PG8_BAR;
            PG8_LDA(At, 0, 1); PG8_STAGE(PG8_SA(0, 0), a2, voffA);
            PG8_BAR; PG8_WAIT_L(0); PG8_MMA(1, 0, At, B0); PG8_BAR; PG8_SCHED;
            PG8_STAGE(PG8_SB(0, 1), b2 + hstepB, voffB);
            PG8_WAIT_V(6); PG8_BAR; PG8_MMA(1, 1, At, B1); PG8_BAR;
            PG8_LDB(B0, 1, 0); PG8_SCHED; PG8_LDA(At, 1, 0); PG8_STAGE(PG8_SA(0, 1), a2 + hstepA, voffA);
            PG8_WAIT_L(8); PG8_BAR; PG8_WAIT_L(0); PG8_MMA(0, 0, At, B0); PG8_BAR; PG8_SCHED;
            PG8_LDB(B1, 1, 1); PG8_STAGE(PG8_SB(1, 0), b3, voffB);
            PG8_BAR; PG8_WAIT_L(0); PG8_MMA(0, 1, At, B1); PG8_BAR;
            PG8_LDA(At, 1, 1); PG8_STAGE(PG8_SA(1, 0), a3, voffA);
            PG8_BAR; PG8_WAIT_L(0); PG8_MMA(1, 0, At, B0); PG8_BAR; PG8_SCHED;
            PG8_STAGE(PG8_SB(1, 1), b3 + hstepB, voffB);
            PG8_WAIT_V(6); PG8_BAR; PG8_MMA(1, 1, At, B1); PG8_BAR;
            }
        }
        if constexpr (ALIGN_EPI) { if (wr == 0) PG8_BAR; }
        if constexpr (!Epi::AFTER_DRAIN) { E(acc, cur, wr, wc, fr, fq); S.done(cur); }
        if (!has_next) break;
#pragma unroll
        for (int a = 0; a < 2; ++a)
#pragma unroll
            for (int b = 0; b < 2; ++b)
#pragma unroll
                for (int m = 0; m < 4; ++m)
#pragma unroll
                    for (int n = 0; n < 2; ++n) acc[a][b][m][n] = (f32x4){0.f, 0.f, 0.f, 0.f};
        cur = nxt; cA = nA; cB = nB; ++ui;
        if constexpr (ALIGN_EPI) { if (wr == 1) PG8_BAR; }
    }
    PG8_WAIT_V(0);
    if constexpr (!ALIGN_EPI) { if (wr == 0) PG8_BAR; }
    PG8_BAR;
    if constexpr (Epi::AFTER_DRAIN) { E.fused(acc, cur, wr, wc, fr, fq, lds, wid, lane); S.done(cur); }
#undef PG8_SA
#undef PG8_SB
#undef PG8_STAGE
#undef PG8_LDA
#undef PG8_LDB
#undef PG8_MMA
#undef PG8_WAIT_V
#undef PG8_WAIT_L
#undef PG8_BAR
#undef PG8_SCHED
}
}

constexpr int BATCH = 8, SEQ = 4096, D = 1024, FF = 4096;
constexpr int M = BATCH * SEQ;
constexpr float NORM_EPS = 1e-6f;
constexpr int NWAVES = 8;
constexpr float LOG2E = 1.4426950408889634f;

constexpr size_t MiB = 1u << 20;
constexpr size_t WS_CTL = 0, CTL_ZERO_BYTES = 64 * 1024;
constexpr size_t WS_WIN = 1 * MiB, WS_WOUT = 13 * MiB, WS_WUP = 17 * MiB, WS_WDN = 25 * MiB;
constexpr size_t WS_H = 33 * MiB;
constexpr size_t WS_BIG = 97 * MiB;
constexpr size_t WS_SMALL = 481 * MiB;
constexpr size_t WS_END = 512 * MiB;
constexpr size_t SM_LRUW = WS_SMALL;
constexpr size_t SM_SCANP = WS_SMALL + 1 * MiB, SM_SCANE = WS_SMALL + 3 * MiB;
constexpr size_t SM_W1K = WS_SMALL + 5 * MiB, SM_W1V = SM_W1K + 512 * 1024;
constexpr size_t SM_W2K = WS_SMALL + 6 * MiB, SM_W2V = SM_W2K + 16 * 1024, SM_PEB = SM_W2V + 16 * 1024;
constexpr size_t SM_KCMP = WS_SMALL + 7 * MiB, SM_VCMPT = SM_KCMP + 512 * 1024;
constexpr size_t SM_GATES = WS_SMALL + 8 * MiB;
constexpr size_t LRU_XY = WS_BIG, LRU_XC = WS_BIG + 128 * MiB, LRU_GP = WS_BIG + 192 * MiB, LRU_HS = WS_BIG + 320 * MiB;
constexpr size_t NSA_Q = WS_BIG, NSA_KC = WS_BIG + 64 * MiB, NSA_VC = NSA_KC + 8 * MiB, NSA_KS = NSA_KC + 16 * MiB, NSA_VST = NSA_KC + 24 * MiB,
                 NSA_KW = NSA_KC + 32 * MiB, NSA_VWT = NSA_KC + 40 * MiB, NSA_O = WS_BIG + 128 * MiB;
constexpr int CW_BAR = 1024;

constexpr int RING_OFF = 0, SCR_BYTES = 143360;
constexpr int LDSCTL_OFF = SCR_BYTES;
constexpr int LDS_BYTES = 147456;

#define GAS __attribute__((address_space(1)))
#define LAS __attribute__((address_space(3)))
typedef unsigned short bf16;
typedef unsigned v4u __attribute__((ext_vector_type(4)));
typedef unsigned v2u __attribute__((ext_vector_type(2)));
typedef float f32x4 __attribute__((ext_vector_type(4)));
typedef float f32x2 __attribute__((ext_vector_type(2)));
typedef float f32x16 __attribute__((ext_vector_type(16)));
typedef short bf16x8 __attribute__((ext_vector_type(8)));
typedef short s16x4 __attribute__((ext_vector_type(4)));
#define MFMA32(a, b, c) __builtin_amdgcn_mfma_f32_32x32x16_bf16((a), (b), (c), 0, 0, 0)
__device__ __forceinline__ unsigned f2bf(float f) { unsigned u = __builtin_bit_cast(unsigned, f); return (u + 0x7fffu + ((u >> 16) & 1u)) >> 16; }
__device__ __forceinline__ unsigned pk2(float lo, float hi) { return f2bf(lo) | (f2bf(hi) << 16); }
__device__ __forceinline__ float bflo(unsigned w) { return __uint_as_float(w << 16); }
__device__ __forceinline__ float bfhi(unsigned w) { return __uint_as_float(w & 0xffff0000u); }
__device__ __forceinline__ float bf1(bf16 v) { return __uint_as_float((unsigned)v << 16); }
__device__ __forceinline__ float gelu_tanh(float x) { const float z = 0.7978845608028654f * (x + 0.044715f * x * x * x); const float t = 1.f - 2.f / (1.f + __expf(2.f * z)); return 0.5f * x * (1.f + t); }
__device__ __forceinline__ float silu(float x) { return x / (1.f + __expf(-x)); }

#define XB_TMO      128
#define XB_XCNT(j)  (256  + 64 * (j))
#define XB_XSUB(j)  (1280 + 64 * (j))
#define XB_XGEN(j)  (2304 + 64 * (j))
#define XB_TOP      3328
#define XB_TOPGEN   3392
#define XCD_BAR_WORDS 3456
#define XB_SPIN_CAP (1u << 18)
#define LAS __attribute__((address_space(3)))

__device__ __forceinline__ unsigned xb_ld(unsigned* p)              { return __hip_atomic_load(p, __ATOMIC_RELAXED, __HIP_MEMORY_SCOPE_AGENT); }
__device__ __forceinline__ unsigned xb_add(unsigned* p, unsigned v) { return __hip_atomic_fetch_add(p, v, __ATOMIC_RELAXED, __HIP_MEMORY_SCOPE_AGENT); }
__device__ __forceinline__ unsigned xb_xcc_id() { return (unsigned)__builtin_amdgcn_s_getreg((3 << 11) | 20) & 0xFu; }
#define XB_SPIN(cond, bar) do { unsigned _sp = 0; while (cond) { __builtin_amdgcn_s_sleep(1); \
    if ((++_sp & 255u) == 0u) { if (xb_ld(&(bar)[XB_TMO])) break; if (_sp > XB_SPIN_CAP) { atomicAdd(&(bar)[XB_TMO], 1u); break; } } } } while (0)

struct XcdBarrier {
    unsigned* bar; unsigned x;
    volatile LAS unsigned* st;
};

__device__ __forceinline__ XcdBarrier xcd_barrier_post(unsigned* bar, volatile LAS unsigned* st) {
    XcdBarrier b; b.bar = bar; b.x = xb_xcc_id(); b.st = st;
    if (threadIdx.x == 0) (void)xb_add(&bar[XB_XCNT(b.x)], 1u);
    return b;
}
__device__ __forceinline__ void xcd_barrier_complete(unsigned* bar, unsigned x, unsigned& nloc, unsigned& nx) {
    const unsigned G = gridDim.x * gridDim.y * gridDim.z;
    unsigned sum, cnt, mine, sp = 0u;
    for (;;) {
        sum = 0u; cnt = 0u; mine = 0u;
#pragma unroll
        for (unsigned j = 0; j < 16; ++j) { const unsigned c = xb_ld(&bar[XB_XCNT(j)]); sum += c; cnt += (c > 0u) ? 1u : 0u; mine = (j == x) ? c : mine; }
        if (sum == G) break;
        __builtin_amdgcn_s_sleep(1);
        if ((++sp & 255u) == 0u) { if (xb_ld(&bar[XB_TMO])) break; if (sp > XB_SPIN_CAP) { atomicAdd(&bar[XB_TMO], 1u); break; } }
    }
    nloc = mine > 0u ? mine : 1u; nx = cnt > 0u ? cnt : 1u;
}

__device__ __forceinline__ void xcd_barrier(const XcdBarrier& b) {
    asm volatile("s_waitcnt vmcnt(0)" ::: "memory");
    __syncthreads();
    if (threadIdx.x == 0) {
        unsigned* bar = b.bar;
        __builtin_amdgcn_s_waitcnt(0);
        unsigned nloc = b.st[0], nx = b.st[1];
        if (nloc == 0u) { xcd_barrier_complete(bar, b.x, nloc, nx); b.st[0] = nloc; b.st[1] = nx; }
        const unsigned old = xb_add(&bar[XB_XSUB(b.x)], 1u);
        const unsigned gen = old / nloc;
        if (old + 1u == (gen + 1u) * nloc) {
            __builtin_amdgcn_fence(__ATOMIC_RELEASE, "agent");
            asm volatile("s_waitcnt vmcnt(0)" ::: "memory");
            const unsigned og = xb_add(&bar[XB_TOP], 1u);
            const unsigned tg = og / nx;
            if (og + 1u == (tg + 1u) * nx) xb_add(&bar[XB_TOPGEN], 1u);
            else XB_SPIN(xb_ld(&bar[XB_TOPGEN]) == tg, bar);
            __builtin_amdgcn_fence(__ATOMIC_ACQUIRE, "agent");
            xb_add(&bar[XB_XGEN(b.x)], 1u);
            asm volatile("s_waitcnt vmcnt(0)" ::: "memory");
        } else {
            XB_SPIN(xb_ld(&bar[XB_XGEN(b.x)]) == gen, bar);
            __builtin_amdgcn_fence(__ATOMIC_ACQUIRE, "agent");
            asm volatile("s_waitcnt vmcnt(0)" ::: "memory");
        }
    }
    __syncthreads();
}

struct Frame {
    LAS unsigned char* lds;
    int tid, lane, wave;
    int vcu, G;
    unsigned char* ws;
};

__device__ __forceinline__ bool frame_refresh(Frame& F) { int tz = threadIdx.x; asm volatile("" : "+v"(tz)); F.tid = tz; F.lane = tz & 63; return true; }
__device__ __forceinline__ float wave_sum(float v) {
#pragma unroll
    for (int o = 1; o < 64; o <<= 1) v += __shfl_xor(v, o);
    return v;
}
__device__ __forceinline__ float grp16_sum(float v) {
#pragma unroll
    for (int o = 1; o < 16; o <<= 1) v += __shfl_xor(v, o);
    return v;
}

__device__ __forceinline__ void conv_w(Frame& F, int& base, const float* W, int K, int ldw, int n_src0, int ncols, int n_valid, bf16* WT, int ldk, int row_off, float scale) {
    LAS float* scr = (LAS float*)(F.lds + F.wave * 8704);
    const int gw = F.vcu * NWAVES + F.wave, NGW = F.G * NWAVES, lane = F.lane;
    const int nblk = ncols / 32, items = (K / 64) * nblk;
    int start = (gw - base % NGW + NGW) % NGW; base += items;
    for (int it = start; it < items; it += NGW) {
        const int kb = it / nblk, nb = it % nblk, k0 = 64 * kb, n0 = 32 * nb;
        const int nn = n_src0 + n0 + (lane & 31); const bool ok = nn < n_valid;
#pragma unroll 8
        for (int i = 0; i < 32; ++i) { const int kk = 2 * i + (lane >> 5); scr[kk * 33 + (lane & 31)] = ok ? W[(size_t)(k0 + kk) * ldw + nn] * scale : 0.f; }
        asm volatile("s_waitcnt lgkmcnt(0)" ::: "memory");
        const int c = lane & 7;
#pragma unroll
        for (int j = 0; j < 4; ++j) { const int n = (lane >> 3) + 8 * j; const LAS float* s = scr + (8 * c) * 33 + n;
            v4u o; o.x = pk2(s[0 * 33], s[1 * 33]); o.y = pk2(s[2 * 33], s[3 * 33]); o.z = pk2(s[4 * 33], s[5 * 33]); o.w = pk2(s[6 * 33], s[7 * 33]);
            *(v4u*)(WT + (size_t)(row_off + n0 + n) * ldk + k0 + 8 * c) = o; }
        asm volatile("s_waitcnt lgkmcnt(0)" ::: "memory");
    }
}

__device__ __forceinline__ void norm_phase(Frame& F, const float* xin, const bf16* Y, float* xout, bf16* H, const float* gpost, const float* gpre) {
    const int gw = F.vcu * NWAVES + F.wave, NGW = F.G * NWAVES, lane = F.lane;
    for (int m = gw; m < M; m += NGW) {
        const f32x4* xr = (const f32x4*)(xin + (size_t)m * D) + lane;
        f32x4 v[4];
#pragma unroll
        for (int j = 0; j < 4; ++j) v[j] = xr[64 * j];
        if (Y) {
            const v2u* yr = (const v2u*)(Y + (size_t)m * D) + lane;
            f32x4 y[4]; float ss = 0.f;
#pragma unroll
            for (int j = 0; j < 4; ++j) { const v2u w = yr[64 * j]; y[j] = (f32x4){bflo(w.x), bfhi(w.x), bflo(w.y), bfhi(w.y)}; ss += (y[j].x * y[j].x + y[j].y * y[j].y) + (y[j].z * y[j].z + y[j].w * y[j].w); }
            const float rstd = rsqrtf(wave_sum(ss) * (1.f / D) + NORM_EPS);
#pragma unroll
            for (int j = 0; j < 4; ++j) { const f32x4 g = *((const f32x4*)gpost + lane + 64 * j); v[j] = v[j] + y[j] * rstd * g; }
        }
        if (xout) { f32x4* xo = (f32x4*)(xout + (size_t)m * D) + lane;
#pragma unroll
            for (int j = 0; j < 4; ++j) xo[64 * j] = v[j]; }
        if (H) {
            float ss = 0.f;
#pragma unroll
            for (int j = 0; j < 4; ++j) ss += (v[j].x * v[j].x + v[j].y * v[j].y) + (v[j].z * v[j].z + v[j].w * v[j].w);
            const float rstd = rsqrtf(wave_sum(ss) * (1.f / D) + NORM_EPS);
            v2u* ho = (v2u*)(H + (size_t)m * D) + lane;
#pragma unroll
            for (int j = 0; j < 4; ++j) { const f32x4 g = *((const f32x4*)gpre + lane + 64 * j); const f32x4 o = v[j] * rstd * g;
                v2u w; w.x = pk2(o.x, o.y); w.y = pk2(o.z, o.w); ho[64 * j] = w; }
        }
    }
}

template <int DK, int DV, int CS, bool ISGLA>
__device__ __forceinline__ void recur_phase(Frame& F, bf16* base, int ld, int qoff, int koff, int voff, int laoff, float kscale) {
    constexpr int NS = DV / CS, NDG = 512 / CS, DPT = DK / NDG, TB = 16, NT = ISGLA ? 3 : 2, NB = SEQ / TB;
    constexpr int STG = NT * TB * DK, VST = TB * CS, RED = NDG * TB * CS;
    static_assert((2 * STG + 2 * VST + 2 * RED) * 4 <= SCR_BYTES, "recurrent phase LDS");
    LAS float* stage = (LAS float*)F.lds; LAS float* vst = stage + 2 * STG; LAS float* red = vst + 2 * VST;
    const int tid = F.tid, c = tid % CS, dg = tid / CS;
    constexpr int QCH = TB * DK / 8, VCH = TB * CS / 8;
    const bool ldq = tid < QCH, ldv = tid < VCH;
    const int qt_ = tid / (DK / 8), qd = (tid % (DK / 8)) * 8;
    const int vt_ = tid / (CS / 8), vc_ = (tid % (CS / 8)) * 8;
    for (int it = F.vcu; it < 32 * NS; it += F.G) {
        const int bh = it / NS, sl = it % NS, b = bh >> 2, h = bh & 3;
        bf16* rowbase = base + (size_t)b * SEQ * ld;
        const bf16* qp = rowbase + qoff + h * DK; const bf16* kp = rowbase + koff + h * DK; const bf16* lap = rowbase + laoff + h * DK;
        bf16* vp = rowbase + voff + h * DV + sl * CS;
        const float gamma = 1.f - exp2f(-5.f - (float)h);
        f32x2 S[DPT / 2];
#pragma unroll
        for (int i = 0; i < DPT / 2; ++i) S[i] = (f32x2){0.f, 0.f};
        v4u rq = {0, 0, 0, 0}, rk = {0, 0, 0, 0}, rl = {0, 0, 0, 0}, rv = {0, 0, 0, 0};
#define RC_GLOAD(n_) do { \
            if (ldq) { const size_t o_ = (size_t)((n_) * TB + qt_) * ld + qd; rq = *(const v4u*)(qp + o_); rk = *(const v4u*)(kp + o_); if (ISGLA) rl = *(const v4u*)(lap + o_); } \
            if (ldv) { rv = *(const v4u*)(vp + (size_t)((n_) * TB + vt_) * ld + vc_); } } while (0)
#define RC_SWRITE(buf_) do { \
            LAS float* st_ = stage + (buf_) * STG; \
            if (ldq) { \
                LAS float* q_ = st_ + qt_ * DK + qd; LAS float* k_ = st_ + TB * DK + qt_ * DK + qd; \
                *(LAS f32x4*)q_ = (f32x4){bflo(rq.x), bfhi(rq.x), bflo(rq.y), bfhi(rq.y)}; *(LAS f32x4*)(q_ + 4) = (f32x4){bflo(rq.z), bfhi(rq.z), bflo(rq.w), bfhi(rq.w)}; \
                *(LAS f32x4*)k_ = (f32x4){bflo(rk.x), bfhi(rk.x), bflo(rk.y), bfhi(rk.y)} * kscale; *(LAS f32x4*)(k_ + 4) = (f32x4){bflo(rk.z), bfhi(rk.z), bflo(rk.w), bfhi(rk.w)} * kscale; \
                if (ISGLA) { LAS float* a_ = st_ + 2 * TB * DK + qt_ * DK + qd; \
                    *(LAS f32x4*)a_ = (f32x4){__expf(bflo(rl.x)), __expf(bfhi(rl.x)), __expf(bflo(rl.y)), __expf(bfhi(rl.y))}; \
                    *(LAS f32x4*)(a_ + 4) = (f32x4){__expf(bflo(rl.z)), __expf(bfhi(rl.z)), __expf(bflo(rl.w)), __expf(bfhi(rl.w))}; } \
            } \
            if (ldv) { LAS float* v_ = vst + (buf_) * VST + vt_ * CS + vc_; \
                *(LAS f32x4*)v_ = (f32x4){bflo(rv.x), bfhi(rv.x), bflo(rv.y), bfhi(rv.y)}; *(LAS f32x4*)(v_ + 4) = (f32x4){bflo(rv.z), bfhi(rv.z), bflo(rv.w), bfhi(rv.w)}; } } while (0)
        __syncthreads();
        RC_GLOAD(0); RC_SWRITE(0);
        __syncthreads();
        for (int n = 0; n < NB; ++n) {
            const int cur = n & 1;
            if (n + 1 < NB) RC_GLOAD(n + 1);
            const LAS float* qs = stage + cur * STG + dg * DPT; const LAS float* ks = qs + TB * DK; const LAS float* as = qs + 2 * TB * DK;
            const LAS float* vs = vst + cur * VST + c;
            LAS float* rd = red + cur * RED + dg * TB * CS + c;
#pragma unroll
            for (int t = 0; t < TB; ++t) {
                const float vv = vs[t * CS];
                f32x2 acc = {0.f, 0.f};
#pragma unroll
                for (int i = 0; i < DPT; i += 4) {
                    const f32x4 k4 = *(const LAS f32x4*)(ks + t * DK + i), q4 = *(const LAS f32x4*)(qs + t * DK + i);
                    f32x2 d0, d1;
                    if (ISGLA) { const f32x4 a4 = *(const LAS f32x4*)(as + t * DK + i); d0 = (f32x2){a4.x, a4.y}; d1 = (f32x2){a4.z, a4.w}; } else { d0 = (f32x2){gamma, gamma}; d1 = d0; }
                    S[i / 2] = S[i / 2] * d0 + (f32x2){k4.x, k4.y} * vv; acc += (f32x2){q4.x, q4.y} * S[i / 2];
                    S[i / 2 + 1] = S[i / 2 + 1] * d1 + (f32x2){k4.z, k4.w} * vv; acc += (f32x2){q4.z, q4.w} * S[i / 2 + 1];
                }
                rd[t * CS] = acc.x + acc.y;
            }
            if (n + 1 < NB) RC_SWRITE(cur ^ 1);
            __syncthreads();
#pragma unroll
            for (int rep = 0; rep < (TB * CS + 511) / 512; ++rep) {
                const int idx = tid + rep * 512;
                if (idx < TB * CS) {
                    const LAS float* rr = red + cur * RED + idx; float s = 0.f;
#pragma unroll
                    for (int g = 0; g < NDG; ++g) s += rr[g * TB * CS];
                    const int t = idx / CS, cc = idx % CS;
                    vp[(size_t)(n * TB + t) * ld + cc] = (bf16)f2bf(s);
                }
            }
        }
    }
    __syncthreads();
}

template <int DV, bool CENTER>
__device__ __forceinline__ void hn_phase(Frame& F, bf16* base, int ld, int ooff, int goff, const float* gn) {
    constexpr int NJ = DV / 128;
    const int gw = F.vcu * NWAVES + F.wave, NGW = F.G * NWAVES, lane = F.lane, hq = lane >> 4, li = lane & 15;
    for (int m = gw; m < M; m += NGW) {
        bf16* op = base + (size_t)m * ld + ooff + hq * DV + li * 8; const bf16* gp = base + (size_t)m * ld + goff + hq * DV + li * 8;
        float o[NJ][8]; v4u gw4[NJ]; float s = 0.f;
#pragma unroll
        for (int j = 0; j < NJ; ++j) { const v4u w = *(const v4u*)(op + 128 * j); gw4[j] = *(const v4u*)(gp + 128 * j);
            o[j][0] = bflo(w.x); o[j][1] = bfhi(w.x); o[j][2] = bflo(w.y); o[j][3] = bfhi(w.y); o[j][4] = bflo(w.z); o[j][5] = bfhi(w.z); o[j][6] = bflo(w.w); o[j][7] = bfhi(w.w);
#pragma unroll
            for (int e = 0; e < 8; ++e) s += o[j][e]; }
        float mean = 0.f;
        if (CENTER) mean = grp16_sum(s) * (1.f / DV);
        float s2 = 0.f;
#pragma unroll
        for (int j = 0; j < NJ; ++j)
#pragma unroll
            for (int e = 0; e < 8; ++e) { o[j][e] -= mean; s2 += o[j][e] * o[j][e]; }
        const float rstd = rsqrtf(grp16_sum(s2) * (1.f / DV) + NORM_EPS);
#pragma unroll
        for (int j = 0; j < NJ; ++j) {
            const float* gnp = gn + hq * DV + li * 8 + 128 * j; const f32x4 g0 = *(const f32x4*)gnp, g1 = *(const f32x4*)(gnp + 4);
            const float gg[8] = {bflo(gw4[j].x), bfhi(gw4[j].x), bflo(gw4[j].y), bfhi(gw4[j].y), bflo(gw4[j].z), bfhi(gw4[j].z), bflo(gw4[j].w), bfhi(gw4[j].w)};
            float r[8];
#pragma unroll
            for (int e = 0; e < 8; ++e) r[e] = o[j][e] * rstd * (e < 4 ? g0[e & 3] : g1[e & 3]) * silu(gg[e]);
            v4u w; w.x = pk2(r[0], r[1]); w.y = pk2(r[2], r[3]); w.z = pk2(r[4], r[5]); w.w = pk2(r[6], r[7]);
            *(v4u*)(op + 128 * j) = w;
        }
    }
}

__device__ __forceinline__ void lru_conv_phase(Frame& F, const bf16* XY, bf16* XC, const float* cw, const float* cb) {
    const int gw = F.vcu * NWAVES + F.wave, NGW = F.G * NWAVES, lane = F.lane;
    for (int m = gw; m < M; m += NGW) {
        const int t = m & (SEQ - 1);
#pragma unroll
        for (int j = 0; j < 2; ++j) {
            const int ch = lane * 8 + 512 * j;
            float acc[8];
            { const f32x4 b0 = *(const f32x4*)(cb + ch), b1 = *(const f32x4*)(cb + ch + 4);
              acc[0] = b0.x; acc[1] = b0.y; acc[2] = b0.z; acc[3] = b0.w; acc[4] = b1.x; acc[5] = b1.y; acc[6] = b1.z; acc[7] = b1.w; }
#pragma unroll
            for (int tap = 0; tap < 4; ++tap) {
                if (t - 3 + tap >= 0) {
                    const v4u w = *(const v4u*)(XY + (size_t)(m - 3 + tap) * 2048 + ch);
                    const f32x4 c0 = *(const f32x4*)(cw + tap * 1024 + ch), c1 = *(const f32x4*)(cw + tap * 1024 + ch + 4);
                    acc[0] += bflo(w.x) * c0.x; acc[1] += bfhi(w.x) * c0.y; acc[2] += bflo(w.y) * c0.z; acc[3] += bfhi(w.y) * c0.w;
                    acc[4] += bflo(w.z) * c1.x; acc[5] += bfhi(w.z) * c1.y; acc[6] += bflo(w.w) * c1.z; acc[7] += bfhi(w.w) * c1.w;
                }
            }
            v4u o; o.x = pk2(acc[0], acc[1]); o.y = pk2(acc[2], acc[3]); o.z = pk2(acc[4], acc[5]); o.w = pk2(acc[6], acc[7]);
            *(v4u*)(XC + (size_t)m * 1024 + ch) = o;
        }
    }
}
template <int PASS>
__device__ __forceinline__ void lru_scan_phase(Frame& F, const bf16* GP, const bf16* XC, const bf16* XY, float* SP, float* SE, bf16* HS, const float* b_a, const float* b_x, const float* lam) {
    const int tid = F.tid, ch = 2 * tid, gcol = (ch >> 7) * 256 + (ch & 127);
    const float ba0 = b_a[ch], ba1 = b_a[ch + 1], bx0 = b_x[ch], bx1 = b_x[ch + 1];
    const float lm0 = lam[ch], lm1 = lam[ch + 1];
    const float sp0 = -8.f * (fmaxf(-lm0, 0.f) + log1pf(__expf(-fabsf(lm0)))), sp1 = -8.f * (fmaxf(-lm1, 0.f) + log1pf(__expf(-fabsf(lm1))));
    for (int it = F.vcu; it < BATCH * 64; it += F.G) {
        const int b = it >> 6, ci = it & 63; const size_t m0 = (size_t)b * SEQ + ci * 64;
        float h0 = 0.f, h1 = 0.f, s0 = 0.f, s1 = 0.f;
        if (PASS == 1) {
            for (int j = 0; j < ci; ++j) { const f32x2 p = *(const f32x2*)(SP + (size_t)(b * 64 + j) * 1024 + ch), e = *(const f32x2*)(SE + (size_t)(b * 64 + j) * 1024 + ch);
                h0 = p.x * h0 + e.x; h1 = p.y * h1 + e.y; }
        }
#pragma unroll 8
        for (int t = 0; t < 64; ++t) {
            const unsigned pa = *(const unsigned*)(GP + (m0 + t) * 2048 + gcol), px = *(const unsigned*)(GP + (m0 + t) * 2048 + gcol + 128), xc = *(const unsigned*)(XC + (m0 + t) * 1024 + ch);
            const float l0 = sp0 / (1.f + __expf(-(bflo(pa) + ba0))), l1 = sp1 / (1.f + __expf(-(bfhi(pa) + ba1)));
            const float a0 = __expf(l0), a1 = __expf(l1);
            const float u0 = sqrtf(fmaxf(1.f - a0 * a0, 0.f)) * bflo(xc) / (1.f + __expf(-(bflo(px) + bx0))), u1 = sqrtf(fmaxf(1.f - a1 * a1, 0.f)) * bfhi(xc) / (1.f + __expf(-(bfhi(px) + bx1)));
            h0 = a0 * h0 + u0; h1 = a1 * h1 + u1;
            if (PASS == 0) { s0 += l0; s1 += l1; }
            else { const unsigned y = *(const unsigned*)(XY + (m0 + t) * 2048 + 1024 + ch);
                *(unsigned*)(HS + (m0 + t) * 1024 + ch) = pk2(h0 * gelu_tanh(bflo(y)), h1 * gelu_tanh(bfhi(y))); }
        }
        if (PASS == 0) { *(f32x2*)(SP + (size_t)it * 1024 + ch) = (f32x2){__expf(s0), __expf(s1)}; *(f32x2*)(SE + (size_t)it * 1024 + ch) = (f32x2){h0, h1}; }
    }
}

__device__ __forceinline__ void nsa_compress_phase(Frame& F, const bf16* KC, const bf16* VC, const bf16* W1K, const bf16* W1V, const bf16* W2K, const bf16* W2V, const float* PEB, bf16* KCMP, bf16* VCMPT) {
    LAS float* part = (LAS float*)F.lds;
    LAS bf16* hid = (LAS bf16*)(F.lds + 32768);
    const int tid = F.tid, lane = F.lane, w = F.wave, r = lane & 31, hh = lane >> 5;
    for (int it = F.vcu; it < 256; it += F.G) {
        const int kv = it >> 7, bg = (it >> 3) & 15, ntile = it & 7;
        const bf16* A = (kv ? VC : KC) + (size_t)bg * SEQ * 64 + (size_t)(32 * ntile) * 1024;
        const bf16* W1 = kv ? W1V : W1K; const bf16* W2 = kv ? W2V : W2K; const float* bias = PEB + kv * 128;
        const int ct = w & 3, kh = w >> 2;
        f32x16 acc = {};
        const bf16* ap = A + (size_t)r * 1024 + 1024 * kh + 8 * hh; const bf16* bp = W1 + (size_t)(32 * ct + r) * 2048 + 1024 * kh + 8 * hh;
#pragma unroll 8
        for (int s = 0; s < 64; ++s) { const bf16x8 a = *(const bf16x8*)(ap + 16 * s), bb = *(const bf16x8*)(bp + 16 * s); acc = MFMA32(a, bb, acc); }
        __syncthreads();
#pragma unroll
        for (int q = 0; q < 16; ++q) { const int row = (q & 3) + 8 * (q >> 2) + 4 * hh; part[kh * 4096 + row * 128 + 32 * ct + r] = acc[q]; }
        __syncthreads();
        { const int row = tid >> 4, col = (tid & 15) * 8; unsigned pk[4];
#pragma unroll
          for (int e = 0; e < 8; e += 2) { const float a0 = part[row * 128 + col + e] + part[4096 + row * 128 + col + e] + bias[col + e];
              const float a1 = part[row * 128 + col + e + 1] + part[4096 + row * 128 + col + e + 1] + bias[col + e + 1];
              pk[e >> 1] = pk2(gelu_tanh(a0), gelu_tanh(a1)); }
          *(LAS v4u*)(hid + row * 136 + col) = (v4u){pk[0], pk[1], pk[2], pk[3]}; }
        __syncthreads();
        if (w < 2) {
            f32x16 a2 = {};
#pragma unroll
            for (int s = 0; s < 8; ++s) { const bf16x8 a = *(const LAS bf16x8*)(hid + r * 136 + 16 * s + 8 * hh), bb = *(const bf16x8*)(W2 + (size_t)(32 * w + r) * 128 + 16 * s + 8 * hh); a2 = MFMA32(a, bb, a2); }
            const int d = 32 * w + r;
            if (kv == 0) {
#pragma unroll
                for (int q = 0; q < 16; ++q) { const int n = 32 * ntile + (q & 3) + 8 * (q >> 2) + 4 * hh; KCMP[((size_t)bg * 256 + n) * 64 + d] = (bf16)(n == 255 ? 0u : f2bf(a2[q])); }
            } else {
#pragma unroll
                for (int q4 = 0; q4 < 4; ++q4) { const int n = 32 * ntile + 8 * q4 + 4 * hh; float v[4];
#pragma unroll
                    for (int e = 0; e < 4; ++e) v[e] = (n + e == 255) ? 0.f : a2[4 * q4 + e];
                    v2u o; o.x = pk2(v[0], v[1]); o.y = pk2(v[2], v[3]); *(v2u*)(VCMPT + ((size_t)bg * 64 + d) * 256 + n) = o; }
            }
        }
    }
    __syncthreads();
}

constexpr int KP = 72;
__device__ __forceinline__ void qk_tile(const LAS bf16* KT, const bf16x8 (&Qf)[4], f32x16& S0, f32x16& S1, int r, int hh) {
    S0 = (f32x16){}; S1 = (f32x16){};
#pragma unroll
    for (int s = 0; s < 4; ++s) {
        const bf16x8 a0 = *(const LAS bf16x8*)(KT + r * KP + 16 * s + 8 * hh), a1 = *(const LAS bf16x8*)(KT + (32 + r) * KP + 16 * s + 8 * hh);
        S0 = MFMA32(a0, Qf[s], S0); S1 = MFMA32(a1, Qf[s], S1);
    }
}
__device__ __forceinline__ void attn_tile(const LAS bf16* KT, const LAS bf16* VT, const bf16x8 (&Qf)[4], f32x16 (&O)[2], float& mrun, float& lrun,
                                          float biasl, float bstep, int limhi, int limlo, int r, int hh) {
    f32x16 S0, S1; qk_tile(KT, Qf, S0, S1, r, hh);
    float mx = -INFINITY;
#pragma unroll
    for (int q = 0; q < 16; ++q) { const int c = (q & 3) + 8 * (q >> 2);
        S0[q] = (c <= limhi && c > limlo) ? S0[q] + __builtin_fmaf(bstep, (float)c, biasl) : -INFINITY;
        S1[q] = (c + 32 <= limhi && c + 32 > limlo) ? S1[q] + __builtin_fmaf(bstep, (float)(c + 32), biasl) : -INFINITY;
        mx = fmaxf(mx, fmaxf(S0[q], S1[q])); }
    mx = fmaxf(mx, __shfl_xor(mx, 32));
    const float mnew = fmaxf(mrun, mx), alpha = __builtin_amdgcn_exp2f(mrun - mnew);
    float rs = 0.f;
#pragma unroll
    for (int q = 0; q < 16; ++q) { S0[q] = __builtin_amdgcn_exp2f(S0[q] - mnew); S1[q] = __builtin_amdgcn_exp2f(S1[q] - mnew); rs += S0[q] + S1[q]; }
    rs += __shfl_xor(rs, 32);
    lrun = lrun * alpha + rs; mrun = mnew;
#pragma unroll
    for (int dt = 0; dt < 2; ++dt)
#pragma unroll
        for (int q = 0; q < 16; ++q) O[dt][q] *= alpha;
    bf16x8 Pf[2][2];
#pragma unroll
    for (int s = 0; s < 2; ++s) {
        v4u w0, w1;
        w0.x = pg8::cvt_pk_bf16(S0[8 * s + 0], S0[8 * s + 1]); w0.y = pg8::cvt_pk_bf16(S0[8 * s + 2], S0[8 * s + 3]); w0.z = pg8::cvt_pk_bf16(S0[8 * s + 4], S0[8 * s + 5]); w0.w = pg8::cvt_pk_bf16(S0[8 * s + 6], S0[8 * s + 7]);
        w1.x = pg8::cvt_pk_bf16(S1[8 * s + 0], S1[8 * s + 1]); w1.y = pg8::cvt_pk_bf16(S1[8 * s + 2], S1[8 * s + 3]); w1.z = pg8::cvt_pk_bf16(S1[8 * s + 4], S1[8 * s + 5]); w1.w = pg8::cvt_pk_bf16(S1[8 * s + 6], S1[8 * s + 7]);
        Pf[0][s] = __builtin_bit_cast(bf16x8, w0); Pf[1][s] = __builtin_bit_cast(bf16x8, w1);
    }
#pragma unroll
    for (int dt = 0; dt < 2; ++dt)
#pragma unroll
        for (int kt = 0; kt < 2; ++kt)
#pragma unroll
            for (int s = 0; s < 2; ++s) {
                const LAS bf16* vp = VT + (32 * dt + r) * KP + 32 * kt + 16 * s + 4 * hh;
                const v2u lo = *(const LAS v2u*)vp, hi = *(const LAS v2u*)(vp + 8);
                const bf16x8 a = __builtin_bit_cast(bf16x8, (v4u){lo.x, lo.y, hi.x, hi.y});
                O[dt] = MFMA32(a, Pf[kt][s], O[dt]);
            }
}
__device__ __forceinline__ void imp_tile(const LAS bf16* KT, const bf16x8 (&Qf)[4], float mfin, float linv, float biasl, float bstep, int limhi, int n0t, LAS unsigned* IMP, int r, int hh) {
    f32x16 S0, S1; qk_tile(KT, Qf, S0, S1, r, hh);
#pragma unroll
    for (int q = 0; q < 16; ++q) { const int c = (q & 3) + 8 * (q >> 2);
        S0[q] = (c <= limhi) ? __builtin_amdgcn_exp2f(S0[q] + __builtin_fmaf(bstep, (float)c, biasl) - mfin) * linv : 0.f;
        S1[q] = (c + 32 <= limhi) ? __builtin_amdgcn_exp2f(S1[q] + __builtin_fmaf(bstep, (float)(c + 32), biasl) - mfin) * linv : 0.f; }
    LAS unsigned* row = IMP + r * 65;
#pragma unroll
    for (int kt = 0; kt < 2; ++kt)
#pragma unroll
        for (int a = 0; a < 4; ++a) {
            const float e0 = kt ? S1[4 * a] : S0[4 * a], e1 = kt ? S1[4 * a + 1] : S0[4 * a + 1], e2 = kt ? S1[4 * a + 2] : S0[4 * a + 2], e3 = kt ? S1[4 * a + 3] : S0[4 * a + 3];
            const int j = (n0t + 32 * kt + 8 * a + 4 * hh) >> 2;
            const unsigned gq = (unsigned)((e0 + e1 + e2 + e3) * 8388608.f + 0.5f), lq = (unsigned)(e3 * 8388608.f + 0.5f);
            if (gq) __hip_atomic_fetch_add((unsigned*)(row + j), gq, __ATOMIC_RELAXED, __HIP_MEMORY_SCOPE_WORKGROUP);
            if (lq && j + 1 < 64) __hip_atomic_fetch_add((unsigned*)(row + j + 1), lq, __ATOMIC_RELAXED, __HIP_MEMORY_SCOPE_WORKGROUP);
        }
}
__device__ __forceinline__ void load_kv_tile(LAS bf16* KT, LAS bf16* VT, const bf16* ksrc  , const bf16* vsrc  , int vstride, int tid, bool with_v) {
    const int row = tid >> 3, ch = (tid & 7) * 8;
    const v4u k = *(const v4u*)(ksrc + row * 64 + ch);
    v4u v = {0, 0, 0, 0}; if (with_v) v = *(const v4u*)(vsrc + (size_t)row * vstride + ch);
    *(LAS v4u*)(KT + row * KP + ch) = k;
    if (with_v) *(LAS v4u*)(VT + row * KP + ch) = v;
}
#define TZ_LANE int tz = tid; asm volatile("" : "+v"(tz)); const int r = tz & 31, hh = (tz >> 5) & 1;
__device__ __forceinline__ void nsa_attn_phase(Frame& F, const bf16* Q, const bf16* KCMP, const bf16* VCMPT, const bf16* KS, const bf16* VST, const bf16* KW, const bf16* VWT, const float* GATES, bf16* OB) {
    LAS bf16* KT = (LAS bf16*)F.lds; LAS bf16* VT = KT + 64 * KP;
    LAS unsigned* IMP = (LAS unsigned*)(F.lds + 2 * 64 * KP * 2);
    LAS unsigned char* SELB = (LAS unsigned char*)(IMP + 32 * 65);
    const int tid = F.tid, w = F.wave;
    for (int it = F.vcu; it < 2048; it += F.G) {
        const int k8 = it >> 8, v = it & 255, slot = k8 >> 1, half = k8 & 1, bg = v >> 4, rr = v & 15;
        const int i = slot == 0 ? rr : (slot == 1 ? 31 - rr : (slot == 2 ? 32 + rr : 63 - rr));
        const int b = bg >> 1, g = bg & 1, h = g * 8 + w, t0 = 64 * i, q0 = 32 * half;
        const float slope2 = exp2f(-0.5f * (float)(h + 1)) * LOG2E;
        bf16x8 Qf[4]; float gate[3];
        { TZ_LANE
          const size_t row = (size_t)b * SEQ + t0 + q0 + r;
#pragma unroll
          for (int s = 0; s < 4; ++s) Qf[s] = *(const bf16x8*)(Q + row * 1024 + h * 64 + 16 * s + 8 * hh);
#pragma unroll
          for (int br = 0; br < 3; ++br) gate[br] = GATES[row * 48 + br * 16 + h]; }
        f32x16 O[2]; O[0] = (f32x16){}; O[1] = (f32x16){};
        unsigned OUTP[2][8];
#define OUT_ACC(sc_, first_) do { _Pragma("unroll") for (int dt_ = 0; dt_ < 2; ++dt_) { _Pragma("unroll") for (int e_ = 0; e_ < 8; ++e_) { const unsigned w_ = (first_) ? 0u : OUTP[dt_][e_]; \
            OUTP[dt_][e_] = pk2(bflo(w_) + O[dt_][2 * e_] * (sc_), bfhi(w_) + O[dt_][2 * e_ + 1] * (sc_)); } O[dt_] = (f32x16){}; } } while (0)
        float mrun = -1e30f, lrun = 0.f;
        __syncthreads();
        for (int idx = tid; idx < 32 * 65; idx += 512) IMP[idx] = 0u;
        const int ncmp = (4 * i + 3) < 255 ? (4 * i + 3) : 255, ntile = (ncmp + 63) >> 6;
        const bf16* kcb = KCMP + (size_t)bg * 256 * 64; const bf16* vcb = VCMPT + (size_t)bg * 64 * 256;
        for (int tl = 0; tl < ntile; ++tl) {
            TZ_LANE
            __syncthreads();
            load_kv_tile(KT, VT, kcb + (size_t)tl * 64 * 64, vcb + tl * 64, 256, tz, true);
            __syncthreads();
            const int n0t = 64 * tl, a1 = ((t0 + q0 + r - 31) >> 4) - n0t - 4 * hh, a2 = 254 - n0t - 4 * hh;
            attn_tile(KT, VT, Qf, O, mrun, lrun, slope2 * (float)(16 * n0t + 31 - t0) + slope2 * 64.f * (float)hh, slope2 * 16.f, a1 < a2 ? a1 : a2, -1000, r, hh);
        }
        const float mfin = mrun, linv = 1.f / fmaxf(lrun, 1e-30f);
        OUT_ACC(linv * gate[0], true);
        mrun = -1e30f; lrun = 0.f;
        for (int tl = 0; tl < ntile; ++tl) {
            TZ_LANE
            __syncthreads();
            load_kv_tile(KT, VT, kcb + (size_t)tl * 64 * 64, vcb, 256, tz, false);
            __syncthreads();
            const int n0t = 64 * tl, a1 = ((t0 + q0 + r - 31) >> 4) - n0t - 4 * hh, a2 = 254 - n0t - 4 * hh;
            imp_tile(KT, Qf, mfin, linv, slope2 * (float)(16 * n0t + 31 - t0) + slope2 * 64.f * (float)hh, slope2 * 16.f, a1 < a2 ? a1 : a2, n0t, IMP, r, hh);
        }
        __syncthreads();
        {
            const int q = (tid >> 3) & 31, oct = tid & 7;
            unsigned mykey[8];
#pragma unroll
            for (int jj = 0; jj < 8; ++jj) { const int j = oct * 8 + jj; unsigned vv = IMP[q * 65 + j]; vv = vv > 0x3fffffeu ? 0x3fffffeu : vv;
                const bool forced = (j == 0) || (j == i) || (j == i - 1);
                mykey[jj] = (j <= i) ? (((forced ? 0x3ffffffu : vv) << 6) | (unsigned)(63 - j)) : 0u; }
            __syncthreads();
            if (tid < 256) {
#pragma unroll
                for (int jj = 0; jj < 8; ++jj) IMP[q * 65 + oct * 8 + jj] = mykey[jj]; }
            __syncthreads();
            unsigned rank[8] = {0, 0, 0, 0, 0, 0, 0, 0};
            for (int j2 = 0; j2 < 64; ++j2) { const unsigned kk = IMP[q * 65 + j2];
#pragma unroll
                for (int jj = 0; jj < 8; ++jj) rank[jj] += (kk > mykey[jj]) ? 1u : 0u; }
            unsigned byte = 0;
#pragma unroll
            for (int jj = 0; jj < 8; ++jj) byte |= ((oct * 8 + jj <= i) && rank[jj] < 16u) ? (1u << jj) : 0u;
            if (tid < 256) SELB[q * 8 + oct] = (unsigned char)byte;
        }
        __syncthreads();
        unsigned long long selm, uni;
        { TZ_LANE
          selm = *(const LAS unsigned long long*)(SELB + 8 * r);
          unsigned ulo = (unsigned)selm, uhi = (unsigned)(selm >> 32);
#pragma unroll
          for (int o = 1; o < 32; o <<= 1) { ulo |= __shfl_xor(ulo, o); uhi |= __shfl_xor(uhi, o); }
          uni = ((unsigned long long)(unsigned)__builtin_amdgcn_readfirstlane(uhi) << 32) | (unsigned)__builtin_amdgcn_readfirstlane(ulo); }
        const bf16* ksb = KS + (size_t)bg * SEQ * 64; const bf16* vsb = VST + (size_t)bg * 64 * SEQ;
        for (int j = 0; j <= i; ++j) {
            if (!((uni >> j) & 1ull)) continue;
            TZ_LANE
            __syncthreads();
            load_kv_tile(KT, VT, ksb + (size_t)j * 64 * 64, vsb + j * 64, SEQ, tz, true);
            __syncthreads();
            const int lh = ((selm >> j) & 1ull) ? (j == i ? q0 + r - 4 * hh : 1000) : -1000;
            attn_tile(KT, VT, Qf, O, mrun, lrun, slope2 * (float)(64 * j - t0) + slope2 * 4.f * (float)hh, slope2, lh, -1000, r, hh);
        }
        OUT_ACC(gate[1] / fmaxf(lrun, 1e-30f), false);
        mrun = -1e30f; lrun = 0.f;
        const bf16* kwb = KW + (size_t)bg * SEQ * 64; const bf16* vwb = VWT + (size_t)bg * 64 * SEQ;
        for (int j = (i > 8 ? i - 8 : 0); j <= i; ++j) {
            TZ_LANE
            __syncthreads();
            load_kv_tile(KT, VT, kwb + (size_t)j * 64 * 64, vwb + j * 64, SEQ, tz, true);
            __syncthreads();
            const int lh = (j == i) ? q0 + r - 4 * hh : 1000, ll = (j == i - 8) ? q0 + r - 4 * hh : -1000;
            attn_tile(KT, VT, Qf, O, mrun, lrun, slope2 * (float)(64 * j - t0) + slope2 * 4.f * (float)hh, slope2, lh, ll, r, hh);
        }
        OUT_ACC(gate[2] / fmaxf(lrun, 1e-30f), false);
        { TZ_LANE
          bf16* op = OB + ((size_t)b * SEQ + t0 + q0 + r) * 1024 + h * 64;
#pragma unroll
          for (int dt = 0; dt < 2; ++dt)
#pragma unroll
              for (int q4 = 0; q4 < 4; ++q4) { v2u o; o.x = OUTP[dt][2 * q4]; o.y = OUTP[dt][2 * q4 + 1]; *(v2u*)(op + 32 * dt + 8 * q4 + 4 * hh) = o; } }
    }
    __syncthreads();
#undef OUT_ACC
}

struct Args { const float* in[32]; float* out; unsigned char* ws; int ph_lo, ph_hi; };
constexpr int N_PHASES = 35;

__global__ void __launch_bounds__(NWAVES * 64, 2) trunk_fwd(Args args) {
    extern __shared__ __attribute__((aligned(16))) unsigned char lds[];
    Frame F;
    F.lds = (LAS unsigned char*)lds;
    F.tid = threadIdx.x; F.lane = F.tid & 63; F.wave = __builtin_amdgcn_readfirstlane(F.tid >> 6);
    F.G = gridDim.x; { const int bx = blockIdx.x; F.vcu = (F.G % 8 == 0) ? (bx % 8) * (F.G / 8) + bx / 8 : bx; }
    F.ws = args.ws;
    unsigned char* ws = args.ws;
    volatile LAS unsigned* MISC = (volatile LAS unsigned*)(F.lds + LDSCTL_OFF);
    for (int u = F.tid; u < (LDS_BYTES - LDSCTL_OFF) / 4; u += NWAVES * 64) ((LAS unsigned*)(F.lds + LDSCTL_OFF))[u] = 0u;
    __syncthreads();
    XcdBarrier bar = xcd_barrier_post((unsigned*)(ws + WS_CTL) + CW_BAR, MISC + 8);

    const int lo = args.ph_lo, hi = args.ph_hi;
#ifndef PHMASK
#define PHMASK 0xFFFFFFFFFFFFFFFFull
#endif
#define INR(k) ((((PHMASK) >> (k)) & 1ull) && lo <= (k) && (k) < hi)
#define IN(k) (INR(k) && frame_refresh(F))
#define SEAM(k) do { if (INR(k) && INR((k) + 1)) xcd_barrier(bar); } while (0)
    const float* const* in = args.in;
    float* xout = args.out;
    bf16* Hb = (bf16*)(ws + WS_H); bf16* BIG = (bf16*)(ws + WS_BIG);
    bf16* Wi = (bf16*)(ws + WS_WIN); bf16* Wo = (bf16*)(ws + WS_WOUT); bf16* Wu = (bf16*)(ws + WS_WUP); bf16* Wd = (bf16*)(ws + WS_WDN);
    LAS unsigned char* ring = F.lds + RING_OFF;

#define CONV_MLP(L, base) do { conv_w(F, base, in[5] + (size_t)(L) * D * FF, D, FF, 0, FF, FF, Wu, D, 0, 1.f); conv_w(F, base, in[6] + (size_t)(L) * FF * D, FF, D, 0, D, D, Wd, FF, 0, 1.f); } while (0)
#define GEMM_PHASE(EPI, Aptr, LDA, Bptr, LDB, NN, KK, APN, E) do { pg8::Gemm g{(const pg8::bf16_t*)(Aptr), (const pg8::bf16_t*)(Bptr), M, (NN), (KK), (LDA), (LDB), (size_t)(APN)}; \
        pg8::StaticOrder S; S.init(M, (NN), F.G, (int)blockIdx.x); pg8::gemm_phase<EPI, pg8::StaticOrder, true, true>(ring, g, S, E); } while (0)
#define MLP_PHASES(P0, L) \
    if (IN(P0)) { pg8::EpiStore<1> E{BIG, FF}; GEMM_PHASE(pg8::EpiStore<1>, Hb, D, Wu, D, FF, D, 0, E); } SEAM(P0); \
    if (IN((P0) + 1)) { pg8::EpiStore<0> E{Hb, D}; GEMM_PHASE(pg8::EpiStore<0>, BIG, FF, Wd, FF, D, FF, 0, E); } SEAM((P0) + 1);

    if (IN(0)) {
        int base = 0;
        conv_w(F, base, in[7], D, 6144, 0, 6144, 6144, Wi, D, 0, 1.f);
        conv_w(F, base, in[9], 2048, D, 0, D, D, Wo, 2048, 0, 1.f);
        CONV_MLP(0, base);
        norm_phase(F, in[0], nullptr, nullptr, Hb, nullptr, in[1]);
    }
    SEAM(0);
    if (IN(1)) { pg8::EpiStore<0> E{BIG, 6144}; GEMM_PHASE(pg8::EpiStore<0>, Hb, D, Wi, D, 6144, D, 0, E); }
    SEAM(1);
    if (IN(2)) recur_phase<256, 512, 64, false>(F, BIG, 6144, 0, 1024, 2048, 0, 0.0625f);
    SEAM(2);
    if (IN(3)) hn_phase<512, true>(F, BIG, 6144, 2048, 4096, in[8]);
    SEAM(3);
    if (IN(4)) { pg8::EpiStore<0> E{Hb, D}; GEMM_PHASE(pg8::EpiStore<0>, BIG + 2048, 6144, Wo, 2048, D, 2048, 0, E); }
    SEAM(4);
    if (IN(5)) norm_phase(F, in[0], Hb, xout, Hb, in[2], in[3]);
    SEAM(5);
    MLP_PHASES(6, 0)
    if (IN(8)) {
        norm_phase(F, xout, Hb, xout, Hb, in[4], in[1] + D);
        int base = 0;
        conv_w(F, base, in[10], D, 3088, 0, 512, 3088, Wi, D, 0, 0.08838834764831845f);
        conv_w(F, base, in[10], D, 3088, 512, 2560, 3088, Wi, D, 512, 1.f);
        {
            const int gw = F.vcu * NWAVES + F.wave, NGW = F.G * NWAVES;
            for (int itx = gw; itx < 16 * 16; itx += NGW) {
                const int kb = itx >> 4, cb = itx & 15, k = kb * 64 + F.lane;
                float wv[16];
#pragma unroll
                for (int r = 0; r < 16; ++r) wv[r] = in[10][(size_t)k * 3088 + 3072 + r];
                for (int c = cb * 32; c < cb * 32 + 32; ++c) { float s = 0.f;
#pragma unroll
                    for (int r = 0; r < 16; ++r) s += wv[r] * in[11][r * 512 + c];
                    Wi[(size_t)(3072 + c) * D + k] = (bf16)f2bf(s); }
            }
        }
        conv_w(F, base, in[14], D, D, 0, D, D, Wo, D, 0, 1.f);
        CONV_MLP(1, base);
    }
    SEAM(8);
    if (IN(9)) { pg8::EpiGla E{BIG, 3584, in[12]}; GEMM_PHASE(pg8::EpiGla, Hb, D, Wi, D, 3584, D, 0, E); }
    SEAM(9);
    if (IN(10)) recur_phase<128, 256, 32, true>(F, BIG, 3584, 0, 512, 1024, 3072, 1.f);
    SEAM(10);
    if (IN(11)) hn_phase<256, false>(F, BIG, 3584, 1024, 2048, in[13]);
    SEAM(11);
    if (IN(12)) { pg8::EpiStore<0> E{Hb, D}; GEMM_PHASE(pg8::EpiStore<0>, BIG + 1024, 3584, Wo, D, D, D, 0, E); }
    SEAM(12);
    if (IN(13)) norm_phase(F, xout, Hb, xout, Hb, in[2] + D, in[3] + D);
    SEAM(13);
    MLP_PHASES(14, 1)
    if (IN(16)) {
        norm_phase(F, xout, Hb, xout, Hb, in[4] + D, in[1] + 2 * D);
        int base = 0;
        conv_w(F, base, in[15], D, 2048, 0, 2048, 2048, Wi, D, 0, 1.f);
        conv_w(F, base, in[23], D, D, 0, D, D, Wo, D, 0, 1.f);
        bf16* LW = (bf16*)(ws + SM_LRUW);
        for (int n = 0; n < 8; ++n) { conv_w(F, base, in[18] + n * 16384, 128, 128, 0, 128, 128, LW + n * 32768, 128, 0, 1.f); conv_w(F, base, in[20] + n * 16384, 128, 128, 0, 128, 128, LW + n * 32768, 128, 128, 1.f); }
        CONV_MLP(2, base);
    }
    SEAM(16);
    if (IN(17)) { pg8::EpiStore<0> E{(bf16*)(ws + LRU_XY), 2048}; GEMM_PHASE(pg8::EpiStore<0>, Hb, D, Wi, D, 2048, D, 0, E); }
    SEAM(17);
    if (IN(18)) lru_conv_phase(F, (const bf16*)(ws + LRU_XY), (bf16*)(ws + LRU_XC), in[16], in[17]);
    SEAM(18);
    if (IN(19)) { pg8::EpiStore<0> E{(bf16*)(ws + LRU_GP), 2048}; GEMM_PHASE(pg8::EpiStore<0>, ws + LRU_XC, D, ws + SM_LRUW, 128, 2048, 128, 256, E); }
    SEAM(19);
    if (IN(20)) lru_scan_phase<0>(F, (const bf16*)(ws + LRU_GP), (const bf16*)(ws + LRU_XC), (const bf16*)(ws + LRU_XY), (float*)(ws + SM_SCANP), (float*)(ws + SM_SCANE), (bf16*)(ws + LRU_HS), in[19], in[21], in[22]);
    SEAM(20);
    if (IN(21)) lru_scan_phase<1>(F, (const bf16*)(ws + LRU_GP), (const bf16*)(ws + LRU_XC), (const bf16*)(ws + LRU_XY), (float*)(ws + SM_SCANP), (float*)(ws + SM_SCANE), (bf16*)(ws + LRU_HS), in[19], in[21], in[22]);
    SEAM(21);
    if (IN(22)) { pg8::EpiStore<0> E{Hb, D}; GEMM_PHASE(pg8::EpiStore<0>, ws + LRU_HS, D, Wo, D, D, D, 0, E); }
    SEAM(22);
    if (IN(23)) norm_phase(F, xout, Hb, xout, Hb, in[2] + 2 * D, in[3] + 2 * D);
    SEAM(23);
    MLP_PHASES(24, 2)
    if (IN(26)) {
        norm_phase(F, xout, Hb, xout, Hb, in[4] + 2 * D, in[1] + 3 * D);
        int base = 0;
        conv_w(F, base, in[24], D, 1840, 0, 1024, 1840, Wi, D, 0, 0.125f * LOG2E);
        conv_w(F, base, in[24], D, 1840, 1024, 1024, 1840, Wi, D, 1024, 1.f);
        conv_w(F, base, in[31], D, D, 0, D, D, Wo, D, 0, 1.f);
        conv_w(F, base, in[26], 2048, 128, 0, 128, 128, (bf16*)(ws + SM_W1K), 2048, 0, 1.f);
        conv_w(F, base, in[29], 2048, 128, 0, 128, 128, (bf16*)(ws + SM_W1V), 2048, 0, 1.f);
        conv_w(F, base, in[27], 128, 64, 0, 64, 64, (bf16*)(ws + SM_W2K), 128, 0, 1.f);
        conv_w(F, base, in[30], 128, 64, 0, 64, 64, (bf16*)(ws + SM_W2V), 128, 0, 1.f);
        CONV_MLP(3, base);
        for (int itx = F.vcu; itx < 4; itx += F.G) {
            const int kv = itx >> 1, c = (itx & 1) * 64 + F.lane;
            const float* pe = kv ? in[28] : in[25]; const float* w1 = kv ? in[29] : in[26];
            float s = 0.f;
            for (int i2 = F.wave * 256; i2 < F.wave * 256 + 256; ++i2) s += pe[i2] * w1[(size_t)i2 * 128 + c];
            LAS float* red = (LAS float*)(F.lds + 8 * 8704);
            __syncthreads();
            red[F.wave * 64 + F.lane] = s;
            __syncthreads();
            if (F.wave == 0) { float tsum = 0.f;
#pragma unroll
                for (int w2 = 0; w2 < 8; ++w2) tsum += red[w2 * 64 + F.lane];
                ((float*)(ws + SM_PEB))[kv * 128 + c] = tsum; }
        }
    }
    SEAM(26);
    if (IN(27)) { pg8::EpiNsa E{(bf16*)(ws + NSA_Q), (bf16*)(ws + NSA_KC), (bf16*)(ws + NSA_VC), (bf16*)(ws + NSA_KS), (bf16*)(ws + NSA_VST), (bf16*)(ws + NSA_KW), (bf16*)(ws + NSA_VWT), (float*)(ws + SM_GATES)};
        GEMM_PHASE(pg8::EpiNsa, Hb, D, Wi, D, 2048, D, 0, E); }
    SEAM(27);
    if (IN(28)) nsa_compress_phase(F, (const bf16*)(ws + NSA_KC), (const bf16*)(ws + NSA_VC), (const bf16*)(ws + SM_W1K), (const bf16*)(ws + SM_W1V), (const bf16*)(ws + SM_W2K), (const bf16*)(ws + SM_W2V),
                                   (const float*)(ws + SM_PEB), (bf16*)(ws + SM_KCMP), (bf16*)(ws + SM_VCMPT));
    SEAM(28);
    if (IN(29)) nsa_attn_phase(F, (const bf16*)(ws + NSA_Q), (const bf16*)(ws + SM_KCMP), (const bf16*)(ws + SM_VCMPT), (const bf16*)(ws + NSA_KS), (const bf16*)(ws + NSA_VST), (const bf16*)(ws + NSA_KW), (const bf16*)(ws + NSA_VWT),
                               (const float*)(ws + SM_GATES), (bf16*)(ws + NSA_O));
    SEAM(29);
    if (IN(30)) { pg8::EpiStore<0> E{Hb, D}; GEMM_PHASE(pg8::EpiStore<0>, ws + NSA_O, D, Wo, D, D, D, 0, E); }
    SEAM(30);
    if (IN(31)) norm_phase(F, xout, Hb, xout, Hb, in[2] + 3 * D, in[3] + 3 * D);
    SEAM(31);
    MLP_PHASES(32, 3)
    if (IN(34)) norm_phase(F, xout, Hb, xout, nullptr, in[4] + 3 * D, nullptr);
#undef IN
#undef SEAM
}

#ifndef MK_PER_PHASE
#define MK_PER_PHASE 1
#endif
extern "C" void kernel_launch(void* const* d_in, const int* in_sizes, int n_in, void* d_out, int out_size, void* d_ws, size_t ws_size, hipStream_t stream) {
    static int grid = 0;
    if (grid == 0) {
        if (n_in != 32 || in_sizes[0] != M * D || out_size != M * D || ws_size < WS_END) { fprintf(stderr, "kernel_launch: unexpected shapes / workspace (n_in %d, ws %zu); nothing launched\n", n_in, ws_size); grid = -1; return; }
        int dev = 0, cus = 0, per_cu = 0;
        if (hipGetDevice(&dev) != hipSuccess || hipDeviceGetAttribute(&cus, hipDeviceAttributeMultiprocessorCount, dev) != hipSuccess) { grid = -1; return; }
        if (hipFuncSetAttribute((const void*)trunk_fwd, hipFuncAttributeMaxDynamicSharedMemorySize, LDS_BYTES) != hipSuccess) { fprintf(stderr, "kernel_launch: hipFuncSetAttribute failed\n"); grid = -1; return; }
        if (hipOccupancyMaxActiveBlocksPerMultiprocessor(&per_cu, (const void*)trunk_fwd, NWAVES * 64, LDS_BYTES) != hipSuccess || per_cu < 1)
            fprintf(stderr, "kernel_launch: note: occupancy query reports %d workgroups per CU\n", per_cu);
        (void)hipGetLastError();
        grid = cus;
    }
    if (grid < 0) return;
    if (hipMemsetAsync((char*)d_ws + WS_CTL, 0, CTL_ZERO_BYTES, stream) != hipSuccess) return;
    Args a{};
    for (int i = 0; i < 32; ++i) a.in[i] = (const float*)d_in[i];
    a.out = (float*)d_out; a.ws = (unsigned char*)d_ws;
#if MK_PER_PHASE
    for (int p = 0; p < N_PHASES; ++p) { a.ph_lo = p; a.ph_hi = p + 1; hipLaunchKernelGGL(trunk_fwd, dim3(grid), dim3(NWAVES * 64), LDS_BYTES, stream, a); }
#else
    a.ph_lo = 0; a.ph_hi = N_PHASES;
    hipLaunchKernelGGL(trunk_fwd, dim3(grid), dim3(NWAVES * 64), LDS_BYTES, stream, a);
#endif
}
```

```cpp
#include <hip/hip_runtime.h>
#include <cstdio>
#include <cstdint>
#include <cmath>

namespace pg8 {
#define PG8_LAS __attribute__((address_space(3)))
typedef unsigned short bf16_t;
typedef short bf16x8 __attribute__((ext_vector_type(8)));
typedef float f32x4 __attribute__((ext_vector_type(4)));
typedef unsigned u32x4 __attribute__((ext_vector_type(4)));
typedef unsigned u32x2 __attribute__((ext_vector_type(2)));
constexpr int BM = 256, BK = 64, HALF = 128, HTB = HALF * BK * 2  , STAGE_BYTES = 8 * HTB, NXCD = 8, WGM = 8;

__host__ __device__ __forceinline__ int lds_byte(int r, int c) { const int st = (r >> 4) * 2 + (c >> 5), rr = r & 15, cc = c & 31, ob = rr * 64 + cc * 2; return st * 1024 + (ob ^ (((ob >> 9) & 1) << 5)); }
__host__ __device__ __forceinline__ void stage_rc(int b, int& R, int& C) { const int st = b / 1024, sb = b % 1024, swz = sb ^ (((sb >> 9) & 1) << 5); R = (st >> 1) * 16 + swz / 64; C = (st & 1) * 32 + (swz % 64) / 2; }
__host__ __device__ __forceinline__ int perm32(int rho) { const int n = rho >> 4, i = rho & 15; return 8 * (i >> 2) + 4 * n + (i & 3); }

struct Unit { int pm, pn; };
struct Gemm { const bf16_t* A; const bf16_t* Bt; int M, N, K, lda, ldb; size_t a_pn_step; };

struct StaticOrder {
    int nM, nN, nwg, G, c;
    __host__ __device__ void init(int M, int N, int G_, int c_) { nM = M / BM; nN = N / BM; nwg = nM * nN; G = G_; c = c_; }
    __host__ __device__ bool next(int i, Unit& u) const {
        const long L = (long)i * G + c; if (L >= nwg) return false;
        int wgid = (int)L; { const int q = nwg / NXCD, r = nwg % NXCD, xcd = wgid % NXCD, off = wgid / NXCD; wgid = (xcd < r ? xcd * (q + 1) : r * (q + 1) + (xcd - r) * q) + off; }
        const int nig = WGM * nN, gid = wgid / nig, fm = gid * WGM, gsz = (nM - fm) < WGM ? (nM - fm) : WGM;
        u.pm = fm + ((wgid % nig) % gsz); u.pn = (wgid % nig) / gsz; return true;
    }
    __device__ __forceinline__ void a_ready(const Unit&) const {}
    __device__ __forceinline__ void done(const Unit&) const {}
};

__device__ __forceinline__ unsigned cvt_pk_bf16(float lo, float hi) { unsigned r; asm volatile("v_cvt_pk_bf16_f32 %0, %1, %2" : "=v"(r) : "v"(lo), "v"(hi)); return r; }
__device__ __forceinline__ u32x4 pack8(const f32x4 v0, const f32x4 v1) { u32x4 w; w.x = cvt_pk_bf16(v0[0], v0[1]); w.y = cvt_pk_bf16(v0[2], v0[3]); w.z = cvt_pk_bf16(v1[0], v1[1]); w.w = cvt_pk_bf16(v1[2], v1[3]); return w; }
__device__ __forceinline__ float bf_lo(unsigned w) { return __uint_as_float(w << 16); }
__device__ __forceinline__ float bf_hi(unsigned w) { return __uint_as_float(w & 0xffff0000u); }

template <int ACT> struct EpiStore {
    static constexpr bool PERM = true, AFTER_DRAIN = false;
    bf16_t* O; int ldc;
    __device__ __forceinline__ void operator()(const f32x4 (&acc)[2][2][4][2], const Unit& u, int wr, int wc, int fr, int fq) const {
        const int row0 = u.pm * BM + wr * 64 + fr, col0 = u.pn * BM + wc * 32 + 8 * fq;
#pragma unroll
        for (int ai = 0; ai < 2; ++ai)
#pragma unroll
            for (int m = 0; m < 4; ++m) { bf16_t* rowp = O + (size_t)(row0 + ai * HALF + m * 16) * ldc + col0;
#pragma unroll
                for (int bj = 0; bj < 2; ++bj) { f32x4 v0 = acc[ai][bj][m][0], v1 = acc[ai][bj][m][1];
                    if (ACT == 1) {
#pragma unroll
                        for (int e = 0; e < 4; ++e) { const float a = fmaxf(v0[e], 0.f), b = fmaxf(v1[e], 0.f); v0[e] = a * a; v1[e] = b * b; } }
                    *(u32x4*)(rowp + bj * HALF) = pack8(v0, v1); } }
    }
};

struct EpiGla {
    static constexpr bool PERM = true, AFTER_DRAIN = false;
    bf16_t* O; int ldc; const float* bgate;
    __device__ __forceinline__ void operator()(const f32x4 (&acc)[2][2][4][2], const Unit& u, int wr, int wc, int fr, int fq) const {
        const int row0 = u.pm * BM + wr * 64 + fr, col0 = u.pn * BM + wc * 32 + 8 * fq;
        const bool gate = u.pn >= 12;
        f32x4 bv[2][2];
#pragma unroll
        for (int bj = 0; bj < 2; ++bj)
#pragma unroll
            for (int n = 0; n < 2; ++n) bv[bj][n] = gate ? *(const f32x4*)(bgate + (col0 - 3072) + bj * HALF + 4 * n) : (f32x4){0.f, 0.f, 0.f, 0.f};
#pragma unroll
        for (int ai = 0; ai < 2; ++ai)
#pragma unroll
            for (int m = 0; m < 4; ++m) { bf16_t* rowp = O + (size_t)(row0 + ai * HALF + m * 16) * ldc + col0;
#pragma unroll
                for (int bj = 0; bj < 2; ++bj) { f32x4 v0 = acc[ai][bj][m][0], v1 = acc[ai][bj][m][1];
                    if (gate) {
#pragma unroll
                        for (int e = 0; e < 4; ++e) {
                            const float z0 = v0[e] + bv[bj][0][e], z1 = v1[e] + bv[bj][1][e];
                            v0[e] = (fminf(z0, 0.f) - log1pf(__expf(-fabsf(z0)))) * 0.0625f;
                            v1[e] = (fminf(z1, 0.f) - log1pf(__expf(-fabsf(z1)))) * 0.0625f; } }
                    *(u32x4*)(rowp + bj * HALF) = pack8(v0, v1); } }
    }
};

struct EpiNsa {
    static constexpr bool PERM = true, AFTER_DRAIN = false;
    bf16_t* Q; bf16_t* KC; bf16_t* VC; bf16_t* KS; bf16_t* VST; bf16_t* KW; bf16_t* VWT; float* GATES;
    template <bool VTRANS> __device__ __forceinline__ void kv_store(const f32x4 (&acc)[2][2][4][2], bf16_t* Kt, bf16_t* Vt, int row0, int c8) const {
        const int g = c8 >> 6, d = c8 & 63;
#pragma unroll
        for (int ai = 0; ai < 2; ++ai)
#pragma unroll
            for (int m = 0; m < 4; ++m) {
                const int row = row0 + ai * HALF + m * 16, b = row >> 12, t = row & 4095;
                const size_t bg = (size_t)(b * 2 + g);
                *(u32x4*)(Kt + (bg * 4096 + t) * 64 + d) = pack8(acc[ai][0][m][0], acc[ai][0][m][1]);
                const u32x4 w = pack8(acc[ai][1][m][0], acc[ai][1][m][1]);
                if (!VTRANS) *(u32x4*)(Vt + (bg * 4096 + t) * 64 + d) = w;
                else {
                    bf16_t* vp = Vt + (bg * 64 + d) * 4096 + t;
                    vp[0 * 4096] = (bf16_t)(w.x & 0xffffu); vp[1 * 4096] = (bf16_t)(w.x >> 16);
                    vp[2 * 4096] = (bf16_t)(w.y & 0xffffu); vp[3 * 4096] = (bf16_t)(w.y >> 16);
                    vp[4 * 4096] = (bf16_t)(w.z & 0xffffu); vp[5 * 4096] = (bf16_t)(w.z >> 16);
                    vp[6 * 4096] = (bf16_t)(w.w & 0xffffu); vp[7 * 4096] = (bf16_t)(w.w >> 16);
                }
            }
    }
    __device__ __forceinline__ void operator()(const f32x4 (&acc)[2][2][4][2], const Unit& u, int wr, int wc, int fr, int fq) const {
        const int row0 = u.pm * BM + wr * 64 + fr, c8 = wc * 32 + 8 * fq;
        if (u.pn < 4) {
#pragma unroll
            for (int ai = 0; ai < 2; ++ai)
#pragma unroll
                for (int m = 0; m < 4; ++m) { bf16_t* rowp = Q + (size_t)(row0 + ai * HALF + m * 16) * 1024 + u.pn * BM + c8;
#pragma unroll
                    for (int bj = 0; bj < 2; ++bj) *(u32x4*)(rowp + bj * HALF) = pack8(acc[ai][bj][m][0], acc[ai][bj][m][1]); }
        } else if (u.pn == 4) { kv_store<false>(acc, KC, VC, row0, c8);
        } else if (u.pn == 5) { kv_store<true>(acc, KS, VST, row0, c8);
        } else if (u.pn == 6) { kv_store<true>(acc, KW, VWT, row0, c8);
        } else {
            if (c8 < 48) {
#pragma unroll
                for (int ai = 0; ai < 2; ++ai)
#pragma unroll
                    for (int m = 0; m < 4; ++m) { float* gp = GATES + (size_t)(row0 + ai * HALF + m * 16) * 48 + c8;
                        f32x4 v0 = acc[ai][0][m][0], v1 = acc[ai][0][m][1];
#pragma unroll
                        for (int e = 0; e < 4; ++e) { v0[e] = 1.f / (1.f + __expf(-v0[e])); v1[e] = 1.f / (1.f + __expf(-v1[e])); }
                        *(f32x4*)gp = v0; *(f32x4*)(gp + 4) = v1; }
            }
        }
    }
};

template <class Epi, class Sched, bool ALIGN_EPI = false, bool SP2 = false>
__device__ __forceinline__ void gemm_phase(PG8_LAS unsigned char* lds, const Gemm g, const Sched& S, const Epi& E) {
    const int tid = threadIdx.x, wid = __builtin_amdgcn_readfirstlane(tid >> 6), lane = tid & 63, wr = wid >> 2, wc = wid & 3, fr = lane & 15, fq = lane >> 4;
    const int K = g.K, nt = K / BK;
    unsigned voffA[2], voffB[2];
#pragma unroll
    for (int i = 0; i < 2; ++i) { int R, C; stage_rc(tid * 16 + i * 8192, R, C); const int Rb = Epi::PERM ? ((R & ~31) + perm32(R & 31)) : R;
        voffA[i] = (unsigned)(R * g.lda + C) * 2u; voffB[i] = (unsigned)(Rb * g.ldb + C) * 2u; }
    const size_t kstep = (size_t)(BK * 2);
    const size_t hstepA = (size_t)HALF * g.lda * 2, hstepB = (size_t)HALF * g.ldb * 2;
    const size_t tstepA = 2 * hstepA, tstepB = 2 * hstepB;
    const unsigned ldsw = (unsigned)wid * 1024u;
    const int aoff = lds_byte(wr * 64 + fr, fq * 8), boff = lds_byte(wc * 32 + fr, fq * 8);
#define PG8_SA(b, h) (((b) * 2 + (h)) * HTB)
#define PG8_SB(b, h) ((4 + (b) * 2 + (h)) * HTB)
#define PG8_STAGE(bufoff, gbase, voff) do { _Pragma("unroll") for (int _i = 0; _i < 2; ++_i) \
        __builtin_amdgcn_global_load_lds((const unsigned*)((const char*)(gbase) + (voff)[_i]), (PG8_LAS unsigned*)(lds + (bufoff) + ldsw + _i * 8192), 16, 0, 0); } while (0)
#define PG8_LDA(dst, b, h) do { _Pragma("unroll") for (int m = 0; m < 4; ++m) _Pragma("unroll") for (int k = 0; k < 2; ++k) dst[m][k] = *(const PG8_LAS bf16x8*)(lds + PG8_SA(b, h) + aoff + m * 2048 + k * 1024); } while (0)
#define PG8_LDB(dst, b, h) do { _Pragma("unroll") for (int n = 0; n < 2; ++n) _Pragma("unroll") for (int k = 0; k < 2; ++k) dst[n][k] = *(const PG8_LAS bf16x8*)(lds + PG8_SB(b, h) + boff + n * 2048 + k * 1024); } while (0)
#define PG8_MMA(ai, bj, At, Bt) do { __builtin_amdgcn_s_setprio(1); _Pragma("unroll") for (int m = 0; m < 4; ++m) _Pragma("unroll") for (int n = 0; n < 2; ++n) _Pragma("unroll") for (int k = 0; k < 2; ++k) \
        acc[ai][bj][m][n] = __builtin_amdgcn_mfma_f32_16x16x32_bf16(Bt[n][k], At[m][k], acc[ai][bj][m][n], 0, 0, 0); __builtin_amdgcn_s_setprio(0); } while (0)
#define PG8_WAIT_V(n) asm volatile("s_waitcnt vmcnt(" #n ")" ::: "memory")
#define PG8_WAIT_L(n) asm volatile("s_waitcnt lgkmcnt(" #n ")" ::: "memory")
#define PG8_BAR __builtin_amdgcn_s_barrier()
#define PG8_SCHED __builtin_amdgcn_sched_barrier(0)
    Unit cur, nxt; int ui = 0;
    if (!S.next(0, cur)) return;
    f32x4 acc[2][2][4][2];
#pragma unroll
    for (int a = 0; a < 2; ++a)
#pragma unroll
        for (int b = 0; b < 2; ++b)
#pragma unroll
            for (int m = 0; m < 4; ++m)
#pragma unroll
                for (int n = 0; n < 2; ++n) acc[a][b][m][n] = (f32x4){0.f, 0.f, 0.f, 0.f};
    bf16x8 At[4][2], B0[2][2], B1[2][2];
    const char* cA = (const char*)g.A + (size_t)cur.pm * tstepA + (size_t)cur.pn * g.a_pn_step; const char* cB = (const char*)g.Bt + (size_t)cur.pn * tstepB;
    S.a_ready(cur);
    if constexpr (SP2) {
        PG8_STAGE(PG8_SB(0, 0), cB, voffB); PG8_STAGE(PG8_SB(0, 1), cB + hstepB, voffB); PG8_STAGE(PG8_SA(0, 0), cA, voffA); PG8_STAGE(PG8_SA(0, 1), cA + hstepA, voffA);
        if (wr == 1) PG8_BAR;
        PG8_WAIT_V(2); PG8_BAR;
        PG8_STAGE(PG8_SB(1, 0), cB + kstep, voffB); PG8_STAGE(PG8_SA(1, 0), cA + kstep, voffA); PG8_STAGE(PG8_SB(1, 1), cB + hstepB + kstep, voffB);
        PG8_WAIT_V(6); PG8_BAR;
    } else {
        PG8_STAGE(PG8_SB(0, 0), cB, voffB); PG8_STAGE(PG8_SA(0, 0), cA, voffA); PG8_STAGE(PG8_SB(0, 1), cB + hstepB, voffB); PG8_STAGE(PG8_SA(0, 1), cA + hstepA, voffA);
        if (wr == 1) PG8_BAR;
        PG8_WAIT_V(4); PG8_BAR;
        PG8_STAGE(PG8_SB(1, 0), cB + kstep, voffB); PG8_STAGE(PG8_SA(1, 0), cA + kstep, voffA); PG8_STAGE(PG8_SB(1, 1), cB + hstepB + kstep, voffB);
        PG8_WAIT_V(6); PG8_BAR;
    }
    for (;;) {
        const bool has_next = S.next(ui + 1, nxt);
        const char* nA = has_next ? (const char*)g.A + (size_t)nxt.pm * tstepA + (size_t)nxt.pn * g.a_pn_step : cA; const char* nB = has_next ? (const char*)g.Bt + (size_t)nxt.pn * tstepB : cB;
        for (int t = 0; t < nt; t += 2) {
            const bool last = (t == nt - 2);
            const char* a1 = cA + (size_t)(t + 1) * kstep;
            const char* a2 = last ? nA : cA + (size_t)(t + 2) * kstep; const char* b2 = last ? nB : cB + (size_t)(t + 2) * kstep;
            const char* a3 = a2 + kstep; const char* b3 = b2 + kstep;
            if (last && has_next) S.a_ready(nxt);
            if constexpr (SP2) {
            PG8_LDB(B0, 0, 0); PG8_LDB(B1, 0, 1); PG8_SCHED; PG8_LDA(At, 0, 0); PG8_STAGE(PG8_SA(1, 1), a1 + hstepA, voffA);
            PG8_WAIT_V(8); PG8_WAIT_L(0); PG8_BAR; PG8_MMA(0, 0, At, B0); PG8_MMA(0, 1, At, B1); PG8_BAR; PG8_SCHED;
            PG8_LDA(At, 0, 1); PG8_STAGE(PG8_SB(0, 0), b2, voffB); PG8_STAGE(PG8_SB(0, 1), b2 + hstepB, voffB); PG8_STAGE(PG8_SA(0, 0), a2, voffA);
            PG8_WAIT_V(8); PG8_WAIT_L(0); PG8_BAR; PG8_MMA(1, 0, At, B0); PG8_MMA(1, 1, At, B1); PG8_BAR; PG8_SCHED;
            PG8_LDB(B0, 1, 0); PG8_LDB(B1, 1, 1); PG8_SCHED; PG8_LDA(At, 1, 0); PG8_STAGE(PG8_SA(0, 1), a2 + hstepA, voffA);
            PG8_WAIT_V(8); PG8_WAIT_L(0); PG8_BAR; PG8_MMA(0, 0, At, B0); PG8_MMA(0, 1, At, B1); PG8_BAR; PG8_SCHED;
            PG8_LDA(At, 1, 1); PG8_STAGE(PG8_SB(1, 0), b3, voffB); PG8_STAGE(PG8_SB(1, 1), b3 + hstepB, voffB); PG8_STAGE(PG8_SA(1, 0), a3, voffA);
            PG8_WAIT_V(8); PG8_WAIT_L(0); PG8_BAR; PG8_MMA(1, 0, At, B0); PG8_MMA(1, 1, At, B1); PG8_BAR; PG8_SCHED;
            } else {
            PG8_LDB(B0, 0, 0); PG8_SCHED; PG8_LDA(At, 0, 0); PG8_STAGE(PG8_SA(1, 1), a1 + hstepA, voffA);
            PG8_WAIT_L(8); PG8_BAR; PG8_WAIT_L(0); PG8_MMA(0, 0, At, B0); PG8_BAR; PG8_SCHED;
            PG8_LDB(B1, 0, 1); PG8_STAGE(PG8_SB(0, 0), b2, voffB);
            PG8_BAR; PG8_WAIT_L(0); PG8_MMA(0, 1, At, B1); PG8_BAR;
            PG8_LDA(At, 0, 1); PG8_STAGE(PG8_SA(0, 0), a2, voffA);
            PG8_BAR; PG8_WAIT_L(0); PG8_MMA(1, 0, At, B0); PG8_BAR; PG8_SCHED;
            PG8_STAGE(PG8_SB(0, 1), b2 + hstepB, voffB);
            PG8_WAIT_V(6); PG8_BAR; PG8_MMA(1, 1, At, B1); PG8_BAR;
            PG8_LDB(B0, 1, 0); PG8_SCHED; PG8_LDA(At, 1, 0); PG8_STAGE(PG8_SA(0, 1), a2 + hstepA, voffA);
            PG8_WAIT_L(8); PG8_BAR; PG8_WAIT_L(0); PG8_MMA(0, 0, At, B0); PG8_BAR; PG8_SCHED;
            PG8_LDB(B1, 1, 1); PG8_STAGE(PG8_SB(1, 0), b3, voffB);
            PG8_BAR; PG8_WAIT_L(0); PG8_MMA(0, 1, At, B1); PG8_BAR;
            PG8_LDA(At, 1, 1); PG8_STAGE(PG8_SA(1, 0), a3, voffA);
            PG8_BAR; PG8_WAIT_L(0); PG8_MMA(1, 0, At, B0); PG8_BAR; PG8_SCHED;
            PG8_STAGE(PG8_SB(1, 1), b3 + hstepB, voffB);
            PG8_WAIT_V(6); PG8_BAR; PG8_MMA(1, 1, At, B1); PG8_BAR;
            }
        }
        if constexpr (ALIGN_EPI) { if (wr == 0) PG8_BAR; }
        if constexpr (!Epi::AFTER_DRAIN) { E(acc, cur, wr, wc, fr, fq); S.done(cur); }
        if (!has_next) break;
#pragma unroll
        for (int a = 0; a < 2; ++a)
#pragma unroll
            for (int b = 0; b < 2; ++b)
#pragma unroll
                for (int m = 0; m < 4; ++m)
#pragma unroll
                    for (int n = 0; n < 2; ++n) acc[a][b][m][n] = (f32x4){0.f, 0.f, 0.f, 0.f};
        cur = nxt; cA = nA; cB = nB; ++ui;
        if constexpr (ALIGN_EPI) { if (wr == 1) PG8_BAR; }
    }
    PG8_WAIT_V(0);
    if constexpr (!ALIGN_EPI) { if (wr == 0) PG8_BAR; }
    PG8_BAR;
    if constexpr (Epi::AFTER_DRAIN) { E.fused(acc, cur, wr, wc, fr, fq, lds, wid, lane); S.done(cur); }
#undef PG8_SA
#undef PG8_SB
#undef PG8_STAGE
#undef PG8_LDA
#undef PG8_LDB
#undef PG8_MMA
#undef PG8_WAIT_V
#undef PG8_WAIT_L
#undef PG8_BAR
#undef PG8_SCHED
}
}

constexpr int BATCH = 8, SEQ = 4096, D = 1024, FF = 4096;
constexpr int M = BATCH * SEQ;
constexpr float NORM_EPS = 1e-6f;
constexpr int NWAVES = 8;
constexpr float LOG2E = 1.4426950408889634f;

constexpr size_t MiB = 1u << 20;
constexpr size_t WS_CTL = 0, CTL_ZERO_BYTES = 64 * 1024;
constexpr size_t WS_WIN = 1 * MiB, WS_WOUT = 13 * MiB, WS_WUP = 17 * MiB, WS_WDN = 25 * MiB;
constexpr size_t WS_H = 33 * MiB;
constexpr size_t WS_BIG = 97 * MiB;
constexpr size_t WS_SMALL = 481 * MiB;
constexpr size_t WS_END = 512 * MiB;
constexpr size_t SM_LRUW = WS_SMALL;
constexpr size_t SM_SCANP = WS_SMALL + 1 * MiB, SM_SCANE = WS_SMALL + 3 * MiB;
constexpr size_t SM_W1K = WS_SMALL + 5 * MiB, SM_W1V = SM_W1K + 512 * 1024;
constexpr size_t SM_W2K = WS_SMALL + 6 * MiB, SM_W2V = SM_W2K + 16 * 1024, SM_PEB = SM_W2V + 16 * 1024;
constexpr size_t SM_KCMP = WS_SMALL + 7 * MiB, SM_VCMPT = SM_KCMP + 512 * 1024;
constexpr size_t SM_GATES = WS_SMALL + 8 * MiB;
constexpr size_t LRU_XY = WS_BIG, LRU_XC = WS_BIG + 128 * MiB, LRU_GP = WS_BIG + 192 * MiB, LRU_HS = WS_BIG + 320 * MiB;
constexpr size_t NSA_Q = WS_BIG, NSA_KC = WS_BIG + 64 * MiB, NSA_VC = NSA_KC + 8 * MiB, NSA_KS = NSA_KC + 16 * MiB, NSA_VST = NSA_KC + 24 * MiB,
                 NSA_KW = NSA_KC + 32 * MiB, NSA_VWT = NSA_KC + 40 * MiB, NSA_O = WS_BIG + 128 * MiB;
constexpr int CW_BAR = 1024;

constexpr int RING_OFF = 0, SCR_BYTES = 143360;
constexpr int LDSCTL_OFF = SCR_BYTES;
constexpr int LDS_BYTES = 147456;

#define GAS __attribute__((address_space(1)))
#define LAS __attribute__((address_space(3)))
typedef unsigned short bf16;
typedef unsigned v4u __attribute__((ext_vector_type(4)));
typedef unsigned v2u __attribute__((ext_vector_type(2)));
typedef float f32x4 __attribute__((ext_vector_type(4)));
typedef float f32x2 __attribute__((ext_vector_type(2)));
typedef float f32x16 __attribute__((ext_vector_type(16)));
typedef short bf16x8 __attribute__((ext_vector_type(8)));
typedef short s16x4 __attribute__((ext_vector_type(4)));
#define MFMA32(a, b, c) __builtin_amdgcn_mfma_f32_32x32x16_bf16((a), (b), (c), 0, 0, 0)
__device__ __forceinline__ unsigned f2bf(float f) { unsigned u = __builtin_bit_cast(unsigned, f); return (u + 0x7fffu + ((u >> 16) & 1u)) >> 16; }
__device__ __forceinline__ unsigned pk2(float lo, float hi) { return f2bf(lo) | (f2bf(hi) << 16); }
__device__ __forceinline__ float bflo(unsigned w) { return __uint_as_float(w << 16); }
__device__ __forceinline__ float bfhi(unsigned w) { return __uint_as_float(w & 0xffff0000u); }
__device__ __forceinline__ float bf1(bf16 v) { return __uint_as_float((unsigned)v << 16); }
__device__ __forceinline__ float gelu_tanh(float x) { const float z = 0.7978845608028654f * (x + 0.044715f * x * x * x); const float t = 1.f - 2.f / (1.f + __expf(2.f * z)); return 0.5f * x * (1.f + t); }
__device__ __forceinline__ float silu(float x) { return x / (1.f + __expf(-x)); }

#define XB_TMO      128
#define XB_XCNT(j)  (256  + 64 * (j))
#define XB_XSUB(j)  (1280 + 64 * (j))
#define XB_XGEN(j)  (2304 + 64 * (j))
#define XB_TOP      3328
#define XB_TOPGEN   3392
#define XCD_BAR_WORDS 3456
#define XB_SPIN_CAP (1u << 18)
#define LAS __attribute__((address_space(3)))

__device__ __forceinline__ unsigned xb_ld(unsigned* p)              { return __hip_atomic_load(p, __ATOMIC_RELAXED, __HIP_MEMORY_SCOPE_AGENT); }
__device__ __forceinline__ unsigned xb_add(unsigned* p, unsigned v) { return __hip_atomic_fetch_add(p, v, __ATOMIC_RELAXED, __HIP_MEMORY_SCOPE_AGENT); }
__device__ __forceinline__ unsigned xb_xcc_id() { return (unsigned)__builtin_amdgcn_s_getreg((3 << 11) | 20) & 0xFu; }
#define XB_SPIN(cond, bar) do { unsigned _sp = 0; while (cond) { __builtin_amdgcn_s_sleep(1); \
    if ((++_sp & 255u) == 0u) { if (xb_ld(&(bar)[XB_TMO])) break; if (_sp > XB_SPIN_CAP) { atomicAdd(&(bar)[XB_TMO], 1u); break; } } } } while (0)

struct XcdBarrier {
    unsigned* bar; unsigned x;
    volatile LAS unsigned* st;
};

__device__ __forceinline__ XcdBarrier xcd_barrier_post(unsigned* bar, volatile LAS unsigned* st) {
    XcdBarrier b; b.bar = bar; b.x = xb_xcc_id(); b.st = st;
    if (threadIdx.x == 0) (void)xb_add(&bar[XB_XCNT(b.x)], 1u);
    return b;
}
__device__ __forceinline__ void xcd_barrier_complete(unsigned* bar, unsigned x, unsigned& nloc, unsigned& nx) {
    const unsigned G = gridDim.x * gridDim.y * gridDim.z;
    unsigned sum, cnt, mine, sp = 0u;
    for (;;) {
        sum = 0u; cnt = 0u; mine = 0u;
#pragma unroll
        for (unsigned j = 0; j < 16; ++j) { const unsigned c = xb_ld(&bar[XB_XCNT(j)]); sum += c; cnt += (c > 0u) ? 1u : 0u; mine = (j == x) ? c : mine; }
        if (sum == G) break;
        __builtin_amdgcn_s_sleep(1);
        if ((++sp & 255u) == 0u) { if (xb_ld(&bar[XB_TMO])) break; if (sp > XB_SPIN_CAP) { atomicAdd(&bar[XB_TMO], 1u); break; } }
    }
    nloc = mine > 0u ? mine : 1u; nx = cnt > 0u ? cnt : 1u;
}

__device__ __forceinline__ void xcd_barrier(const XcdBarrier& b) {
    asm volatile("s_waitcnt vmcnt(0)" ::: "memory");
    __syncthreads();
    if (threadIdx.x == 0) {
        unsigned* bar = b.bar;
        __builtin_amdgcn_s_waitcnt(0);
        unsigned nloc = b.st[0], nx = b.st[1];
        if (nloc == 0u) { xcd_barrier_complete(bar, b.x, nloc, nx); b.st[0] = nloc; b.st[1] = nx; }
        const unsigned old = xb_add(&bar[XB_XSUB(b.x)], 1u);
        const unsigned gen = old / nloc;
        if (old + 1u == (gen + 1u) * nloc) {
            __builtin_amdgcn_fence(__ATOMIC_RELEASE, "agent");
            asm volatile("s_waitcnt vmcnt(0)" ::: "memory");
            const unsigned og = xb_add(&bar[XB_TOP], 1u);
            const unsigned tg = og / nx;
            if (og + 1u == (tg + 1u) * nx) xb_add(&bar[XB_TOPGEN], 1u);
            else XB_SPIN(xb_ld(&bar[XB_TOPGEN]) == tg, bar);
            __builtin_amdgcn_fence(__ATOMIC_ACQUIRE, "agent");
            xb_add(&bar[XB_XGEN(b.x)], 1u);
            asm volatile("s_waitcnt vmcnt(0)" ::: "memory");
        } else {
            XB_SPIN(xb_ld(&bar[XB_XGEN(b.x)]) == gen, bar);
            __builtin_amdgcn_fence(__ATOMIC_ACQUIRE, "agent");
            asm volatile("s_waitcnt vmcnt(0)" ::: "memory");
        }
    }
    __syncthreads();
}

struct Frame {
    LAS unsigned char* lds;
    int tid, lane, wave;
    int vcu, G;
    unsigned char* ws;
};

__device__ __forceinline__ bool frame_refresh(Frame& F) { int tz = threadIdx.x; asm volatile("" : "+v"(tz)); F.tid = tz; F.lane = tz & 63; return true; }
__device__ __forceinline__ float wave_sum(float v) {
#pragma unroll
    for (int o = 1; o < 64; o <<= 1) v += __shfl_xor(v, o);
    return v;
}
__device__ __forceinline__ float grp16_sum(float v) {
#pragma unroll
    for (int o = 1; o < 16; o <<= 1) v += __shfl_xor(v, o);
    return v;
}

__device__ __forceinline__ void conv_w(Frame& F, int& base, const float* W, int K, int ldw, int n_src0, int ncols, int n_valid, bf16* WT, int ldk, int row_off, float scale) {
    LAS float* scr = (LAS float*)(F.lds + F.wave * 8704);
    const int gw = F.vcu * NWAVES + F.wave, NGW = F.G * NWAVES, lane = F.lane;
    const int nblk = ncols / 32, items = (K / 64) * nblk;
    int start = (gw - base % NGW + NGW) % NGW; base += items;
    for (int it = start; it < items; it += NGW) {
        const int kb = it / nblk, nb = it % nblk, k0 = 64 * kb, n0 = 32 * nb;
        const int nn = n_src0 + n0 + (lane & 31); const bool ok = nn < n_valid;
#pragma unroll 8
        for (int i = 0; i < 32; ++i) { const int kk = 2 * i + (lane >> 5); scr[kk * 33 + (lane & 31)] = ok ? W[(size_t)(k0 + kk) * ldw + nn] * scale : 0.f; }
        asm volatile("s_waitcnt lgkmcnt(0)" ::: "memory");
        const int c = lane & 7;
#pragma unroll
        for (int j = 0; j < 4; ++j) { const int n = (lane >> 3) + 8 * j; const LAS float* s = scr + (8 * c) * 33 + n;
            v4u o; o.x = pk2(s[0 * 33], s[1 * 33]); o.y = pk2(s[2 * 33], s[3 * 33]); o.z = pk2(s[4 * 33], s[5 * 33]); o.w = pk2(s[6 * 33], s[7 * 33]);
            *(v4u*)(WT + (size_t)(row_off + n0 + n) * ldk + k0 + 8 * c) = o; }
        asm volatile("s_waitcnt lgkmcnt(0)" ::: "memory");
    }
}

__device__ __forceinline__ void norm_phase(Frame& F, const float* xin, const bf16* Y, float* xout, bf16* H, const float* gpost, const float* gpre) {
    const int gw = F.vcu * NWAVES + F.wave, NGW = F.G * NWAVES, lane = F.lane;
    for (int m = gw; m < M; m += NGW) {
        const f32x4* xr = (const f32x4*)(xin + (size_t)m * D) + lane;
        f32x4 v[4];
#pragma unroll
        for (int j = 0; j < 4; ++j) v[j] = xr[64 * j];
        if (Y) {
            const v2u* yr = (const v2u*)(Y + (size_t)m * D) + lane;
            f32x4 y[4]; float ss = 0.f;
#pragma unroll
            for (int j = 0; j < 4; ++j) { const v2u w = yr[64 * j]; y[j] = (f32x4){bflo(w.x), bfhi(w.x), bflo(w.y), bfhi(w.y)}; ss += (y[j].x * y[j].x + y[j].y * y[j].y) + (y[j].z * y[j].z + y[j].w * y[j].w); }
            const float rstd = rsqrtf(wave_sum(ss) * (1.f / D) + NORM_EPS);
#pragma unroll
            for (int j = 0; j < 4; ++j) { const f32x4 g = *((const f32x4*)gpost + lane + 64 * j); v[j] = v[j] + y[j] * rstd * g; }
        }
        if (xout) { f32x4* xo = (f32x4*)(xout + (size_t)m * D) + lane;
#pragma unroll
            for (int j = 0; j < 4; ++j) xo[64 * j] = v[j]; }
        if (H) {
            float ss = 0.f;
#pragma unroll
            for (int j = 0; j < 4; ++j) ss += (v[j].x * v[j].x + v[j].y * v[j].y) + (v[j].z * v[j].z + v[j].w * v[j].w);
            const float rstd = rsqrtf(wave_sum(ss) * (1.f / D) + NORM_EPS);
            v2u* ho = (v2u*)(H + (size_t)m * D) + lane;
#pragma unroll
            for (int j = 0; j < 4; ++j) { const f32x4 g = *((const f32x4*)gpre + lane + 64 * j); const f32x4 o = v[j] * rstd * g;
                v2u w; w.x = pk2(o.x, o.y); w.y = pk2(o.z, o.w); ho[64 * j] = w; }
        }
    }
}

template <int DK, int DV, int CS, bool ISGLA>
__device__ __forceinline__ void recur_phase(Frame& F, bf16* base, int ld, int qoff, int koff, int voff, int laoff, float kscale) {
    constexpr int NS = DV / CS, NDG = 512 / CS, DPT = DK / NDG, TB = 16, NT = ISGLA ? 3 : 2, NB = SEQ / TB;
    constexpr int STG = NT * TB * DK, VST = TB * CS, RED = NDG * TB * CS;
    static_assert((2 * STG + 2 * VST + 2 * RED) * 4 <= SCR_BYTES, "recurrent phase LDS");
    LAS float* stage = (LAS float*)F.lds; LAS float* vst = stage + 2 * STG; LAS float* red = vst + 2 * VST;
    const int tid = F.tid, c = tid % CS, dg = tid / CS;
    constexpr int QCH = TB * DK / 8, VCH = TB * CS / 8;
    const bool ldq = tid < QCH, ldv = tid < VCH;
    const int qt_ = tid / (DK / 8), qd = (tid % (DK / 8)) * 8;
    const int vt_ = tid / (CS / 8), vc_ = (tid % (CS / 8)) * 8;
    for (int it = F.vcu; it < 32 * NS; it += F.G) {
        const int bh = it / NS, sl = it % NS, b = bh >> 2, h = bh & 3;
        bf16* rowbase = base + (size_t)b * SEQ * ld;
        const bf16* qp = rowbase + qoff + h * DK; const bf16* kp = rowbase + koff + h * DK; const bf16* lap = rowbase + laoff + h * DK;
        bf16* vp = rowbase + voff + h * DV + sl * CS;
        const float gamma = 1.f - exp2f(-5.f - (float)h);
        f32x2 S[DPT / 2];
#pragma unroll
        for (int i = 0; i < DPT / 2; ++i) S[i] = (f32x2){0.f, 0.f};
        v4u rq = {0, 0, 0, 0}, rk = {0, 0, 0, 0}, rl = {0, 0, 0, 0}, rv = {0, 0, 0, 0};
#define RC_GLOAD(n_) do { \
            if (ldq) { const size_t o_ = (size_t)((n_) * TB + qt_) * ld + qd; rq = *(const v4u*)(qp + o_); rk = *(const v4u*)(kp + o_); if (ISGLA) rl = *(const v4u*)(lap + o_); } \
            if (ldv) { rv = *(const v4u*)(vp + (size_t)((n_) * TB + vt_) * ld + vc_); } } while (0)
#define RC_SWRITE(buf_) do { \
            LAS float* st_ = stage + (buf_) * STG; \
            if (ldq) { \
                LAS float* q_ = st_ + qt_ * DK + qd; LAS float* k_ = st_ + TB * DK + qt_ * DK + qd; \
                *(LAS f32x4*)q_ = (f32x4){bflo(rq.x), bfhi(rq.x), bflo(rq.y), bfhi(rq.y)}; *(LAS f32x4*)(q_ + 4) = (f32x4){bflo(rq.z), bfhi(rq.z), bflo(rq.w), bfhi(rq.w)}; \
                *(LAS f32x4*)k_ = (f32x4){bflo(rk.x), bfhi(rk.x), bflo(rk.y), bfhi(rk.y)} * kscale; *(LAS f32x4*)(k_ + 4) = (f32x4){bflo(rk.z), bfhi(rk.z), bflo(rk.w), bfhi(rk.w)} * kscale; \
                if (ISGLA) { LAS float* a_ = st_ + 2 * TB * DK + qt_ * DK + qd; \
                    *(LAS f32x4*)a_ = (f32x4){__expf(bflo(rl.x)), __expf(bfhi(rl.x)), __expf(bflo(rl.y)), __expf(bfhi(rl.y))}; \
                    *(LAS f32x4*)(a_ + 4) = (f32x4){__expf(bflo(rl.z)), __expf(bfhi(rl.z)), __expf(bflo(rl.w)), __expf(bfhi(rl.w))}; } \
            } \
            if (ldv) { LAS float* v_ = vst + (buf_) * VST + vt_ * CS + vc_; \
                *(LAS f32x4*)v_ = (f32x4){bflo(rv.x), bfhi(rv.x), bflo(rv.y), bfhi(rv.y)}; *(LAS f32x4*)(v_ + 4) = (f32x4){bflo(rv.z), bfhi(rv.z), bflo(rv.w), bfhi(rv.w)}; } } while (0)
        __syncthreads();
        RC_GLOAD(0); RC_SWRITE(0);
        __syncthreads();
        for (int n = 0; n < NB; ++n) {
            const int cur = n & 1;
            if (n + 1 < NB) RC_GLOAD(n + 1);
            const LAS float* qs = stage + cur * STG + dg * DPT; const LAS float* ks = qs + TB * DK; const LAS float* as = qs + 2 * TB * DK;
            const LAS float* vs = vst + cur * VST + c;
            LAS float* rd = red + cur * RED + dg * TB * CS + c;
#pragma unroll
            for (int t = 0; t < TB; ++t) {
                const float vv = vs[t * CS];
                f32x2 acc = {0.f, 0.f};
#pragma unroll
                for (int i = 0; i < DPT; i += 4) {
                    const f32x4 k4 = *(const LAS f32x4*)(ks + t * DK + i), q4 = *(const LAS f32x4*)(qs + t * DK + i);
                    f32x2 d0, d1;
                    if (ISGLA) { const f32x4 a4 = *(const LAS f32x4*)(as + t * DK + i); d0 = (f32x2){a4.x, a4.y}; d1 = (f32x2){a4.z, a4.w}; } else { d0 = (f32x2){gamma, gamma}; d1 = d0; }
                    S[i / 2] = S[i / 2] * d0 + (f32x2){k4.x, k4.y} * vv; acc += (f32x2){q4.x, q4.y} * S[i / 2];
                    S[i / 2 + 1] = S[i / 2 + 1] * d1 + (f32x2){k4.z, k4.w} * vv; acc += (f32x2){q4.z, q4.w} * S[i / 2 + 1];
                }
                rd[t * CS] = acc.x + acc.y;
            }
            if (n + 1 < NB) RC_SWRITE(cur ^ 1);
            __syncthreads();
#pragma unroll
            for (int rep = 0; rep < (TB * CS + 511) / 512; ++rep) {
                const int idx = tid + rep * 512;
                if (idx < TB * CS) {
                    const LAS float* rr = red + cur * RED + idx; float s = 0.f;
#pragma unroll
                    for (int g = 0; g < NDG; ++g) s += rr[g * TB * CS];
                    const int t = idx / CS, cc = idx % CS;
                    vp[(size_t)(n * TB + t) * ld + cc] = (bf16)f2bf(s);
                }
            }
        }
    }
    __syncthreads();
}

template <int DV, bool CENTER>
__device__ __forceinline__ void hn_phase(Frame& F, bf16* base, int ld, int ooff, int goff, const float* gn) {
    constexpr int NJ = DV / 128;
    const int gw = F.vcu * NWAVES + F.wave, NGW = F.G * NWAVES, lane = F.lane, hq = lane >> 4, li = lane & 15;
    for (int m = gw; m < M; m += NGW) {
        bf16* op = base + (size_t)m * ld + ooff + hq * DV + li * 8; const bf16* gp = base + (size_t)m * ld + goff + hq * DV + li * 8;
        float o[NJ][8]; v4u gw4[NJ]; float s = 0.f;
#pragma unroll
        for (int j = 0; j < NJ; ++j) { const v4u w = *(const v4u*)(op + 128 * j); gw4[j] = *(const v4u*)(gp + 128 * j);
            o[j][0] = bflo(w.x); o[j][1] = bfhi(w.x); o[j][2] = bflo(w.y); o[j][3] = bfhi(w.y); o[j][4] = bflo(w.z); o[j][5] = bfhi(w.z); o[j][6] = bflo(w.w); o[j][7] = bfhi(w.w);
#pragma unroll
            for (int e = 0; e < 8; ++e) s += o[j][e]; }
        float mean = 0.f;
        if (CENTER) mean = grp16_sum(s) * (1.f / DV);
        float s2 = 0.f;
#pragma unroll
        for (int j = 0; j < NJ; ++j)
#pragma unroll
            for (int e = 0; e < 8; ++e) { o[j][e] -= mean; s2 += o[j][e] * o[j][e]; }
        const float rstd = rsqrtf(grp16_sum(s2) * (1.f / DV) + NORM_EPS);
#pragma unroll
        for (int j = 0; j < NJ; ++j) {
            const float* gnp = gn + hq * DV + li * 8 + 128 * j; const f32x4 g0 = *(const f32x4*)gnp, g1 = *(const f32x4*)(gnp + 4);
            const float gg[8] = {bflo(gw4[j].x), bfhi(gw4[j].x), bflo(gw4[j].y), bfhi(gw4[j].y), bflo(gw4[j].z), bfhi(gw4[j].z), bflo(gw4[j].w), bfhi(gw4[j].w)};
            float r[8];
#pragma unroll
            for (int e = 0; e < 8; ++e) r[e] = o[j][e] * rstd * (e < 4 ? g0[e & 3] : g1[e & 3]) * silu(gg[e]);
            v4u w; w.x = pk2(r[0], r[1]); w.y = pk2(r[2], r[3]); w.z = pk2(r[4], r[5]); w.w = pk2(r[6], r[7]);
            *(v4u*)(op + 128 * j) = w;
        }
    }
}

__device__ __forceinline__ void lru_conv_phase(Frame& F, const bf16* XY, bf16* XC, const float* cw, const float* cb) {
    const int gw = F.vcu * NWAVES + F.wave, NGW = F.G * NWAVES, lane = F.lane;
    for (int m = gw; m < M; m += NGW) {
        const int t = m & (SEQ - 1);
#pragma unroll
        for (int j = 0; j < 2; ++j) {
            const int ch = lane * 8 + 512 * j;
            float acc[8];
            { const f32x4 b0 = *(const f32x4*)(cb + ch), b1 = *(const f32x4*)(cb + ch + 4);
              acc[0] = b0.x; acc[1] = b0.y; acc[2] = b0.z; acc[3] = b0.w; acc[4] = b1.x; acc[5] = b1.y; acc[6] = b1.z; acc[7] = b1.w; }
#pragma unroll
            for (int tap = 0; tap < 4; ++tap) {
                if (t - 3 + tap >= 0) {
                    const v4u w = *(const v4u*)(XY + (size_t)(m - 3 + tap) * 2048 + ch);
                    const f32x4 c0 = *(const f32x4*)(cw + tap * 1024 + ch), c1 = *(const f32x4*)(cw + tap * 1024 + ch + 4);
                    acc[0] += bflo(w.x) * c0.x; acc[1] += bfhi(w.x) * c0.y; acc[2] += bflo(w.y) * c0.z; acc[3] += bfhi(w.y) * c0.w;
                    acc[4] += bflo(w.z) * c1.x; acc[5] += bfhi(w.z) * c1.y; acc[6] += bflo(w.w) * c1.z; acc[7] += bfhi(w.w) * c1.w;
                }
            }
            v4u o; o.x = pk2(acc[0], acc[1]); o.y = pk2(acc[2], acc[3]); o.z = pk2(acc[4], acc[5]); o.w = pk2(acc[6], acc[7]);
            *(v4u*)(XC + (size_t)m * 1024 + ch) = o;
        }
    }
}
template <int PASS>
__device__ __forceinline__ void lru_scan_phase(Frame& F, const bf16* GP, const bf16* XC, const bf16* XY, float* SP, float* SE, bf16* HS, const float* b_a, const float* b_x, const float* lam) {
    const int tid = F.tid, ch = 2 * tid, gcol = (ch >> 7) * 256 + (ch & 127);
    const float ba0 = b_a[ch], ba1 = b_a[ch + 1], bx0 = b_x[ch], bx1 = b_x[ch + 1];
    const float lm0 = lam[ch], lm1 = lam[ch + 1];
    const float sp0 = -8.f * (fmaxf(-lm0, 0.f) + log1pf(__expf(-fabsf(lm0)))), sp1 = -8.f * (fmaxf(-lm1, 0.f) + log1pf(__expf(-fabsf(lm1))));
    for (int it = F.vcu; it < BATCH * 64; it += F.G) {
        const int b = it >> 6, ci = it & 63; const size_t m0 = (size_t)b * SEQ + ci * 64;
        float h0 = 0.f, h1 = 0.f, s0 = 0.f, s1 = 0.f;
        if (PASS == 1) {
            for (int j = 0; j < ci; ++j) { const f32x2 p = *(const f32x2*)(SP + (size_t)(b * 64 + j) * 1024 + ch), e = *(const f32x2*)(SE + (size_t)(b * 64 + j) * 1024 + ch);
                h0 = p.x * h0 + e.x; h1 = p.y * h1 + e.y; }
        }
#pragma unroll 8
        for (int t = 0; t < 64; ++t) {
            const unsigned pa = *(const unsigned*)(GP + (m0 + t) * 2048 + gcol), px = *(const unsigned*)(GP + (m0 + t) * 2048 + gcol + 128), xc = *(const unsigned*)(XC + (m0 + t) * 1024 + ch);
            const float l0 = sp0 / (1.f + __expf(-(bflo(pa) + ba0))), l1 = sp1 / (1.f + __expf(-(bfhi(pa) + ba1)));
            const float a0 = __expf(l0), a1 = __expf(l1);
            const float u0 = sqrtf(fmaxf(1.f - a0 * a0, 0.f)) * bflo(xc) / (1.f + __expf(-(bflo(px) + bx0))), u1 = sqrtf(fmaxf(1.f - a1 * a1, 0.f)) * bfhi(xc) / (1.f + __expf(-(bfhi(px) + bx1)));
            h0 = a0 * h0 + u0; h1 = a1 * h1 + u1;
            if (PASS == 0) { s0 += l0; s1 += l1; }
            else { const unsigned y = *(const unsigned*)(XY + (m0 + t) * 2048 + 1024 + ch);
                *(unsigned*)(HS + (m0 + t) * 1024 + ch) = pk2(h0 * gelu_tanh(bflo(y)), h1 * gelu_tanh(bfhi(y))); }
        }
        if (PASS == 0) { *(f32x2*)(SP + (size_t)it * 1024 + ch) = (f32x2){__expf(s0), __expf(s1)}; *(f32x2*)(SE + (size_t)it * 1024 + ch) = (f32x2){h0, h1}; }
    }
}

__device__ __forceinline__ void nsa_compress_phase(Frame& F, const bf16* KC, const bf16* VC, const bf16* W1K, const bf16* W1V, const bf16* W2K, const bf16* W2V, const float* PEB, bf16* KCMP, bf16* VCMPT) {
    LAS float* part = (LAS float*)F.lds;
    LAS bf16* hid = (LAS bf16*)(F.lds + 32768);
    const int tid = F.tid, lane = F.lane, w = F.wave, r = lane & 31, hh = lane >> 5;
    for (int it = F.vcu; it < 256; it += F.G) {
        const int kv = it >> 7, bg = (it >> 3) & 15, ntile = it & 7;
        const bf16* A = (kv ? VC : KC) + (size_t)bg * SEQ * 64 + (size_t)(32 * ntile) * 1024;
        const bf16* W1 = kv ? W1V : W1K; const bf16* W2 = kv ? W2V : W2K; const float* bias = PEB + kv * 128;
        const int ct = w & 3, kh = w >> 2;
        f32x16 acc = {};
        const bf16* ap = A + (size_t)r * 1024 + 1024 * kh + 8 * hh; const bf16* bp = W1 + (size_t)(32 * ct + r) * 2048 + 1024 * kh + 8 * hh;
#pragma unroll 8
        for (int s = 0; s < 64; ++s) { const bf16x8 a = *(const bf16x8*)(ap + 16 * s), bb = *(const bf16x8*)(bp + 16 * s); acc = MFMA32(a, bb, acc); }
        __syncthreads();
#pragma unroll
        for (int q = 0; q < 16; ++q) { const int row = (q & 3) + 8 * (q >> 2) + 4 * hh; part[kh * 4096 + row * 128 + 32 * ct + r] = acc[q]; }
        __syncthreads();
        { const int row = tid >> 4, col = (tid & 15) * 8; unsigned pk[4];
#pragma unroll
          for (int e = 0; e < 8; e += 2) { const float a0 = part[row * 128 + col + e] + part[4096 + row * 128 + col + e] + bias[col + e];
              const float a1 = part[row * 128 + col + e + 1] + part[4096 + row * 128 + col + e + 1] + bias[col + e + 1];
              pk[e >> 1] = pk2(gelu_tanh(a0), gelu_tanh(a1)); }
          *(LAS v4u*)(hid + row * 136 + col) = (v4u){pk[0], pk[1], pk[2], pk[3]}; }
        __syncthreads();
        if (w < 2) {
            f32x16 a2 = {};
#pragma unroll
            for (int s = 0; s < 8; ++s) { const bf16x8 a = *(const LAS bf16x8*)(hid + r * 136 + 16 * s + 8 * hh), bb = *(const bf16x8*)(W2 + (size_t)(32 * w + r) * 128 + 16 * s + 8 * hh); a2 = MFMA32(a, bb, a2); }
            const int d = 32 * w + r;
            if (kv == 0) {
#pragma unroll
                for (int q = 0; q < 16; ++q) { const int n = 32 * ntile + (q & 3) + 8 * (q >> 2) + 4 * hh; KCMP[((size_t)bg * 256 + n) * 64 + d] = (bf16)(n == 255 ? 0u : f2bf(a2[q])); }
            } else {
#pragma unroll
                for (int q4 = 0; q4 < 4; ++q4) { const int n = 32 * ntile + 8 * q4 + 4 * hh; float v[4];
#pragma unroll
                    for (int e = 0; e < 4; ++e) v[e] = (n + e == 255) ? 0.f : a2[4 * q4 + e];
                    v2u o; o.x = pk2(v[0], v[1]); o.y = pk2(v[2], v[3]); *(v2u*)(VCMPT + ((size_t)bg * 64 + d) * 256 + n) = o; }
            }
        }
    }
    __syncthreads();
}

constexpr int KP = 72;
__device__ __forceinline__ void qk_tile(const LAS bf16* KT, const bf16x8 (&Qf)[4], f32x16& S0, f32x16& S1, int r, int hh) {
    S0 = (f32x16){}; S1 = (f32x16){};
#pragma unroll
    for (int s = 0; s < 4; ++s) {
        const bf16x8 a0 = *(const LAS bf16x8*)(KT + r * KP + 16 * s + 8 * hh), a1 = *(const LAS bf16x8*)(KT + (32 + r) * KP + 16 * s + 8 * hh);
        S0 = MFMA32(a0, Qf[s], S0); S1 = MFMA32(a1, Qf[s], S1);
    }
}
__device__ __forceinline__ void attn_tile(const LAS bf16* KT, const LAS bf16* VT, const bf16x8 (&Qf)[4], f32x16 (&O)[2], float& mrun, float& lrun,
                                          float biasl, float bstep, int limhi, int limlo, int r, int hh) {
    f32x16 S0, S1; qk_tile(KT, Qf, S0, S1, r, hh);
    float mx = -INFINITY;
#pragma unroll
    for (int q = 0; q < 16; ++q) { const int c = (q & 3) + 8 * (q >> 2);
        S0[q] = (c <= limhi && c > limlo) ? S0[q] + __builtin_fmaf(bstep, (float)c, biasl) : -INFINITY;
        S1[q] = (c + 32 <= limhi && c + 32 > limlo) ? S1[q] + __builtin_fmaf(bstep, (float)(c + 32), biasl) : -INFINITY;
        mx = fmaxf(mx, fmaxf(S0[q], S1[q])); }
    mx = fmaxf(mx, __shfl_xor(mx, 32));
    const float mnew = fmaxf(mrun, mx), alpha = __builtin_amdgcn_exp2f(mrun - mnew);
    float rs = 0.f;
#pragma unroll
    for (int q = 0; q < 16; ++q) { S0[q] = __builtin_amdgcn_exp2f(S0[q] - mnew); S1[q] = __builtin_amdgcn_exp2f(S1[q] - mnew); rs += S0[q] + S1[q]; }
    rs += __shfl_xor(rs, 32);
    lrun = lrun * alpha + rs; mrun = mnew;
#pragma unroll
    for (int dt = 0; dt < 2; ++dt)
#pragma unroll
        for (int q = 0; q < 16; ++q) O[dt][q] *= alpha;
    bf16x8 Pf[2][2];
#pragma unroll
    for (int s = 0; s < 2; ++s) {
        v4u w0, w1;
        w0.x = pg8::cvt_pk_bf16(S0[8 * s + 0], S0[8 * s + 1]); w0.y = pg8::cvt_pk_bf16(S0[8 * s + 2], S0[8 * s + 3]); w0.z = pg8::cvt_pk_bf16(S0[8 * s + 4], S0[8 * s + 5]); w0.w = pg8::cvt_pk_bf16(S0[8 * s + 6], S0[8 * s + 7]);
        w1.x = pg8::cvt_pk_bf16(S1[8 * s + 0], S1[8 * s + 1]); w1.y = pg8::cvt_pk_bf16(S1[8 * s + 2], S1[8 * s + 3]); w1.z = pg8::cvt_pk_bf16(S1[8 * s + 4], S1[8 * s + 5]); w1.w = pg8::cvt_pk_bf16(S1[8 * s + 6], S1[8 * s + 7]);
        Pf[0][s] = __builtin_bit_cast(bf16x8, w0); Pf[1][s] = __builtin_bit_cast(bf16x8, w1);
    }
#pragma unroll
    for (int dt = 0; dt < 2; ++dt)
#pragma unroll
        for (int kt = 0; kt < 2; ++kt)
#pragma unroll
            for (int s = 0; s < 2; ++s) {
                const LAS bf16* vp = VT + (32 * dt + r) * KP + 32 * kt + 16 * s + 4 * hh;
                const v2u lo = *(const LAS v2u*)vp, hi = *(const LAS v2u*)(vp + 8);
                const bf16x8 a = __builtin_bit_cast(bf16x8, (v4u){lo.x, lo.y, hi.x, hi.y});
                O[dt] = MFMA32(a, Pf[kt][s], O[dt]);
            }
}
__device__ __forceinline__ void imp_tile(const LAS bf16* KT, const bf16x8 (&Qf)[4], float mfin, float linv, float biasl, float bstep, int limhi, int n0t, LAS unsigned* IMP, int r, int hh) {
    f32x16 S0, S1; qk_tile(KT, Qf, S0, S1, r, hh);
#pragma unroll
    for (int q = 0; q < 16; ++q) { const int c = (q & 3) + 8 * (q >> 2);
        S0[q] = (c <= limhi) ? __builtin_amdgcn_exp2f(S0[q] + __builtin_fmaf(bstep, (float)c, biasl) - mfin) * linv : 0.f;
        S1[q] = (c + 32 <= limhi) ? __builtin_amdgcn_exp2f(S1[q] + __builtin_fmaf(bstep, (float)(c + 32), biasl) - mfin) * linv : 0.f; }
    LAS unsigned* row = IMP + r * 65;
#pragma unroll
    for (int kt = 0; kt < 2; ++kt)
#pragma unroll
        for (int a = 0; a < 4; ++a) {
            const float e0 = kt ? S1[4 * a] : S0[4 * a], e1 = kt ? S1[4 * a + 1] : S0[4 * a + 1], e2 = kt ? S1[4 * a + 2] : S0[4 * a + 2], e3 = kt ? S1[4 * a + 3] : S0[4 * a + 3];
            const int j = (n0t + 32 * kt + 8 * a + 4 * hh) >> 2;
            const unsigned gq = (unsigned)((e0 + e1 + e2 + e3) * 8388608.f + 0.5f), lq = (unsigned)(e3 * 8388608.f + 0.5f);
            if (gq) __hip_atomic_fetch_add((unsigned*)(row + j), gq, __ATOMIC_RELAXED, __HIP_MEMORY_SCOPE_WORKGROUP);
            if (lq && j + 1 < 64) __hip_atomic_fetch_add((unsigned*)(row + j + 1), lq, __ATOMIC_RELAXED, __HIP_MEMORY_SCOPE_WORKGROUP);
        }
}
__device__ __forceinline__ void load_kv_tile(LAS bf16* KT, LAS bf16* VT, const bf16* ksrc  , const bf16* vsrc  , int vstride, int tid, bool with_v) {
    const int row = tid >> 3, ch = (tid & 7) * 8;
    const v4u k = *(const v4u*)(ksrc + row * 64 + ch);
    v4u v = {0, 0, 0, 0}; if (with_v) v = *(const v4u*)(vsrc + (size_t)row * vstride + ch);
    *(LAS v4u*)(KT + row * KP + ch) = k;
    if (with_v) *(LAS v4u*)(VT + row * KP + ch) = v;
}
#define TZ_LANE int tz = tid; asm volatile("" : "+v"(tz)); const int r = tz & 31, hh = (tz >> 5) & 1;
__device__ __forceinline__ void nsa_attn_phase(Frame& F, const bf16* Q, const bf16* KCMP, const bf16* VCMPT, const bf16* KS, const bf16* VST, const bf16* KW, const bf16* VWT, const float* GATES, bf16* OB) {
    LAS bf16* KT = (LAS bf16*)F.lds; LAS bf16* VT = KT + 64 * KP;
    LAS unsigned* IMP = (LAS unsigned*)(F.lds + 2 * 64 * KP * 2);
    LAS unsigned char* SELB = (LAS unsigned char*)(IMP + 32 * 65);
    const int tid = F.tid, w = F.wave;
    for (int it = F.vcu; it < 2048; it += F.G) {
        const int k8 = it >> 8, v = it & 255, slot = k8 >> 1, half = k8 & 1, bg = v >> 4, rr = v & 15;
        const int i = slot == 0 ? rr : (slot == 1 ? 31 - rr : (slot == 2 ? 32 + rr : 63 - rr));
        const int b = bg >> 1, g = bg & 1, h = g * 8 + w, t0 = 64 * i, q0 = 32 * half;
        const float slope2 = exp2f(-0.5f * (float)(h + 1)) * LOG2E;
        bf16x8 Qf[4]; float gate[3];
        { TZ_LANE
          const size_t row = (size_t)b * SEQ + t0 + q0 + r;
#pragma unroll
          for (int s = 0; s < 4; ++s) Qf[s] = *(const bf16x8*)(Q + row * 1024 + h * 64 + 16 * s + 8 * hh);
#pragma unroll
          for (int br = 0; br < 3; ++br) gate[br] = GATES[row * 48 + br * 16 + h]; }
        f32x16 O[2]; O[0] = (f32x16){}; O[1] = (f32x16){};
        unsigned OUTP[2][8];
#define OUT_ACC(sc_, first_) do { _Pragma("unroll") for (int dt_ = 0; dt_ < 2; ++dt_) { _Pragma("unroll") for (int e_ = 0; e_ < 8; ++e_) { const unsigned w_ = (first_) ? 0u : OUTP[dt_][e_]; \
            OUTP[dt_][e_] = pk2(bflo(w_) + O[dt_][2 * e_] * (sc_), bfhi(w_) + O[dt_][2 * e_ + 1] * (sc_)); } O[dt_] = (f32x16){}; } } while (0)
        float mrun = -1e30f, lrun = 0.f;
        __syncthreads();
        for (int idx = tid; idx < 32 * 65; idx += 512) IMP[idx] = 0u;
        const int ncmp = (4 * i + 3) < 255 ? (4 * i + 3) : 255, ntile = (ncmp + 63) >> 6;
        const bf16* kcb = KCMP + (size_t)bg * 256 * 64; const bf16* vcb = VCMPT + (size_t)bg * 64 * 256;
        for (int tl = 0; tl < ntile; ++tl) {
            TZ_LANE
            __syncthreads();
            load_kv_tile(KT, VT, kcb + (size_t)tl * 64 * 64, vcb + tl * 64, 256, tz, true);
            __syncthreads();
            const int n0t = 64 * tl, a1 = ((t0 + q0 + r - 31) >> 4) - n0t - 4 * hh, a2 = 254 - n0t - 4 * hh;
            attn_tile(KT, VT, Qf, O, mrun, lrun, slope2 * (float)(16 * n0t + 31 - t0) + slope2 * 64.f * (float)hh, slope2 * 16.f, a1 < a2 ? a1 : a2, -1000, r, hh);
        }
        const float mfin = mrun, linv = 1.f / fmaxf(lrun, 1e-30f);
        OUT_ACC(linv * gate[0], true);
        mrun = -1e30f; lrun = 0.f;
        for (int tl = 0; tl < ntile; ++tl) {
            TZ_LANE
            __syncthreads();
            load_kv_tile(KT, VT, kcb + (size_t)tl * 64 * 64, vcb, 256, tz, false);
            __syncthreads();
            const int n0t = 64 * tl, a1 = ((t0 + q0 + r - 31) >> 4) - n0t - 4 * hh, a2 = 254 - n0t - 4 * hh;
            imp_tile(KT, Qf, mfin, linv, slope2 * (float)(16 * n0t + 31 - t0) + slope2 * 64.f * (float)hh, slope2 * 16.f, a1 < a2 ? a1 : a2, n0t, IMP, r, hh);
        }
        __syncthreads();
        {
            const int q = (tid >> 3) & 31, oct = tid & 7;
            unsigned mykey[8];
#pragma unroll
            for (int jj = 0; jj < 8; ++jj) { const int j = oct * 8 + jj; unsigned vv = IMP[q * 65 + j]; vv = vv > 0x3fffffeu ? 0x3fffffeu : vv;
                const bool forced = (j == 0) || (j == i) || (j == i - 1);
                mykey[jj] = (j <= i) ? (((forced ? 0x3ffffffu : vv) << 6) | (unsigned)(63 - j)) : 0u; }
            __syncthreads();
            if (tid < 256) {
#pragma unroll
                for (int jj = 0; jj < 8; ++jj) IMP[q * 65 + oct * 8 + jj] = mykey[jj]; }
            __syncthreads();
            unsigned rank[8] = {0, 0, 0, 0, 0, 0, 0, 0};
            for (int j2 = 0; j2 < 64; ++j2) { const unsigned kk = IMP[q * 65 + j2];
#pragma unroll
                for (int jj = 0; jj < 8; ++jj) rank[jj] += (kk > mykey[jj]) ? 1u : 0u; }
            unsigned byte = 0;
#pragma unroll
            for (int jj = 0; jj < 8; ++jj) byte |= ((oct * 8 + jj <= i) && rank[jj] < 16u) ? (1u << jj) : 0u;
            if (tid < 256) SELB[q * 8 + oct] = (unsigned char)byte;
        }
        __syncthreads();
        unsigned long long selm, uni;
        { TZ_LANE
          selm = *(const LAS unsigned long long*)(SELB + 8 * r);
          unsigned ulo = (unsigned)selm, uhi = (unsigned)(selm >> 32);
#pragma unroll
          for (int o = 1; o < 32; o <<= 1) { ulo |= __shfl_xor(ulo, o); uhi |= __shfl_xor(uhi, o); }
          uni = ((unsigned long long)(unsigned)__builtin_amdgcn_readfirstlane(uhi) << 32) | (unsigned)__builtin_amdgcn_readfirstlane(ulo); }
        const bf16* ksb = KS + (size_t)bg * SEQ * 64; const bf16* vsb = VST + (size_t)bg * 64 * SEQ;
        for (int j = 0; j <= i; ++j) {
            if (!((uni >> j) & 1ull)) continue;
            TZ_LANE
            __syncthreads();
            load_kv_tile(KT, VT, ksb + (size_t)j * 64 * 64, vsb + j * 64, SEQ, tz, true);
            __syncthreads();
            const int lh = ((selm >> j) & 1ull) ? (j == i ? q0 + r - 4 * hh : 1000) : -1000;
            attn_tile(KT, VT, Qf, O, mrun, lrun, slope2 * (float)(64 * j - t0) + slope2 * 4.f * (float)hh, slope2, lh, -1000, r, hh);
        }
        OUT_ACC(gate[1] / fmaxf(lrun, 1e-30f), false);
        mrun = -1e30f; lrun = 0.f;
        const bf16* kwb = KW + (size_t)bg * SEQ * 64; const bf16* vwb = VWT + (size_t)bg * 64 * SEQ;
        for (int j = (i > 8 ? i - 8 : 0); j <= i; ++j) {
            TZ_LANE
            __syncthreads();
            load_kv_tile(KT, VT, kwb + (size_t)j * 64 * 64, vwb + j * 64, SEQ, tz, true);
            __syncthreads();
            const int lh = (j == i) ? q0 + r - 4 * hh : 1000, ll = (j == i - 8) ? q0 + r - 4 * hh : -1000;
            attn_tile(KT, VT, Qf, O, mrun, lrun, slope2 * (float)(64 * j - t0) + slope2 * 4.f * (float)hh, slope2, lh, ll, r, hh);
        }
        OUT_ACC(gate[2] / fmaxf(lrun, 1e-30f), false);
        { TZ_LANE
          bf16* op = OB + ((size_t)b * SEQ + t0 + q0 + r) * 1024 + h * 64;
#pragma unroll
          for (int dt = 0; dt < 2; ++dt)
#pragma unroll
              for (int q4 = 0; q4 < 4; ++q4) { v2u o; o.x = OUTP[dt][2 * q4]; o.y = OUTP[dt][2 * q4 + 1]; *(v2u*)(op + 32 * dt + 8 * q4 + 4 * hh) = o; } }
    }
    __syncthreads();
#undef OUT_ACC
}

struct Args { const float* in[32]; float* out; unsigned char* ws; int ph_lo, ph_hi; };
constexpr int N_PHASES = 35;

__global__ void __launch_bounds__(NWAVES * 64, 2) trunk_fwd(Args args) {
    extern __shared__ __attribute__((aligned(16))) unsigned char lds[];
    Frame F;
    F.lds = (LAS unsigned char*)lds;
    F.tid = threadIdx.x; F.lane = F.tid & 63; F.wave = __builtin_amdgcn_readfirstlane(F.tid >> 6);
    F.G = gridDim.x; { const int bx = blockIdx.x; F.vcu = (F.G % 8 == 0) ? (bx % 8) * (F.G / 8) + bx / 8 : bx; }
    F.ws = args.ws;
    unsigned char* ws = args.ws;
    volatile LAS unsigned* MISC = (volatile LAS unsigned*)(F.lds + LDSCTL_OFF);
    for (int u = F.tid; u < (LDS_BYTES - LDSCTL_OFF) / 4; u += NWAVES * 64) ((LAS unsigned*)(F.lds + LDSCTL_OFF))[u] = 0u;
    __syncthreads();
    XcdBarrier bar = xcd_barrier_post((unsigned*)(ws + WS_CTL) + CW_BAR, MISC + 8);

    const int lo = args.ph_lo, hi = args.ph_hi;
#ifndef PHMASK
#define PHMASK 0xFFFFFFFFFFFFFFFFull
#endif
#define INR(k) ((((PHMASK) >> (k)) & 1ull) && lo <= (k) && (k) < hi)
#define IN(k) (INR(k) && frame_refresh(F))
#define SEAM(k) do { if (INR(k) && INR((k) + 1)) xcd_barrier(bar); } while (0)
    const float* const* in = args.in;
    float* xout = args.out;
    bf16* Hb = (bf16*)(ws + WS_H); bf16* BIG = (bf16*)(ws + WS_BIG);
    bf16* Wi = (bf16*)(ws + WS_WIN); bf16* Wo = (bf16*)(ws + WS_WOUT); bf16* Wu = (bf16*)(ws + WS_WUP); bf16* Wd = (bf16*)(ws + WS_WDN);
    LAS unsigned char* ring = F.lds + RING_OFF;

#define CONV_MLP(L, base) do { conv_w(F, base, in[5] + (size_t)(L) * D * FF, D, FF, 0, FF, FF, Wu, D, 0, 1.f); conv_w(F, base, in[6] + (size_t)(L) * FF * D, FF, D, 0, D, D, Wd, FF, 0, 1.f); } while (0)
#define GEMM_PHASE(EPI, Aptr, LDA, Bptr, LDB, NN, KK, APN, E) do { pg8::Gemm g{(const pg8::bf16_t*)(Aptr), (const pg8::bf16_t*)(Bptr), M, (NN), (KK), (LDA), (LDB), (size_t)(APN)}; \
        pg8::StaticOrder S; S.init(M, (NN), F.G, (int)blockIdx.x); pg8::gemm_phase<EPI, pg8::StaticOrder, true, true>(ring, g, S, E); } while (0)
#define MLP_PHASES(P0, L) \
    if (IN(P0)) { pg8::EpiStore<1> E{BIG, FF}; GEMM_PHASE(pg8::EpiStore<1>, Hb, D, Wu, D, FF, D, 0, E); } SEAM(P0); \
    if (IN((P0) + 1)) { pg8::EpiStore<0> E{Hb, D}; GEMM_PHASE(pg8::EpiStore<0>, BIG, FF, Wd, FF, D, FF, 0, E); } SEAM((P0) + 1);

    if (IN(0)) {
        int base = 0;
        conv_w(F, base, in[7], D, 6144, 0, 6144, 6144, Wi, D, 0, 1.f);
        conv_w(F, base, in[9], 2048, D, 0, D, D, Wo, 2048, 0, 1.f);
        CONV_MLP(0, base);
        norm_phase(F, in[0], nullptr, nullptr, Hb, nullptr, in[1]);
    }
    SEAM(0);
    if (IN(1)) { pg8::EpiStore<0> E{BIG, 6144}; GEMM_PHASE(pg8::EpiStore<0>, Hb, D, Wi, D, 6144, D, 0, E); }
    SEAM(1);
    if (IN(2)) recur_phase<256, 512, 64, false>(F, BIG, 6144, 0, 1024, 2048, 0, 0.0625f);
    SEAM(2);
    if (IN(3)) hn_phase<512, true>(F, BIG, 6144, 2048, 4096, in[8]);
    SEAM(3);
    if (IN(4)) { pg8::EpiStore<0> E{Hb, D}; GEMM_PHASE(pg8::EpiStore<0>, BIG + 2048, 6144, Wo, 2048, D, 2048, 0, E); }
    SEAM(4);
    if (IN(5)) norm_phase(F, in[0], Hb, xout, Hb, in[2], in[3]);
    SEAM(5);
    MLP_PHASES(6, 0)
    if (IN(8)) {
        norm_phase(F, xout, Hb, xout, Hb, in[4], in[1] + D);
        int base = 0;
        conv_w(F, base, in[10], D, 3088, 0, 512, 3088, Wi, D, 0, 0.08838834764831845f);
        conv_w(F, base, in[10], D, 3088, 512, 2560, 3088, Wi, D, 512, 1.f);
        {
            const int gw = F.vcu * NWAVES + F.wave, NGW = F.G * NWAVES;
            for (int itx = gw; itx < 16 * 16; itx += NGW) {
                const int kb = itx >> 4, cb = itx & 15, k = kb * 64 + F.lane;
                float wv[16];
#pragma unroll
                for (int r = 0; r < 16; ++r) wv[r] = in[10][(size_t)k * 3088 + 3072 + r];
                for (int c = cb * 32; c < cb * 32 + 32; ++c) { float s = 0.f;
#pragma unroll
                    for (int r = 0; r < 16; ++r) s += wv[r] * in[11][r * 512 + c];
                    Wi[(size_t)(3072 + c) * D + k] = (bf16)f2bf(s); }
            }
        }
        conv_w(F, base, in[14], D, D, 0, D, D, Wo, D, 0, 1.f);
        CONV_MLP(1, base);
    }
    SEAM(8);
    if (IN(9)) { pg8::EpiGla E{BIG, 3584, in[12]}; GEMM_PHASE(pg8::EpiGla, Hb, D, Wi, D, 3584, D, 0, E); }
    SEAM(9);
    if (IN(10)) recur_phase<128, 256, 32, true>(F, BIG, 3584, 0, 512, 1024, 3072, 1.f);
    SEAM(10);
    if (IN(11)) hn_phase<256, false>(F, BIG, 3584, 1024, 2048, in[13]);
    SEAM(11);
    if (IN(12)) { pg8::EpiStore<0> E{Hb, D}; GEMM_PHASE(pg8::EpiStore<0>, BIG + 1024, 3584, Wo, D, D, D, 0, E); }
    SEAM(12);
    if (IN(13)) norm_phase(F, xout, Hb, xout, Hb, in[2] + D, in[3] + D);
    SEAM(13);
    MLP_PHASES(14, 1)
    if (IN(16)) {
        norm_phase(F, xout, Hb, xout, Hb, in[4] + D, in[1] + 2 * D);
        int base = 0;
        conv_w(F, base, in[15], D, 2048, 0, 2048, 2048, Wi, D, 0, 1.f);
        conv_w(F, base, in[23], D, D, 0, D, D, Wo, D, 0, 1.f);
        bf16* LW = (bf16*)(ws + SM_LRUW);
        for (int n = 0; n < 8; ++n) { conv_w(F, base, in[18] + n * 16384, 128, 128, 0, 128, 128, LW + n * 32768, 128, 0, 1.f); conv_w(F, base, in[20] + n * 16384, 128, 128, 0, 128, 128, LW + n * 32768, 128, 128, 1.f); }
        CONV_MLP(2, base);
    }
    SEAM(16);
    if (IN(17)) { pg8::EpiStore<0> E{(bf16*)(ws + LRU_XY), 2048}; GEMM_PHASE(pg8::EpiStore<0>, Hb, D, Wi, D, 2048, D, 0, E); }
    SEAM(17);
    if (IN(18)) lru_conv_phase(F, (const bf16*)(ws + LRU_XY), (bf16*)(ws + LRU_XC), in[16], in[17]);
    SEAM(18);
    if (IN(19)) { pg8::EpiStore<0> E{(bf16*)(ws + LRU_GP), 2048}; GEMM_PHASE(pg8::EpiStore<0>, ws + LRU_XC, D, ws + SM_LRUW, 128, 2048, 128, 256, E); }
    SEAM(19);
    if (IN(20)) lru_scan_phase<0>(F, (const bf16*)(ws + LRU_GP), (const bf16*)(ws + LRU_XC), (const bf16*)(ws + LRU_XY), (float*)(ws + SM_SCANP), (float*)(ws + SM_SCANE), (bf16*)(ws + LRU_HS), in[19], in[21], in[22]);
    SEAM(20);
    if (IN(21)) lru_scan_phase<1>(F, (const bf16*)(ws + LRU_GP), (const bf16*)(ws + LRU_XC), (const bf16*)(ws + LRU_XY), (float*)(ws + SM_SCANP), (float*)(ws + SM_SCANE), (bf16*)(ws + LRU_HS), in[19], in[21], in[22]);
    SEAM(21);
    if (IN(22)) { pg8::EpiStore<0> E{Hb, D}; GEMM_PHASE(pg8::EpiStore<0>, ws + LRU_HS, D, Wo, D, D, D, 0, E); }
    SEAM(22);
    if (IN(23)) norm_phase(F, xout, Hb, xout, Hb, in[2] + 2 * D, in[3] + 2 * D);
    SEAM(23);
    MLP_PHASES(24, 2)
    if (IN(26)) {
        norm_phase(F, xout, Hb, xout, Hb, in[4] + 2 * D, in[1] + 3 * D);
        int base = 0;
        conv_w(F, base, in[24], D, 1840, 0, 1024, 1840, Wi, D, 0, 0.125f * LOG2E);
        conv_w(F, base, in[24], D, 1840, 1024, 1024, 1840, Wi, D, 1024, 1.f);
        conv_w(F, base, in[31], D, D, 0, D, D, Wo, D, 0, 1.f);
        conv_w(F, base, in[26], 2048, 128, 0, 128, 128, (bf16*)(ws + SM_W1K), 2048, 0, 1.f);
        conv_w(F, base, in[29], 2048, 128, 0, 128, 128, (bf16*)(ws + SM_W1V), 2048, 0, 1.f);
        conv_w(F, base, in[27], 128, 64, 0, 64, 64, (bf16*)(ws + SM_W2K), 128, 0, 1.f);
        conv_w(F, base, in[30], 128, 64, 0, 64, 64, (bf16*)(ws + SM_W2V), 128, 0, 1.f);
        CONV_MLP(3, base);
        for (int itx = F.vcu; itx < 4; itx += F.G) {
            const int kv = itx >> 1, c = (itx & 1) * 64 + F.lane;
            const float* pe = kv ? in[28] : in[25]; const float* w1 = kv ? in[29] : in[26];
            float s = 0.f;
            for (int i2 = F.wave * 256; i2 < F.wave * 256 + 256; ++i2) s += pe[i2] * w1[(size_t)i2 * 128 + c];
            LAS float* red = (LAS float*)(F.lds + 8 * 8704);
            __syncthreads();
            red[F.wave * 64 + F.lane] = s;
            __syncthreads();
            if (F.wave == 0) { float tsum = 0.f;
#pragma unroll
                for (int w2 = 0; w2 < 8; ++w2) tsum += red[w2 * 64 + F.lane];
                ((float*)(ws + SM_PEB))[kv * 128 + c] = tsum; }
        }
    }
    SEAM(26);
    if (IN(27)) { pg8::EpiNsa E{(bf16*)(ws + NSA_Q), (bf16*)(ws + NSA_KC), (bf16*)(ws + NSA_VC), (bf16*)(ws + NSA_KS), (bf16*)(ws + NSA_VST), (bf16*)(ws + NSA_KW), (bf16*)(ws + NSA_VWT), (float*)(ws + SM_GATES)};
        GEMM_PHASE(pg8::EpiNsa, Hb, D, Wi, D, 2048, D, 0, E); }
    SEAM(27);
    if (IN(28)) nsa_compress_phase(F, (const bf16*)(ws + NSA_KC), (const bf16*)(ws + NSA_VC), (const bf16*)(ws + SM_W1K), (const bf16*)(ws + SM_W1V), (const bf16*)(ws + SM_W2K), (const bf16*)(ws + SM_W2V),
                                   (const float*)(ws + SM_PEB), (bf16*)(ws + SM_KCMP), (bf16*)(ws + SM_VCMPT));
    SEAM(28);
    if (IN(29)) nsa_attn_phase(F, (const bf16*)(ws + NSA_Q), (const bf16*)(ws + SM_KCMP), (const bf16*)(ws + SM_VCMPT), (const bf16*)(ws + NSA_KS), (const bf16*)(ws + NSA_VST), (const bf16*)(ws + NSA_KW), (const bf16*)(ws + NSA_VWT),
                               (const float*)(ws + SM_GATES), (bf16*)(ws + NSA_O));
    SEAM(29);
    if (IN(30)) { pg8::EpiStore<0> E{Hb, D}; GEMM_PHASE(pg8::EpiStore<0>, ws + NSA_O, D, Wo, D, D, D, 0, E); }
    SEAM(30);
    if (IN(31)) norm_phase(F, xout, Hb, xout, Hb, in[2] + 3 * D, in[3] + 3 * D);
    SEAM(31);
    MLP_PHASES(32, 3)
    if (IN(34)) norm_phase(F, xout, Hb, xout, nullptr, in[4] + 3 * D, nullptr);
#undef IN
#undef SEAM
}

#ifndef MK_PER_PHASE
#define MK_PER_PHASE 0
#endif
extern "C" void kernel_launch(void* const* d_in, const int* in_sizes, int n_in, void* d_out, int out_size, void* d_ws, size_t ws_size, hipStream_t stream) {
    static int grid = 0;
    if (grid == 0) {
        if (n_in != 32 || in_sizes[0] != M * D || out_size != M * D || ws_size < WS_END) { fprintf(stderr, "kernel_launch: unexpected shapes / workspace (n_in %d, ws %zu); nothing launched\n", n_in, ws_size); grid = -1; return; }
        int dev = 0, cus = 0, per_cu = 0;
        if (hipGetDevice(&dev) != hipSuccess || hipDeviceGetAttribute(&cus, hipDeviceAttributeMultiprocessorCount, dev) != hipSuccess) { grid = -1; return; }
        if (hipFuncSetAttribute((const void*)trunk_fwd, hipFuncAttributeMaxDynamicSharedMemorySize, LDS_BYTES) != hipSuccess) { fprintf(stderr, "kernel_launch: hipFuncSetAttribute failed\n"); grid = -1; return; }
        if (hipOccupancyMaxActiveBlocksPerMultiprocessor(&per_cu, (const void*)trunk_fwd, NWAVES * 64, LDS_BYTES) != hipSuccess || per_cu < 1)
            fprintf(stderr, "kernel_launch: note: occupancy query reports %d workgroups per CU\n", per_cu);
        (void)hipGetLastError();
        grid = cus;
    }
    if (grid < 0) return;
    if (hipMemsetAsync((char*)d_ws + WS_CTL, 0, CTL_ZERO_BYTES, stream) != hipSuccess) return;
    Args a{};
    for (int i = 0; i < 32; ++i) a.in[i] = (const float*)d_in[i];
    a.out = (float*)d_out; a.ws = (unsigned char*)d_ws;
#if MK_PER_PHASE
    for (int p = 0; p < N_PHASES; ++p) { a.ph_lo = p; a.ph_hi = p + 1; hipLaunchKernelGGL(trunk_fwd, dim3(grid), dim3(NWAVES * 64), LDS_BYTES, stream, a); }
#else
    a.ph_lo = 0; a.ph_hi = N_PHASES;
    hipLaunchKernelGGL(trunk_fwd, dim3(grid), dim3(NWAVES * 64), LDS_BYTES, stream, a);
#endif
}
```

```cpp
#include <hip/hip_runtime.h>
#include <cstdio>
#include <cstdint>
#include <cmath>

namespace pg8 {
#define PG8_LAS __attribute__((address_space(3)))
typedef unsigned short bf16_t;
typedef short bf16x8 __attribute__((ext_vector_type(8)));
typedef float f32x4 __attribute__((ext_vector_type(4)));
typedef unsigned u32x4 __attribute__((ext_vector_type(4)));
typedef unsigned u32x2 __attribute__((ext_vector_type(2)));
constexpr int BM = 256, BK = 64, HALF = 128, HTB = HALF * BK * 2  , STAGE_BYTES = 8 * HTB, NXCD = 8, WGM = 8;

__host__ __device__ __forceinline__ int lds_byte(int r, int c) { const int st = (r >> 4) * 2 + (c >> 5), rr = r & 15, cc = c & 31, ob = rr * 64 + cc * 2; return st * 1024 + (ob ^ (((ob >> 9) & 1) << 5)); }
__host__ __device__ __forceinline__ void stage_rc(int b, int& R, int& C) { const int st = b / 1024, sb = b % 1024, swz = sb ^ (((sb >> 9) & 1) << 5); R = (st >> 1) * 16 + swz / 64; C = (st & 1) * 32 + (swz % 64) / 2; }
__host__ __device__ __forceinline__ int perm32(int rho) { const int n = rho >> 4, i = rho & 15; return 8 * (i >> 2) + 4 * n + (i & 3); }

struct Unit { int pm, pn; };
struct Gemm { const bf16_t* A; const bf16_t* Bt; int M, N, K, lda, ldb; size_t a_pn_step; };

struct StaticOrder {
    int nM, nN, nwg, G, c;
    __host__ __device__ void init(int M, int N, int G_, int c_) { nM = M / BM; nN = N / BM; nwg = nM * nN; G = G_; c = c_; }
    __host__ __device__ bool next(int i, Unit& u) const {
        const long L = (long)i * G + c; if (L >= nwg) return false;
        int wgid = (int)L; { const int q = nwg / NXCD, r = nwg % NXCD, xcd = wgid % NXCD, off = wgid / NXCD; wgid = (xcd < r ? xcd * (q + 1) : r * (q + 1) + (xcd - r) * q) + off; }
        const int nig = WGM * nN, gid = wgid / nig, fm = gid * WGM, gsz = (nM - fm) < WGM ? (nM - fm) : WGM;
        u.pm = fm + ((wgid % nig) % gsz); u.pn = (wgid % nig) / gsz; return true;
    }
    __device__ __forceinline__ void a_ready(const Unit&) const {}
    __device__ __forceinline__ void done(const Unit&) const {}
};

__device__ __forceinline__ unsigned cvt_pk_bf16(float lo, float hi) { unsigned r; asm volatile("v_cvt_pk_bf16_f32 %0, %1, %2" : "=v"(r) : "v"(lo), "v"(hi)); return r; }
__device__ __forceinline__ u32x4 pack8(const f32x4 v0, const f32x4 v1) { u32x4 w; w.x = cvt_pk_bf16(v0[0], v0[1]); w.y = cvt_pk_bf16(v0[2], v0[3]); w.z = cvt_pk_bf16(v1[0], v1[1]); w.w = cvt_pk_bf16(v1[2], v1[3]); return w; }
__device__ __forceinline__ float bf_lo(unsigned w) { return __uint_as_float(w << 16); }
__device__ __forceinline__ float bf_hi(unsigned w) { return __uint_as_float(w & 0xffff0000u); }

template <int ACT> struct EpiStore {
    static constexpr bool PERM = true, AFTER_DRAIN = false;
    bf16_t* O; int ldc;
    __device__ __forceinline__ void operator()(const f32x4 (&acc)[2][2][4][2], const Unit& u, int wr, int wc, int fr, int fq) const {
        const int row0 = u.pm * BM + wr * 64 + fr, col0 = u.pn * BM + wc * 32 + 8 * fq;
#pragma unroll
        for (int ai = 0; ai < 2; ++ai)
#pragma unroll
            for (int m = 0; m < 4; ++m) { bf16_t* rowp = O + (size_t)(row0 + ai * HALF + m * 16) * ldc + col0;
#pragma unroll
                for (int bj = 0; bj < 2; ++bj) { f32x4 v0 = acc[ai][bj][m][0], v1 = acc[ai][bj][m][1];
                    if (ACT == 1) {
#pragma unroll
                        for (int e = 0; e < 4; ++e) { const float a = fmaxf(v0[e], 0.f), b = fmaxf(v1[e], 0.f); v0[e] = a * a; v1[e] = b * b; } }
                    *(u32x4*)(rowp + bj * HALF) = pack8(v0, v1); } }
    }
};

struct EpiRet {
    static constexpr bool PERM = true, AFTER_DRAIN = false;
    bf16_t* O; int ldc;
    __device__ __forceinline__ void operator()(const f32x4 (&acc)[2][2][4][2], const Unit& u, int wr, int wc, int fr, int fq) const {
        const int row0 = u.pm * BM + wr * 64 + fr, col0 = u.pn * BM + wc * 32 + 8 * fq;
        const float lg = __log2f(1.f - exp2f(-5.f - (float)(u.pn & 3)));
        const float sgn = u.pn < 4 ? lg : -lg, mul = u.pn < 4 ? 1.f : 0.0625f;
        const bool scaled = u.pn < 8;
#pragma unroll
        for (int ai = 0; ai < 2; ++ai)
#pragma unroll
            for (int m = 0; m < 4; ++m) { const int row = row0 + ai * HALF + m * 16; bf16_t* rowp = O + (size_t)row * ldc + col0;
                const float sc = scaled ? exp2f(sgn * (float)(row & 63)) * mul : 1.f;
#pragma unroll
                for (int bj = 0; bj < 2; ++bj) *(u32x4*)(rowp + bj * HALF) = pack8(acc[ai][bj][m][0] * sc, acc[ai][bj][m][1] * sc); }
    }
};

struct EpiGla {
    static constexpr bool PERM = true, AFTER_DRAIN = false;
    bf16_t* O; int ldc; const float* bgate;
    __device__ __forceinline__ void operator()(const f32x4 (&acc)[2][2][4][2], const Unit& u, int wr, int wc, int fr, int fq) const {
        const int row0 = u.pm * BM + wr * 64 + fr, col0 = u.pn * BM + wc * 32 + 8 * fq;
        const bool gate = u.pn >= 12;
        f32x4 bv[2][2];
#pragma unroll
        for (int bj = 0; bj < 2; ++bj)
#pragma unroll
            for (int n = 0; n < 2; ++n) bv[bj][n] = gate ? *(const f32x4*)(bgate + (col0 - 3072) + bj * HALF + 4 * n) : (f32x4){0.f, 0.f, 0.f, 0.f};
#pragma unroll
        for (int ai = 0; ai < 2; ++ai)
#pragma unroll
            for (int m = 0; m < 4; ++m) { bf16_t* rowp = O + (size_t)(row0 + ai * HALF + m * 16) * ldc + col0;
#pragma unroll
                for (int bj = 0; bj < 2; ++bj) { f32x4 v0 = acc[ai][bj][m][0], v1 = acc[ai][bj][m][1];
                    if (gate) {
#pragma unroll
                        for (int e = 0; e < 4; ++e) {
                            const float z0 = v0[e] + bv[bj][0][e], z1 = v1[e] + bv[bj][1][e];
                            v0[e] = (fminf(z0, 0.f) - log1pf(__expf(-fabsf(z0)))) * 0.0625f;
                            v1[e] = (fminf(z1, 0.f) - log1pf(__expf(-fabsf(z1)))) * 0.0625f; } }
                    *(u32x4*)(rowp + bj * HALF) = pack8(v0, v1); } }
    }
};

struct EpiNsa {
    static constexpr bool PERM = true, AFTER_DRAIN = false;
    bf16_t* Q; bf16_t* KC; bf16_t* VC; bf16_t* KS; bf16_t* VST; bf16_t* KW; bf16_t* VWT; float* GATES;
    template <bool VTRANS> __device__ __forceinline__ void kv_store(const f32x4 (&acc)[2][2][4][2], bf16_t* Kt, bf16_t* Vt, int row0, int c8) const {
        const int g = c8 >> 6, d = c8 & 63;
#pragma unroll
        for (int ai = 0; ai < 2; ++ai)
#pragma unroll
            for (int m = 0; m < 4; ++m) {
                const int row = row0 + ai * HALF + m * 16, b = row >> 12, t = row & 4095;
                const size_t bg = (size_t)(b * 2 + g);
                *(u32x4*)(Kt + (bg * 4096 + t) * 64 + d) = pack8(acc[ai][0][m][0], acc[ai][0][m][1]);
                const u32x4 w = pack8(acc[ai][1][m][0], acc[ai][1][m][1]);
                if (!VTRANS) *(u32x4*)(Vt + (bg * 4096 + t) * 64 + d) = w;
                else {
                    bf16_t* vp = Vt + (bg * 64 + d) * 4096 + t;
                    vp[0 * 4096] = (bf16_t)(w.x & 0xffffu); vp[1 * 4096] = (bf16_t)(w.x >> 16);
                    vp[2 * 4096] = (bf16_t)(w.y & 0xffffu); vp[3 * 4096] = (bf16_t)(w.y >> 16);
                    vp[4 * 4096] = (bf16_t)(w.z & 0xffffu); vp[5 * 4096] = (bf16_t)(w.z >> 16);
                    vp[6 * 4096] = (bf16_t)(w.w & 0xffffu); vp[7 * 4096] = (bf16_t)(w.w >> 16);
                }
            }
    }
    __device__ __forceinline__ void operator()(const f32x4 (&acc)[2][2][4][2], const Unit& u, int wr, int wc, int fr, int fq) const {
        const int row0 = u.pm * BM + wr * 64 + fr, c8 = wc * 32 + 8 * fq;
        if (u.pn < 4) {
#pragma unroll
            for (int ai = 0; ai < 2; ++ai)
#pragma unroll
                for (int m = 0; m < 4; ++m) { bf16_t* rowp = Q + (size_t)(row0 + ai * HALF + m * 16) * 1024 + u.pn * BM + c8;
#pragma unroll
                    for (int bj = 0; bj < 2; ++bj) *(u32x4*)(rowp + bj * HALF) = pack8(acc[ai][bj][m][0], acc[ai][bj][m][1]); }
        } else if (u.pn == 4) { kv_store<false>(acc, KC, VC, row0, c8);
        } else if (u.pn == 5) { kv_store<true>(acc, KS, VST, row0, c8);
        } else if (u.pn == 6) { kv_store<true>(acc, KW, VWT, row0, c8);
        } else {
            if (c8 < 48) {
#pragma unroll
                for (int ai = 0; ai < 2; ++ai)
#pragma unroll
                    for (int m = 0; m < 4; ++m) { float* gp = GATES + (size_t)(row0 + ai * HALF + m * 16) * 48 + c8;
                        f32x4 v0 = acc[ai][0][m][0], v1 = acc[ai][0][m][1];
#pragma unroll
                        for (int e = 0; e < 4; ++e) { v0[e] = 1.f / (1.f + __expf(-v0[e])); v1[e] = 1.f / (1.f + __expf(-v1[e])); }
                        *(f32x4*)gp = v0; *(f32x4*)(gp + 4) = v1; }
            }
        }
    }
};

template <class Epi, class Sched, bool ALIGN_EPI = false, bool SP2 = false>
__device__ __forceinline__ void gemm_phase(PG8_LAS unsigned char* lds, const Gemm g, const Sched& S, const Epi& E) {
    const int tid = threadIdx.x, wid = __builtin_amdgcn_readfirstlane(tid >> 6), lane = tid & 63, wr = wid >> 2, wc = wid & 3, fr = lane & 15, fq = lane >> 4;
    const int K = g.K, nt = K / BK;
    unsigned voffA[2], voffB[2];
#pragma unroll
    for (int i = 0; i < 2; ++i) { int R, C; stage_rc(tid * 16 + i * 8192, R, C); const int Rb = Epi::PERM ? ((R & ~31) + perm32(R & 31)) : R;
        voffA[i] = (unsigned)(R * g.lda + C) * 2u; voffB[i] = (unsigned)(Rb * g.ldb + C) * 2u; }
    const size_t kstep = (size_t)(BK * 2);
    const size_t hstepA = (size_t)HALF * g.lda * 2, hstepB = (size_t)HALF * g.ldb * 2;
    const size_t tstepA = 2 * hstepA, tstepB = 2 * hstepB;
    const unsigned ldsw = (unsigned)wid * 1024u;
    const int aoff = lds_byte(wr * 64 + fr, fq * 8), boff = lds_byte(wc * 32 + fr, fq * 8);
#define PG8_SA(b, h) (((b) * 2 + (h)) * HTB)
#define PG8_SB(b, h) ((4 + (b) * 2 + (h)) * HTB)
#define PG8_STAGE(bufoff, gbase, voff) do { _Pragma("unroll") for (int _i = 0; _i < 2; ++_i) \
        __builtin_amdgcn_global_load_lds((const unsigned*)((const char*)(gbase) + (voff)[_i]), (PG8_LAS unsigned*)(lds + (bufoff) + ldsw + _i * 8192), 16, 0, 0); } while (0)
#define PG8_LDA(dst, b, h) do { _Pragma("unroll") for (int m = 0; m < 4; ++m) _Pragma("unroll") for (int k = 0; k < 2; ++k) dst[m][k] = *(const PG8_LAS bf16x8*)(lds + PG8_SA(b, h) + aoff + m * 2048 + k * 1024); } while (0)
#define PG8_LDB(dst, b, h) do { _Pragma("unroll") for (int n = 0; n < 2; ++n) _Pragma("unroll") for (int k = 0; k < 2; ++k) dst[n][k] = *(const PG8_LAS bf16x8*)(lds + PG8_SB(b, h) + boff + n * 2048 + k * 1024); } while (0)
#define PG8_MMA(ai, bj, At, Bt) do { __builtin_amdgcn_s_setprio(1); _Pragma("unroll") for (int m = 0; m < 4; ++m) _Pragma("unroll") for (int n = 0; n < 2; ++n) _Pragma("unroll") for (int k = 0; k < 2; ++k) \
        acc[ai][bj][m][n] = __builtin_amdgcn_mfma_f32_16x16x32_bf16(Bt[n][k], At[m][k], acc[ai][bj][m][n], 0, 0, 0); __builtin_amdgcn_s_setprio(0); } while (0)
#define PG8_WAIT_V(n) asm volatile("s_waitcnt vmcnt(" #n ")" ::: "memory")
#define PG8_WAIT_L(n) asm volatile("s_waitcnt lgkmcnt(" #n ")" ::: "memory")
#define PG8_BAR __builtin_amdgcn_s_barrier()
#define PG8_SCHED __builtin_amdgcn_sched_barrier(0)
    Unit cur, nxt; int ui = 0;
    if (!S.next(0, cur)) return;
    f32x4 acc[2][2][4][2];
#pragma unroll
    for (int a = 0; a < 2; ++a)
#pragma unroll
        for (int b = 0; b < 2; ++b)
#pragma unroll
            for (int m = 0; m < 4; ++m)
#pragma unroll
                for (int n = 0; n < 2; ++n) acc[a][b][m][n] = (f32x4){0.f, 0.f, 0.f, 0.f};
    bf16x8 At[4][2], B0[2][2], B1[2][2];
    const char* cA = (const char*)g.A + (size_t)cur.pm * tstepA + (size_t)cur.pn * g.a_pn_step; const char* cB = (const char*)g.Bt + (size_t)cur.pn * tstepB;
    S.a_ready(cur);
    if constexpr (SP2) {
        PG8_STAGE(PG8_SB(0, 0), cB, voffB); PG8_STAGE(PG8_SB(0, 1), cB + hstepB, voffB); PG8_STAGE(PG8_SA(0, 0), cA, voffA); PG8_STAGE(PG8_SA(0, 1), cA + hstepA, voffA);
        if (wr == 1) PG8_BAR;
        PG8_WAIT_V(2); PG8_BAR;
        PG8_STAGE(PG8_SB(1, 0), cB + kstep, voffB); PG8_STAGE(PG8_SA(1, 0), cA + kstep, voffA); PG8_STAGE(PG8_SB(1, 1), cB + hstepB + kstep, voffB);
        PG8_WAIT_V(6); PG8_BAR;
    } else {
        PG8_STAGE(PG8_SB(0, 0), cB, voffB); PG8_STAGE(PG8_SA(0, 0), cA, voffA); PG8_STAGE(PG8_SB(0, 1), cB + hstepB, voffB); PG8_STAGE(PG8_SA(0, 1), cA + hstepA, voffA);
        if (wr == 1) PG8_BAR;
        PG8_WAIT_V(4); PG8_BAR;
        PG8_STAGE(PG8_SB(1, 0), cB + kstep, voffB); PG8_STAGE(PG8_SA(1, 0), cA + kstep, voffA); PG8_STAGE(PG8_SB(1, 1), cB + hstepB + kstep, voffB);
        PG8_WAIT_V(6); PG8_BAR;
    }
    for (;;) {
        const bool has_next = S.next(ui + 1, nxt);
        const char* nA = has_next ? (const char*)g.A + (size_t)nxt.pm * tstepA + (size_t)nxt.pn * g.a_pn_step : cA; const char* nB = has_next ? (const char*)g.Bt + (size_t)nxt.pn * tstepB : cB;
        for (int t = 0; t < nt; t += 2) {
            const bool last = (t == nt - 2);
            const char* a1 = cA + (size_t)(t + 1) * kstep;
            const char* a2 = last ? nA : cA + (size_t)(t + 2) * kstep; const char* b2 = last ? nB : cB + (size_t)(t + 2) * kstep;
            const char* a3 = a2 + kstep; const char* b3 = b2 + kstep;
            if (last && has_next) S.a_ready(nxt);
            if constexpr (SP2) {
            PG8_LDB(B0, 0, 0); PG8_LDB(B1, 0, 1); PG8_SCHED; PG8_LDA(At, 0, 0); PG8_STAGE(PG8_SA(1, 1), a1 + hstepA, voffA);
            PG8_WAIT_V(8); PG8_WAIT_L(0); PG8_BAR; PG8_MMA(0, 0, At, B0); PG8_MMA(0, 1, At, B1); PG8_BAR; PG8_SCHED;
            PG8_LDA(At, 0, 1); PG8_STAGE(PG8_SB(0, 0), b2, voffB); PG8_STAGE(PG8_SB(0, 1), b2 + hstepB, voffB); PG8_STAGE(PG8_SA(0, 0), a2, voffA);
            PG8_WAIT_V(8); PG8_WAIT_L(0); PG8_BAR; PG8_MMA(1, 0, At, B0); PG8_MMA(1, 1, At, B1); PG8_BAR; PG8_SCHED;
            PG8_LDB(B0, 1, 0); PG8_LDB(B1, 1, 1); PG8_SCHED; PG8_LDA(At, 1, 0); PG8_STAGE(PG8_SA(0, 1), a2 + hstepA, voffA);
            PG8_WAIT_V(8); PG8_WAIT_L(0); PG8_BAR; PG8_MMA(0, 0, At, B0); PG8_MMA(0, 1, At, B1); PG8_BAR; PG8_SCHED;
            PG8_LDA(At, 1, 1); PG8_STAGE(PG8_SB(1, 0), b3, voffB); PG8_STAGE(PG8_SB(1, 1), b3 + hstepB, voffB); PG8_STAGE(PG8_SA(1, 0), a3, voffA);
            PG8_WAIT_V(8); PG8_WAIT_L(0); PG8_BAR; PG8_MMA(1, 0, At, B0); PG8_MMA(1, 1, At, B1); PG8_BAR; PG8_SCHED;
            } else {
            PG8_LDB(B0, 0, 0); PG8_SCHED; PG8_LDA(At, 0, 0); PG8_STAGE(PG8_SA(1, 1), a1 + hstepA, voffA);
            PG8_WAIT_L(8); PG8_BAR; PG8_WAIT_L(0); PG8_MMA(0, 0, At, B0); PG8_BAR; PG8_SCHED;
            PG8_LDB(B1, 0, 1); PG8_STAGE(PG8_SB(0, 0), b2, voffB);
            PG8_BAR; PG8_WAIT_L(0); PG8_MMA(0, 1, At, B1); PG8_BAR;
            PG8_LDA(At, 0, 1); PG8_STAGE(PG8_SA(0, 0), a2, voffA);
            PG8_BAR; PG8_WAIT_L(0); PG8_MMA(1, 0, At, B0); PG8_BAR; PG8_SCHED;
            PG8_STAGE(PG8_SB(0, 1), b2 + hstepB, voffB);
            PG8_WAIT_V(6); PG8_BAR; PG8_MMA(1, 1, At, B1); PG8_BAR;
            PG8_LDB(B0, 1, 0); PG8_SCHED; PG8_LDA(At, 1, 0); PG8_STAGE(PG8_SA(0, 1), a2 + hstepA, voffA);
            PG8_WAIT_L(8); PG8_BAR; PG8_WAIT_L(0); PG8_MMA(0, 0, At, B0); PG8_BAR; PG8_SCHED;
            PG8_LDB(B1, 1, 1); PG8_STAGE(PG8_SB(1, 0), b3, voffB);
            PG8_BAR; PG8_WAIT_L(0); PG8_MMA(0, 1, At, B1); PG8_BAR;
            PG8_LDA(At, 1, 1); PG8_STAGE(PG8_SA(1, 0), a3, voffA);
            PG8_BAR; PG8_WAIT_L(0); PG8_MMA(1, 0, At, B0); PG8_BAR; PG8_SCHED;
            PG8_STAGE(PG8_SB(1, 1), b3 + hstepB, voffB);
            PG8_WAIT_V(6); PG8_BAR; PG8_MMA(1, 1, At, B1); PG8_BAR;
            }
        }
        if constexpr (ALIGN_EPI) { if (wr == 0) PG8_BAR; }
        if constexpr (!Epi::AFTER_DRAIN) { E(acc, cur, wr, wc, fr, fq); S.done(cur); }
        if (!has_next) break;
#pragma unroll
        for (int a = 0; a < 2; ++a)
#pragma unroll
            for (int b = 0; b < 2; ++b)
#pragma unroll
                for (int m = 0; m < 4; ++m)
#pragma unroll
                    for (int n = 0; n < 2; ++n) acc[a][b][m][n] = (f32x4){0.f, 0.f, 0.f, 0.f};
        cur = nxt; cA = nA; cB = nB; ++ui;
        if constexpr (ALIGN_EPI) { if (wr == 1) PG8_BAR; }
    }
    PG8_WAIT_V(0);
    if constexpr (!ALIGN_EPI) { if (wr == 0) PG8_BAR; }
    PG8_BAR;
    if constexpr (Epi::AFTER_DRAIN) { E.fused(acc, cur, wr, wc, fr, fq, lds, wid, lane); S.done(cur); }
#undef PG8_SA
#undef PG8_SB
#undef PG8_STAGE
#undef PG8_LDA
#undef PG8_LDB
#undef PG8_MMA
#undef PG8_WAIT_V
#undef PG8_WAIT_L
#undef PG8_BAR
#undef PG8_SCHED
}
}

constexpr int BATCH = 8, SEQ = 4096, D = 1024, FF = 4096;
constexpr int M = BATCH * SEQ;
constexpr float NORM_EPS = 1e-6f;
constexpr int NWAVES = 8;
constexpr float LOG2E = 1.4426950408889634f;

constexpr size_t MiB = 1u << 20;
constexpr size_t WS_CTL = 0, CTL_ZERO_BYTES = 64 * 1024;
constexpr size_t WS_WIN = 1 * MiB, WS_WOUT = 13 * MiB, WS_WUP = 17 * MiB, WS_WDN = 25 * MiB;
constexpr size_t WS_H = 33 * MiB;
constexpr size_t WS_BIG = 97 * MiB;
constexpr size_t WS_SMALL = 481 * MiB;
constexpr size_t WS_END = 512 * MiB;
constexpr size_t SM_LRUW = WS_SMALL;
constexpr size_t SM_SCANP = WS_SMALL + 1 * MiB, SM_SCANE = WS_SMALL + 3 * MiB;
constexpr size_t SM_W1K = WS_SMALL + 5 * MiB, SM_W1V = SM_W1K + 512 * 1024;
constexpr size_t SM_W2K = WS_SMALL + 6 * MiB, SM_W2V = SM_W2K + 16 * 1024, SM_PEB = SM_W2V + 16 * 1024;
constexpr size_t SM_KCMP = WS_SMALL + 7 * MiB, SM_VCMPT = SM_KCMP + 512 * 1024;
constexpr size_t SM_GATES = WS_SMALL + 8 * MiB;
constexpr size_t SM_GLAW = WS_SMALL + 16 * MiB;
constexpr size_t LRU_XY = WS_BIG, LRU_XC = WS_BIG + 128 * MiB, LRU_GP = WS_BIG + 192 * MiB, LRU_HS = WS_BIG + 320 * MiB;
constexpr size_t NSA_Q = WS_BIG, NSA_KC = WS_BIG + 64 * MiB, NSA_VC = NSA_KC + 8 * MiB, NSA_KS = NSA_KC + 16 * MiB, NSA_VST = NSA_KC + 24 * MiB,
                 NSA_KW = NSA_KC + 32 * MiB, NSA_VWT = NSA_KC + 40 * MiB, NSA_O = WS_BIG + 128 * MiB;
constexpr int CW_BAR = 1024;

constexpr int RING_OFF = 0, SCR_BYTES = 143360;
constexpr int LDSCTL_OFF = SCR_BYTES;
constexpr int LDS_BYTES = 147456;

#define GAS __attribute__((address_space(1)))
#define LAS __attribute__((address_space(3)))
typedef unsigned short bf16;
typedef unsigned v4u __attribute__((ext_vector_type(4)));
typedef unsigned v2u __attribute__((ext_vector_type(2)));
typedef float f32x4 __attribute__((ext_vector_type(4)));
typedef float f32x2 __attribute__((ext_vector_type(2)));
typedef float f32x16 __attribute__((ext_vector_type(16)));
typedef short bf16x8 __attribute__((ext_vector_type(8)));
typedef short s16x4 __attribute__((ext_vector_type(4)));
#define MFMA32(a, b, c) __builtin_amdgcn_mfma_f32_32x32x16_bf16((a), (b), (c), 0, 0, 0)
__device__ __forceinline__ unsigned f2bf(float f) { unsigned u = __builtin_bit_cast(unsigned, f); return (u + 0x7fffu + ((u >> 16) & 1u)) >> 16; }
__device__ __forceinline__ unsigned pk2(float lo, float hi) { return f2bf(lo) | (f2bf(hi) << 16); }
__device__ __forceinline__ float bflo(unsigned w) { return __uint_as_float(w << 16); }
__device__ __forceinline__ float bfhi(unsigned w) { return __uint_as_float(w & 0xffff0000u); }
__device__ __forceinline__ float bf1(bf16 v) { return __uint_as_float((unsigned)v << 16); }
__device__ __forceinline__ float gelu_tanh(float x) { const float z = 0.7978845608028654f * (x + 0.044715f * x * x * x); const float t = 1.f - 2.f / (1.f + __expf(2.f * z)); return 0.5f * x * (1.f + t); }
__device__ __forceinline__ float silu(float x) { return x / (1.f + __expf(-x)); }

#define XB_TMO      128
#define XB_XCNT(j)  (256  + 64 * (j))
#define XB_XSUB(j)  (1280 + 64 * (j))
#define XB_XGEN(j)  (2304 + 64 * (j))
#define XB_TOP      3328
#define XB_TOPGEN   3392
#define XCD_BAR_WORDS 3456
#define XB_SPIN_CAP (1u << 18)
#define LAS __attribute__((address_space(3)))

__device__ __forceinline__ unsigned xb_ld(unsigned* p)              { return __hip_atomic_load(p, __ATOMIC_RELAXED, __HIP_MEMORY_SCOPE_AGENT); }
__device__ __forceinline__ unsigned xb_add(unsigned* p, unsigned v) { return __hip_atomic_fetch_add(p, v, __ATOMIC_RELAXED, __HIP_MEMORY_SCOPE_AGENT); }
__device__ __forceinline__ unsigned xb_xcc_id() { return (unsigned)__builtin_amdgcn_s_getreg((3 << 11) | 20) & 0xFu; }
#define XB_SPIN(cond, bar) do { unsigned _sp = 0; while (cond) { __builtin_amdgcn_s_sleep(1); \
    if ((++_sp & 255u) == 0u) { if (xb_ld(&(bar)[XB_TMO])) break; if (_sp > XB_SPIN_CAP) { atomicAdd(&(bar)[XB_TMO], 1u); break; } } } } while (0)

struct XcdBarrier {
    unsigned* bar; unsigned x;
    volatile LAS unsigned* st;
};

__device__ __forceinline__ XcdBarrier xcd_barrier_post(unsigned* bar, volatile LAS unsigned* st) {
    XcdBarrier b; b.bar = bar; b.x = xb_xcc_id(); b.st = st;
    if (threadIdx.x == 0) (void)xb_add(&bar[XB_XCNT(b.x)], 1u);
    return b;
}
__device__ __forceinline__ void xcd_barrier_complete(unsigned* bar, unsigned x, unsigned& nloc, unsigned& nx) {
    const unsigned G = gridDim.x * gridDim.y * gridDim.z;
    unsigned sum, cnt, mine, sp = 0u;
    for (;;) {
        sum = 0u; cnt = 0u; mine = 0u;
#pragma unroll
        for (unsigned j = 0; j < 16; ++j) { const unsigned c = xb_ld(&bar[XB_XCNT(j)]); sum += c; cnt += (c > 0u) ? 1u : 0u; mine = (j == x) ? c : mine; }
        if (sum == G) break;
        __builtin_amdgcn_s_sleep(1);
        if ((++sp & 255u) == 0u) { if (xb_ld(&bar[XB_TMO])) break; if (sp > XB_SPIN_CAP) { atomicAdd(&bar[XB_TMO], 1u); break; } }
    }
    nloc = mine > 0u ? mine : 1u; nx = cnt > 0u ? cnt : 1u;
}

__device__ __forceinline__ void xcd_barrier(const XcdBarrier& b) {
    asm volatile("s_waitcnt vmcnt(0)" ::: "memory");
    __syncthreads();
    if (threadIdx.x == 0) {
        unsigned* bar = b.bar;
        __builtin_amdgcn_s_waitcnt(0);
        unsigned nloc = b.st[0], nx = b.st[1];
        if (nloc == 0u) { xcd_barrier_complete(bar, b.x, nloc, nx); b.st[0] = nloc; b.st[1] = nx; }
        const unsigned old = xb_add(&bar[XB_XSUB(b.x)], 1u);
        const unsigned gen = old / nloc;
        if (old + 1u == (gen + 1u) * nloc) {
            __builtin_amdgcn_fence(__ATOMIC_RELEASE, "agent");
            asm volatile("s_waitcnt vmcnt(0)" ::: "memory");
            const unsigned og = xb_add(&bar[XB_TOP], 1u);
            const unsigned tg = og / nx;
            if (og + 1u == (tg + 1u) * nx) xb_add(&bar[XB_TOPGEN], 1u);
            else XB_SPIN(xb_ld(&bar[XB_TOPGEN]) == tg, bar);
            __builtin_amdgcn_fence(__ATOMIC_ACQUIRE, "agent");
            xb_add(&bar[XB_XGEN(b.x)], 1u);
            asm volatile("s_waitcnt vmcnt(0)" ::: "memory");
        } else {
            XB_SPIN(xb_ld(&bar[XB_XGEN(b.x)]) == gen, bar);
            __builtin_amdgcn_fence(__ATOMIC_ACQUIRE, "agent");
            asm volatile("s_waitcnt vmcnt(0)" ::: "memory");
        }
    }
    __syncthreads();
}

struct Frame {
    LAS unsigned char* lds;
    int tid, lane, wave;
    int vcu, G;
    unsigned char* ws;
    int dry;
};

__device__ __forceinline__ bool frame_refresh(Frame& F) { int tz = threadIdx.x; asm volatile("" : "+v"(tz)); F.tid = tz; F.lane = tz & 63; return true; }
__device__ __forceinline__ float wave_sum(float v) {
#pragma unroll
    for (int o = 1; o < 64; o <<= 1) v += __shfl_xor(v, o);
    return v;
}
__device__ __forceinline__ float grp16_sum(float v) {
#pragma unroll
    for (int o = 1; o < 16; o <<= 1) v += __shfl_xor(v, o);
    return v;
}

__device__ __forceinline__ void conv_w(Frame& F, int& base, const float* W, int K, int ldw, int n_src0, int ncols, int n_valid, bf16* WT, int ldk, int row_off, float scale) {
    LAS float* scr = (LAS float*)(F.lds + F.wave * 8704);
    const int gw = F.vcu * NWAVES + F.wave, NGW = F.G * NWAVES, lane = F.lane;
    const int nblk = ncols / 32, items = (K / 64) * nblk;
    int start = (gw - base % NGW + NGW) % NGW; base += items;
    for (int it = start; it < items; it += NGW) {
        const int kb = it / nblk, nb = it % nblk, k0 = 64 * kb, n0 = 32 * nb;
        const int nn = n_src0 + n0 + (lane & 31); const bool ok = nn < n_valid;
#pragma unroll 8
        for (int i = 0; i < 32; ++i) { const int kk = 2 * i + (lane >> 5); scr[kk * 33 + (lane & 31)] = ok ? W[(size_t)(k0 + kk) * ldw + nn] * scale : 0.f; }
        asm volatile("s_waitcnt lgkmcnt(0)" ::: "memory");
        const int c = lane & 7;
#pragma unroll
        for (int j = 0; j < 4; ++j) { const int n = (lane >> 3) + 8 * j; const LAS float* s = scr + (8 * c) * 33 + n;
            v4u o; o.x = pk2(s[0 * 33], s[1 * 33]); o.y = pk2(s[2 * 33], s[3 * 33]); o.z = pk2(s[4 * 33], s[5 * 33]); o.w = pk2(s[6 * 33], s[7 * 33]);
            *(v4u*)(WT + (size_t)(row_off + n0 + n) * ldk + k0 + 8 * c) = o; }
        asm volatile("s_waitcnt lgkmcnt(0)" ::: "memory");
    }
}

__device__ __forceinline__ void norm_phase(Frame& F, const float* xin, const bf16* Y, float* xout, bf16* H, const float* gpost, const float* gpre) {
    const int gw = F.vcu * NWAVES + F.wave, NGW = F.G * NWAVES, lane = F.lane;
    for (int m = gw; m < M; m += NGW) {
        const f32x4* xr = (const f32x4*)(xin + (size_t)m * D) + lane;
        f32x4 v[4];
#pragma unroll
        for (int j = 0; j < 4; ++j) v[j] = xr[64 * j];
        if (Y) {
            const v2u* yr = (const v2u*)(Y + (size_t)m * D) + lane;
            f32x4 y[4]; float ss = 0.f;
#pragma unroll
            for (int j = 0; j < 4; ++j) { const v2u w = yr[64 * j]; y[j] = (f32x4){bflo(w.x), bfhi(w.x), bflo(w.y), bfhi(w.y)}; ss += (y[j].x * y[j].x + y[j].y * y[j].y) + (y[j].z * y[j].z + y[j].w * y[j].w); }
            const float rstd = rsqrtf(wave_sum(ss) * (1.f / D) + NORM_EPS);
#pragma unroll
            for (int j = 0; j < 4; ++j) { const f32x4 g = *((const f32x4*)gpost + lane + 64 * j); v[j] = v[j] + y[j] * rstd * g; }
        }
        if (xout && !F.dry) { f32x4* xo = (f32x4*)(xout + (size_t)m * D) + lane;
#pragma unroll
            for (int j = 0; j < 4; ++j) xo[64 * j] = v[j]; }
        if (H && !F.dry) {
            float ss = 0.f;
#pragma unroll
            for (int j = 0; j < 4; ++j) ss += (v[j].x * v[j].x + v[j].y * v[j].y) + (v[j].z * v[j].z + v[j].w * v[j].w);
            const float rstd = rsqrtf(wave_sum(ss) * (1.f / D) + NORM_EPS);
            v2u* ho = (v2u*)(H + (size_t)m * D) + lane;
#pragma unroll
            for (int j = 0; j < 4; ++j) { const f32x4 g = *((const f32x4*)gpre + lane + 64 * j); const f32x4 o = v[j] * rstd * g;
                v2u w; w.x = pk2(o.x, o.y); w.y = pk2(o.z, o.w); ho[64 * j] = w; }
        }
    }
}

template <int DK, int DV, int CS, bool ISGLA>
__device__ __forceinline__ void recur_phase(Frame& F, bf16* base, int ld, int qoff, int koff, int voff, int laoff, float kscale) {
    constexpr int NS = DV / CS, NDG = 512 / CS, DPT = DK / NDG, TB = 16, NT = ISGLA ? 3 : 2, NB = SEQ / TB;
    constexpr int STG = NT * TB * DK, VST = TB * CS, RED = NDG * TB * CS;
    static_assert((2 * STG + 2 * VST + 2 * RED) * 4 <= SCR_BYTES, "recurrent phase LDS");
    LAS float* stage = (LAS float*)F.lds; LAS float* vst = stage + 2 * STG; LAS float* red = vst + 2 * VST;
    const int tid = F.tid, c = tid % CS, dg = tid / CS;
    constexpr int QCH = TB * DK / 8, VCH = TB * CS / 8;
    const bool ldq = tid < QCH, ldv = tid < VCH;
    const int qt_ = tid / (DK / 8), qd = (tid % (DK / 8)) * 8;
    const int vt_ = tid / (CS / 8), vc_ = (tid % (CS / 8)) * 8;
    for (int it = F.vcu; it < 32 * NS; it += F.G) {
        const int bh = it / NS, sl = it % NS, b = bh >> 2, h = bh & 3;
        bf16* rowbase = base + (size_t)b * SEQ * ld;
        const bf16* qp = rowbase + qoff + h * DK; const bf16* kp = rowbase + koff + h * DK; const bf16* lap = rowbase + laoff + h * DK;
        bf16* vp = rowbase + voff + h * DV + sl * CS;
        const float gamma = 1.f - exp2f(-5.f - (float)h);
        f32x2 S[DPT / 2];
#pragma unroll
        for (int i = 0; i < DPT / 2; ++i) S[i] = (f32x2){0.f, 0.f};
        v4u rq = {0, 0, 0, 0}, rk = {0, 0, 0, 0}, rl = {0, 0, 0, 0}, rv = {0, 0, 0, 0};
#define RC_GLOAD(n_) do { \
            if (ldq) { const size_t o_ = (size_t)((n_) * TB + qt_) * ld + qd; rq = *(const v4u*)(qp + o_); rk = *(const v4u*)(kp + o_); if (ISGLA) rl = *(const v4u*)(lap + o_); } \
            if (ldv) { rv = *(const v4u*)(vp + (size_t)((n_) * TB + vt_) * ld + vc_); } } while (0)
#define RC_SWRITE(buf_) do { \
            LAS float* st_ = stage + (buf_) * STG; \
            if (ldq) { \
                LAS float* q_ = st_ + qt_ * DK + qd; LAS float* k_ = st_ + TB * DK + qt_ * DK + qd; \
                *(LAS f32x4*)q_ = (f32x4){bflo(rq.x), bfhi(rq.x), bflo(rq.y), bfhi(rq.y)}; *(LAS f32x4*)(q_ + 4) = (f32x4){bflo(rq.z), bfhi(rq.z), bflo(rq.w), bfhi(rq.w)}; \
                *(LAS f32x4*)k_ = (f32x4){bflo(rk.x), bfhi(rk.x), bflo(rk.y), bfhi(rk.y)} * kscale; *(LAS f32x4*)(k_ + 4) = (f32x4){bflo(rk.z), bfhi(rk.z), bflo(rk.w), bfhi(rk.w)} * kscale; \
                if (ISGLA) { LAS float* a_ = st_ + 2 * TB * DK + qt_ * DK + qd; \
                    *(LAS f32x4*)a_ = (f32x4){__expf(bflo(rl.x)), __expf(bfhi(rl.x)), __expf(bflo(rl.y)), __expf(bfhi(rl.y))}; \
                    *(LAS f32x4*)(a_ + 4) = (f32x4){__expf(bflo(rl.z)), __expf(bfhi(rl.z)), __expf(bflo(rl.w)), __expf(bfhi(rl.w))}; } \
            } \
            if (ldv) { LAS float* v_ = vst + (buf_) * VST + vt_ * CS + vc_; \
                *(LAS f32x4*)v_ = (f32x4){bflo(rv.x), bfhi(rv.x), bflo(rv.y), bfhi(rv.y)}; *(LAS f32x4*)(v_ + 4) = (f32x4){bflo(rv.z), bfhi(rv.z), bflo(rv.w), bfhi(rv.w)}; } } while (0)
        __syncthreads();
        RC_GLOAD(0); RC_SWRITE(0);
        __syncthreads();
        for (int n = 0; n < NB; ++n) {
            const int cur = n & 1;
            if (n + 1 < NB) RC_GLOAD(n + 1);
            const LAS float* qs = stage + cur * STG + dg * DPT; const LAS float* ks = qs + TB * DK; const LAS float* as = qs + 2 * TB * DK;
            const LAS float* vs = vst + cur * VST + c;
            LAS float* rd = red + cur * RED + dg * TB * CS + c;
#pragma unroll
            for (int t = 0; t < TB; ++t) {
                const float vv = vs[t * CS];
                f32x2 acc = {0.f, 0.f};
#pragma unroll
                for (int i = 0; i < DPT; i += 4) {
                    const f32x4 k4 = *(const LAS f32x4*)(ks + t * DK + i), q4 = *(const LAS f32x4*)(qs + t * DK + i);
                    f32x2 d0, d1;
                    if (ISGLA) { const f32x4 a4 = *(const LAS f32x4*)(as + t * DK + i); d0 = (f32x2){a4.x, a4.y}; d1 = (f32x2){a4.z, a4.w}; } else { d0 = (f32x2){gamma, gamma}; d1 = d0; }
                    S[i / 2] = S[i / 2] * d0 + (f32x2){k4.x, k4.y} * vv; acc += (f32x2){q4.x, q4.y} * S[i / 2];
                    S[i / 2 + 1] = S[i / 2 + 1] * d1 + (f32x2){k4.z, k4.w} * vv; acc += (f32x2){q4.z, q4.w} * S[i / 2 + 1];
                }
                rd[t * CS] = acc.x + acc.y;
            }
            if (n + 1 < NB) RC_SWRITE(cur ^ 1);
            __syncthreads();
#pragma unroll
            for (int rep = 0; rep < (TB * CS + 511) / 512; ++rep) {
                const int idx = tid + rep * 512;
                if (idx < TB * CS) {
                    const LAS float* rr = red + cur * RED + idx; float s = 0.f;
#pragma unroll
                    for (int g = 0; g < NDG; ++g) s += rr[g * TB * CS];
                    const int t = idx / CS, cc = idx % CS;
                    if (!F.dry) vp[(size_t)(n * TB + t) * ld + cc] = (bf16)f2bf(s);
                }
            }
        }
    }
    __syncthreads();
}

__device__ __forceinline__ bf16x8 tr_frag(const LAS bf16* p) {
    const s16x4 lo = __builtin_bit_cast(s16x4, __builtin_amdgcn_ds_read_tr16_b64_v4i16((LAS s16x4*)p));
    return (bf16x8){lo[0], lo[1], lo[2], lo[3], 0, 0, 0, 0};
}
template <int DK, int DV, bool ISGLA>
__device__ __forceinline__ void chunk_phase(Frame& F, bf16* base, int ld, int qoff, int koff, int voff, const float* Wdec) {
    constexpr int C = 64, NS = DV / 256, NDT = DK / 32, QP = DK + 8, VP = 256 + 8, AP = 72;
    static_assert((2 * C * QP + C * VP + C * AP) * 2 + DK * 4 <= SCR_BYTES, "chunk phase LDS");
    LAS bf16* QL = (LAS bf16*)F.lds; LAS bf16* KL = QL + C * QP; LAS bf16* VL = KL + C * QP; LAS bf16* AL = VL + C * VP; LAS float* WL = (LAS float*)(AL + C * AP);
    const int tid = F.tid, w = F.wave;
    for (int it = F.vcu; it < 32 * NS; it += F.G) {
        const int bh = it / NS, sl = it % NS, b = bh >> 2, h = bh & 3;
        bf16* rowbase = base + (size_t)b * SEQ * ld;
        const bf16* qp = rowbase + qoff + h * DK; const bf16* kp = rowbase + koff + h * DK; bf16* vp = rowbase + voff + h * DV + sl * 256;
        const float wsc = exp2f(64.f * log2f(1.f - exp2f(-5.f - (float)h)));
        f32x16 S[NDT];
#pragma unroll
        for (int d = 0; d < NDT; ++d) S[d] = (f32x16){};
        for (int c = 0; c < SEQ / C; ++c) {
            {
                int tz = tid; asm volatile("" : "+v"(tz));
                __syncthreads();
#pragma unroll
                for (int u = 0; u < (C * DK / 8) / 512; ++u) { const int idx = tz + 512 * u, row = idx / (DK / 8), c8 = (idx % (DK / 8)) * 8; const size_t go = (size_t)(C * c + row) * ld + c8;
                    const v4u q4 = *(const v4u*)(qp + go), k4 = *(const v4u*)(kp + go); *(LAS v4u*)(QL + row * QP + c8) = q4; *(LAS v4u*)(KL + row * QP + c8) = k4; }
#pragma unroll
                for (int u = 0; u < 4; ++u) { const int idx = tz + 512 * u, row = idx >> 5, c8 = (idx & 31) * 8; *(LAS v4u*)(VL + row * VP + c8) = *(const v4u*)(vp + (size_t)(C * c + row) * ld + c8); }
                if (ISGLA && tz < DK / 4) *(LAS f32x4*)(WL + 4 * tz) = *(const f32x4*)(Wdec + ((size_t)(b * (SEQ / C) + c) * 4 + h) * DK + 4 * tz);
                __syncthreads();
            }
            if (w < 3) {
                int tz = tid; asm volatile("" : "+v"(tz)); const int r = tz & 31, hh = (tz >> 5) & 1;
                const int jt = w >> 1, itl = (w + 1) >> 1;
                f32x16 a = {};
#pragma unroll
                for (int s = 0; s < DK / 16; ++s) { const bf16x8 kf = *(const LAS bf16x8*)(KL + (32 * jt + r) * QP + 16 * s + 8 * hh), qf = *(const LAS bf16x8*)(QL + (32 * itl + r) * QP + 16 * s + 8 * hh); a = MFMA32(kf, qf, a); }
                const int lim = (jt == itl) ? r - 4 * hh : 1000;
#pragma unroll
                for (int a4 = 0; a4 < 4; ++a4) { float e[4];
#pragma unroll
                    for (int x = 0; x < 4; ++x) e[x] = (8 * a4 + x <= lim) ? a[4 * a4 + x] : 0.f;
                    v2u o; o.x = pk2(e[0], e[1]); o.y = pk2(e[2], e[3]); *(LAS v2u*)(AL + (32 * itl + r) * AP + 32 * jt + 8 * a4 + 4 * hh) = o; }
            }
            __syncthreads();
            {
                int tz = tid; asm volatile("" : "+v"(tz)); const int r = tz & 31, hh = (tz >> 5) & 1;
                const int trow = 8 * hh + ((tz & 15) >> 2), tcol = 16 * ((tz >> 4) & 1) + 4 * (tz & 3);
                bf16x8 vf[4];
#pragma unroll
                for (int ks = 0; ks < 4; ++ks) { const LAS bf16* p = VL + (16 * ks + trow) * VP + 32 * w + tcol;
                    const s16x4 lo = __builtin_bit_cast(s16x4, __builtin_amdgcn_ds_read_tr16_b64_v4i16((LAS s16x4*)p)), hi = __builtin_bit_cast(s16x4, __builtin_amdgcn_ds_read_tr16_b64_v4i16((LAS s16x4*)(p + 4 * VP)));
                    vf[ks] = (bf16x8){lo[0], lo[1], lo[2], lo[3], hi[0], hi[1], hi[2], hi[3]}; }
                f32x16 O[2]; O[0] = (f32x16){}; O[1] = (f32x16){};
#pragma unroll
                for (int itl = 0; itl < 2; ++itl)
#pragma unroll
                    for (int ks = 0; ks < 2 * itl + 2; ++ks) { const bf16x8 af = *(const LAS bf16x8*)(AL + (32 * itl + r) * AP + 16 * ks + 8 * hh); O[itl] = MFMA32(vf[ks], af, O[itl]); }
#pragma unroll
                for (int dt = 0; dt < NDT; ++dt)
#pragma unroll
                    for (int s2 = 0; s2 < 2; ++s2) {
                        v4u sw; sw.x = pg8::cvt_pk_bf16(S[dt][8 * s2 + 0], S[dt][8 * s2 + 1]); sw.y = pg8::cvt_pk_bf16(S[dt][8 * s2 + 2], S[dt][8 * s2 + 3]);
                        sw.z = pg8::cvt_pk_bf16(S[dt][8 * s2 + 4], S[dt][8 * s2 + 5]); sw.w = pg8::cvt_pk_bf16(S[dt][8 * s2 + 6], S[dt][8 * s2 + 7]);
                        const bf16x8 sf = __builtin_bit_cast(bf16x8, sw);
#pragma unroll
                        for (int itl = 0; itl < 2; ++itl) { const LAS bf16* qq = QL + (32 * itl + r) * QP + 32 * dt + 16 * s2 + 4 * hh;
                            const v2u lo = *(const LAS v2u*)qq, hi = *(const LAS v2u*)(qq + 8);
                            O[itl] = MFMA32(sf, __builtin_bit_cast(bf16x8, (v4u){lo.x, lo.y, hi.x, hi.y}), O[itl]); }
                    }
                if (!F.dry) {
#pragma unroll
                    for (int itl = 0; itl < 2; ++itl) { bf16* op = vp + (size_t)(C * c + 32 * itl + r) * ld + 32 * w + 4 * hh;
#pragma unroll
                        for (int a4 = 0; a4 < 4; ++a4) { v2u o; o.x = pk2(O[itl][4 * a4], O[itl][4 * a4 + 1]); o.y = pk2(O[itl][4 * a4 + 2], O[itl][4 * a4 + 3]); *(v2u*)(op + 8 * a4) = o; } }
                }
#pragma unroll
                for (int dt = 0; dt < NDT; ++dt) {
#pragma unroll
                    for (int ks = 0; ks < 4; ++ks) { const LAS bf16* p = KL + (16 * ks + trow) * QP + 32 * dt + tcol;
                        const s16x4 lo = __builtin_bit_cast(s16x4, __builtin_amdgcn_ds_read_tr16_b64_v4i16((LAS s16x4*)p)), hi = __builtin_bit_cast(s16x4, __builtin_amdgcn_ds_read_tr16_b64_v4i16((LAS s16x4*)(p + 4 * QP)));
                        S[dt] = MFMA32(((bf16x8){lo[0], lo[1], lo[2], lo[3], hi[0], hi[1], hi[2], hi[3]}), vf[ks], S[dt]); }
                    if (ISGLA) {
#pragma unroll
                        for (int a4 = 0; a4 < 4; ++a4) { const f32x4 w4 = *(const LAS f32x4*)(WL + 32 * dt + 8 * a4 + 4 * hh);
#pragma unroll
                            for (int x = 0; x < 4; ++x) S[dt][4 * a4 + x] *= w4[x]; }
                    } else S[dt] *= wsc;
                }
            }
        }
    }
    __syncthreads();
}
__device__ __forceinline__ void gla_prep_phase(Frame& F, bf16* base, int ld, float* Wdec) {
    const int tid = F.tid;
    for (int it = F.vcu; it < BATCH * 64; it += F.G) {
        bf16* p = base + (size_t)it * 64 * ld + tid;
        float bsum = 0.f;
#pragma unroll 8
        for (int t = 0; t < 64; ++t) {
            bf16* rp = p + (size_t)t * ld;
            bsum += bf1(rp[3072]);
            const float eb = __expf(bsum);
            const float q = bf1(rp[0]) * eb, k = bf1(rp[512]) / eb;
            if (!F.dry) { rp[0] = (bf16)f2bf(q); rp[512] = (bf16)f2bf(k); }
        }
        Wdec[(size_t)it * 512 + tid] = __expf(bsum);
    }
}

template <int DV, bool CENTER>
__device__ __forceinline__ void hn_phase(Frame& F, bf16* base, int ld, int ooff, int goff, const float* gn) {
    constexpr int NJ = DV / 128;
    const int gw = F.vcu * NWAVES + F.wave, NGW = F.G * NWAVES, lane = F.lane, hq = lane >> 4, li = lane & 15;
    for (int m = gw; m < M; m += NGW) {
        bf16* op = base + (size_t)m * ld + ooff + hq * DV + li * 8; const bf16* gp = base + (size_t)m * ld + goff + hq * DV + li * 8;
        float o[NJ][8]; v4u gw4[NJ]; float s = 0.f;
#pragma unroll
        for (int j = 0; j < NJ; ++j) { const v4u w = *(const v4u*)(op + 128 * j); gw4[j] = *(const v4u*)(gp + 128 * j);
            o[j][0] = bflo(w.x); o[j][1] = bfhi(w.x); o[j][2] = bflo(w.y); o[j][3] = bfhi(w.y); o[j][4] = bflo(w.z); o[j][5] = bfhi(w.z); o[j][6] = bflo(w.w); o[j][7] = bfhi(w.w);
#pragma unroll
            for (int e = 0; e < 8; ++e) s += o[j][e]; }
        float mean = 0.f;
        if (CENTER) mean = grp16_sum(s) * (1.f / DV);
        float s2 = 0.f;
#pragma unroll
        for (int j = 0; j < NJ; ++j)
#pragma unroll
            for (int e = 0; e < 8; ++e) { o[j][e] -= mean; s2 += o[j][e] * o[j][e]; }
        const float rstd = rsqrtf(grp16_sum(s2) * (1.f / DV) + NORM_EPS);
#pragma unroll
        for (int j = 0; j < NJ; ++j) {
            const float* gnp = gn + hq * DV + li * 8 + 128 * j; const f32x4 g0 = *(const f32x4*)gnp, g1 = *(const f32x4*)(gnp + 4);
            const float gg[8] = {bflo(gw4[j].x), bfhi(gw4[j].x), bflo(gw4[j].y), bfhi(gw4[j].y), bflo(gw4[j].z), bfhi(gw4[j].z), bflo(gw4[j].w), bfhi(gw4[j].w)};
            float r[8];
#pragma unroll
            for (int e = 0; e < 8; ++e) r[e] = o[j][e] * rstd * (e < 4 ? g0[e & 3] : g1[e & 3]) * silu(gg[e]);
            v4u w; w.x = pk2(r[0], r[1]); w.y = pk2(r[2], r[3]); w.z = pk2(r[4], r[5]); w.w = pk2(r[6], r[7]);
            if (!F.dry) *(v4u*)(op + 128 * j) = w;
        }
    }
}

__device__ __forceinline__ void lru_conv_phase(Frame& F, const bf16* XY, bf16* XC, const float* cw, const float* cb) {
    const int gw = F.vcu * NWAVES + F.wave, NGW = F.G * NWAVES, lane = F.lane;
    for (int m = gw; m < M; m += NGW) {
        const int t = m & (SEQ - 1);
#pragma unroll
        for (int j = 0; j < 2; ++j) {
            const int ch = lane * 8 + 512 * j;
            float acc[8];
            { const f32x4 b0 = *(const f32x4*)(cb + ch), b1 = *(const f32x4*)(cb + ch + 4);
              acc[0] = b0.x; acc[1] = b0.y; acc[2] = b0.z; acc[3] = b0.w; acc[4] = b1.x; acc[5] = b1.y; acc[6] = b1.z; acc[7] = b1.w; }
#pragma unroll
            for (int tap = 0; tap < 4; ++tap) {
                if (t - 3 + tap >= 0) {
                    const v4u w = *(const v4u*)(XY + (size_t)(m - 3 + tap) * 2048 + ch);
                    const f32x4 c0 = *(const f32x4*)(cw + tap * 1024 + ch), c1 = *(const f32x4*)(cw + tap * 1024 + ch + 4);
                    acc[0] += bflo(w.x) * c0.x; acc[1] += bfhi(w.x) * c0.y; acc[2] += bflo(w.y) * c0.z; acc[3] += bfhi(w.y) * c0.w;
                    acc[4] += bflo(w.z) * c1.x; acc[5] += bfhi(w.z) * c1.y; acc[6] += bflo(w.w) * c1.z; acc[7] += bfhi(w.w) * c1.w;
                }
            }
            v4u o; o.x = pk2(acc[0], acc[1]); o.y = pk2(acc[2], acc[3]); o.z = pk2(acc[4], acc[5]); o.w = pk2(acc[6], acc[7]);
            *(v4u*)(XC + (size_t)m * 1024 + ch) = o;
        }
    }
}
template <int PASS>
__device__ __forceinline__ void lru_scan_phase(Frame& F, const bf16* GP, const bf16* XC, const bf16* XY, float* SP, float* SE, bf16* HS, const float* b_a, const float* b_x, const float* lam) {
    const int tid = F.tid, ch = 2 * tid, gcol = (ch >> 7) * 256 + (ch & 127);
    const float ba0 = b_a[ch], ba1 = b_a[ch + 1], bx0 = b_x[ch], bx1 = b_x[ch + 1];
    const float lm0 = lam[ch], lm1 = lam[ch + 1];
    const float sp0 = -8.f * (fmaxf(-lm0, 0.f) + log1pf(__expf(-fabsf(lm0)))), sp1 = -8.f * (fmaxf(-lm1, 0.f) + log1pf(__expf(-fabsf(lm1))));
    for (int it = F.vcu; it < BATCH * 64; it += F.G) {
        const int b = it >> 6, ci = it & 63; const size_t m0 = (size_t)b * SEQ + ci * 64;
        float h0 = 0.f, h1 = 0.f, s0 = 0.f, s1 = 0.f;
        if (PASS == 1) {
            for (int j = 0; j < ci; ++j) { const f32x2 p = *(const f32x2*)(SP + (size_t)(b * 64 + j) * 1024 + ch), e = *(const f32x2*)(SE + (size_t)(b * 64 + j) * 1024 + ch);
                h0 = p.x * h0 + e.x; h1 = p.y * h1 + e.y; }
        }
#pragma unroll 8
        for (int t = 0; t < 64; ++t) {
            const unsigned pa = *(const unsigned*)(GP + (m0 + t) * 2048 + gcol), px = *(const unsigned*)(GP + (m0 + t) * 2048 + gcol + 128), xc = *(const unsigned*)(XC + (m0 + t) * 1024 + ch);
            const float l0 = sp0 / (1.f + __expf(-(bflo(pa) + ba0))), l1 = sp1 / (1.f + __expf(-(bfhi(pa) + ba1)));
            const float a0 = __expf(l0), a1 = __expf(l1);
            const float u0 = sqrtf(fmaxf(1.f - a0 * a0, 0.f)) * bflo(xc) / (1.f + __expf(-(bflo(px) + bx0))), u1 = sqrtf(fmaxf(1.f - a1 * a1, 0.f)) * bfhi(xc) / (1.f + __expf(-(bfhi(px) + bx1)));
            h0 = a0 * h0 + u0; h1 = a1 * h1 + u1;
            if (PASS == 0) { s0 += l0; s1 += l1; }
            else { const unsigned y = *(const unsigned*)(XY + (m0 + t) * 2048 + 1024 + ch);
                *(unsigned*)(HS + (m0 + t) * 1024 + ch) = pk2(h0 * gelu_tanh(bflo(y)), h1 * gelu_tanh(bfhi(y))); }
        }
        if (PASS == 0) { *(f32x2*)(SP + (size_t)it * 1024 + ch) = (f32x2){__expf(s0), __expf(s1)}; *(f32x2*)(SE + (size_t)it * 1024 + ch) = (f32x2){h0, h1}; }
    }
}

__device__ __forceinline__ void nsa_compress_phase(Frame& F, const bf16* KC, const bf16* VC, const bf16* W1K, const bf16* W1V, const bf16* W2K, const bf16* W2V, const float* PEB, bf16* KCMP, bf16* VCMPT) {
    LAS float* part = (LAS float*)F.lds;
    LAS bf16* hid = (LAS bf16*)(F.lds + 32768);
    const int tid = F.tid, lane = F.lane, w = F.wave, r = lane & 31, hh = lane >> 5;
    for (int it = F.vcu; it < 256; it += F.G) {
        const int kv = it >> 7, bg = (it >> 3) & 15, ntile = it & 7;
        const bf16* A = (kv ? VC : KC) + (size_t)bg * SEQ * 64 + (size_t)(32 * ntile) * 1024;
        const bf16* W1 = kv ? W1V : W1K; const bf16* W2 = kv ? W2V : W2K; const float* bias = PEB + kv * 128;
        const int ct = w & 3, kh = w >> 2;
        f32x16 acc = {};
        const bf16* ap = A + (size_t)r * 1024 + 1024 * kh + 8 * hh; const bf16* bp = W1 + (size_t)(32 * ct + r) * 2048 + 1024 * kh + 8 * hh;
#pragma unroll 8
        for (int s = 0; s < 64; ++s) { const bf16x8 a = *(const bf16x8*)(ap + 16 * s), bb = *(const bf16x8*)(bp + 16 * s); acc = MFMA32(a, bb, acc); }
        __syncthreads();
#pragma unroll
        for (int q = 0; q < 16; ++q) { const int row = (q & 3) + 8 * (q >> 2) + 4 * hh; part[kh * 4096 + row * 128 + 32 * ct + r] = acc[q]; }
        __syncthreads();
        { const int row = tid >> 4, col = (tid & 15) * 8; unsigned pk[4];
#pragma unroll
          for (int e = 0; e < 8; e += 2) { const float a0 = part[row * 128 + col + e] + part[4096 + row * 128 + col + e] + bias[col + e];
              const float a1 = part[row * 128 + col + e + 1] + part[4096 + row * 128 + col + e + 1] + bias[col + e + 1];
              pk[e >> 1] = pk2(gelu_tanh(a0), gelu_tanh(a1)); }
          *(LAS v4u*)(hid + row * 136 + col) = (v4u){pk[0], pk[1], pk[2], pk[3]}; }
        __syncthreads();
        if (w < 2) {
            f32x16 a2 = {};
#pragma unroll
            for (int s = 0; s < 8; ++s) { const bf16x8 a = *(const LAS bf16x8*)(hid + r * 136 + 16 * s + 8 * hh), bb = *(const bf16x8*)(W2 + (size_t)(32 * w + r) * 128 + 16 * s + 8 * hh); a2 = MFMA32(a, bb, a2); }
            const int d = 32 * w + r;
            if (kv == 0) {
#pragma unroll
                for (int q = 0; q < 16; ++q) { const int n = 32 * ntile + (q & 3) + 8 * (q >> 2) + 4 * hh; KCMP[((size_t)bg * 256 + n) * 64 + d] = (bf16)(n == 255 ? 0u : f2bf(a2[q])); }
            } else {
#pragma unroll
                for (int q4 = 0; q4 < 4; ++q4) { const int n = 32 * ntile + 8 * q4 + 4 * hh; float v[4];
#pragma unroll
                    for (int e = 0; e < 4; ++e) v[e] = (n + e == 255) ? 0.f : a2[4 * q4 + e];
                    v2u o; o.x = pk2(v[0], v[1]); o.y = pk2(v[2], v[3]); *(v2u*)(VCMPT + ((size_t)bg * 64 + d) * 256 + n) = o; }
            }
        }
    }
    __syncthreads();
}

constexpr int KP = 72;
__device__ __forceinline__ void qk_tile(const LAS bf16* KT, const bf16x8 (&Qf)[4], f32x16& S0, f32x16& S1, int r, int hh) {
    S0 = (f32x16){}; S1 = (f32x16){};
#pragma unroll
    for (int s = 0; s < 4; ++s) {
        const bf16x8 a0 = *(const LAS bf16x8*)(KT + r * KP + 16 * s + 8 * hh), a1 = *(const LAS bf16x8*)(KT + (32 + r) * KP + 16 * s + 8 * hh);
        S0 = MFMA32(a0, Qf[s], S0); S1 = MFMA32(a1, Qf[s], S1);
    }
}
__device__ __forceinline__ void attn_tile(const LAS bf16* KT, const LAS bf16* VT, const bf16x8 (&Qf)[4], f32x16 (&O)[2], float& mrun, float& lrun,
                                          float biasl, float bstep, int limhi, int limlo, int r, int hh) {
    f32x16 S0, S1; qk_tile(KT, Qf, S0, S1, r, hh);
    float mx = -INFINITY;
#pragma unroll
    for (int q = 0; q < 16; ++q) { const int c = (q & 3) + 8 * (q >> 2);
        S0[q] = (c <= limhi && c > limlo) ? S0[q] + __builtin_fmaf(bstep, (float)c, biasl) : -INFINITY;
        S1[q] = (c + 32 <= limhi && c + 32 > limlo) ? S1[q] + __builtin_fmaf(bstep, (float)(c + 32), biasl) : -INFINITY;
        mx = fmaxf(mx, fmaxf(S0[q], S1[q])); }
    mx = fmaxf(mx, __shfl_xor(mx, 32));
    const float mnew = fmaxf(mrun, mx), alpha = __builtin_amdgcn_exp2f(mrun - mnew);
    float rs = 0.f;
#pragma unroll
    for (int q = 0; q < 16; ++q) { S0[q] = __builtin_amdgcn_exp2f(S0[q] - mnew); S1[q] = __builtin_amdgcn_exp2f(S1[q] - mnew); rs += S0[q] + S1[q]; }
    rs += __shfl_xor(rs, 32);
    lrun = lrun * alpha + rs; mrun = mnew;
#pragma unroll
    for (int dt = 0; dt < 2; ++dt)
#pragma unroll
        for (int q = 0; q < 16; ++q) O[dt][q] *= alpha;
    bf16x8 Pf[2][2];
#pragma unroll
    for (int s = 0; s < 2; ++s) {
        v4u w0, w1;
        w0.x = pg8::cvt_pk_bf16(S0[8 * s + 0], S0[8 * s + 1]); w0.y = pg8::cvt_pk_bf16(S0[8 * s + 2], S0[8 * s + 3]); w0.z = pg8::cvt_pk_bf16(S0[8 * s + 4], S0[8 * s + 5]); w0.w = pg8::cvt_pk_bf16(S0[8 * s + 6], S0[8 * s + 7]);
        w1.x = pg8::cvt_pk_bf16(S1[8 * s + 0], S1[8 * s + 1]); w1.y = pg8::cvt_pk_bf16(S1[8 * s + 2], S1[8 * s + 3]); w1.z = pg8::cvt_pk_bf16(S1[8 * s + 4], S1[8 * s + 5]); w1.w = pg8::cvt_pk_bf16(S1[8 * s + 6], S1[8 * s + 7]);
        Pf[0][s] = __builtin_bit_cast(bf16x8, w0); Pf[1][s] = __builtin_bit_cast(bf16x8, w1);
    }
#pragma unroll
    for (int dt = 0; dt < 2; ++dt)
#pragma unroll
        for (int kt = 0; kt < 2; ++kt)
#pragma unroll
            for (int s = 0; s < 2; ++s) {
                const LAS bf16* vp = VT + (32 * dt + r) * KP + 32 * kt + 16 * s + 4 * hh;
                const v2u lo = *(const LAS v2u*)vp, hi = *(const LAS v2u*)(vp + 8);
                const bf16x8 a = __builtin_bit_cast(bf16x8, (v4u){lo.x, lo.y, hi.x, hi.y});
                O[dt] = MFMA32(a, Pf[kt][s], O[dt]);
            }
}
__device__ __forceinline__ void imp_tile(const LAS bf16* KT, const bf16x8 (&Qf)[4], float mfin, float linv, float biasl, float bstep, int limhi, int n0t, LAS unsigned* IMP, int r, int hh) {
    f32x16 S0, S1; qk_tile(KT, Qf, S0, S1, r, hh);
#pragma unroll
    for (int q = 0; q < 16; ++q) { const int c = (q & 3) + 8 * (q >> 2);
        S0[q] = (c <= limhi) ? __builtin_amdgcn_exp2f(S0[q] + __builtin_fmaf(bstep, (float)c, biasl) - mfin) * linv : 0.f;
        S1[q] = (c + 32 <= limhi) ? __builtin_amdgcn_exp2f(S1[q] + __builtin_fmaf(bstep, (float)(c + 32), biasl) - mfin) * linv : 0.f; }
    LAS unsigned* row = IMP + r * 65;
#pragma unroll
    for (int kt = 0; kt < 2; ++kt)
#pragma unroll
        for (int a = 0; a < 4; ++a) {
            const float e0 = kt ? S1[4 * a] : S0[4 * a], e1 = kt ? S1[4 * a + 1] : S0[4 * a + 1], e2 = kt ? S1[4 * a + 2] : S0[4 * a + 2], e3 = kt ? S1[4 * a + 3] : S0[4 * a + 3];
            const int j = (n0t + 32 * kt + 8 * a + 4 * hh) >> 2;
            const unsigned gq = (unsigned)((e0 + e1 + e2 + e3) * 8388608.f + 0.5f), lq = (unsigned)(e3 * 8388608.f + 0.5f);
            if (gq) __hip_atomic_fetch_add((unsigned*)(row + j), gq, __ATOMIC_RELAXED, __HIP_MEMORY_SCOPE_WORKGROUP);
            if (lq && j + 1 < 64) __hip_atomic_fetch_add((unsigned*)(row + j + 1), lq, __ATOMIC_RELAXED, __HIP_MEMORY_SCOPE_WORKGROUP);
        }
}
__device__ __forceinline__ void load_kv_tile(LAS bf16* KT, LAS bf16* VT, const bf16* ksrc  , const bf16* vsrc  , int vstride, int tid, bool with_v) {
    const int row = tid >> 3, ch = (tid & 7) * 8;
    const v4u k = *(const v4u*)(ksrc + row * 64 + ch);
    v4u v = {0, 0, 0, 0}; if (with_v) v = *(const v4u*)(vsrc + (size_t)row * vstride + ch);
    *(LAS v4u*)(KT + row * KP + ch) = k;
    if (with_v) *(LAS v4u*)(VT + row * KP + ch) = v;
}
#define TZ_LANE int tz = tid; asm volatile("" : "+v"(tz)); const int r = tz & 31, hh = (tz >> 5) & 1;
__device__ __forceinline__ void nsa_attn_phase(Frame& F, const bf16* Q, const bf16* KCMP, const bf16* VCMPT, const bf16* KS, const bf16* VST, const bf16* KW, const bf16* VWT, const float* GATES, bf16* OB) {
    LAS bf16* KT = (LAS bf16*)F.lds; LAS bf16* VT = KT + 64 * KP;
    LAS unsigned* IMP = (LAS unsigned*)(F.lds + 2 * 64 * KP * 2);
    LAS unsigned char* SELB = (LAS unsigned char*)(IMP + 32 * 65);
    const int tid = F.tid, w = F.wave;
    for (int it = F.vcu; it < 2048; it += F.G) {
        const int k8 = it >> 8, v = it & 255, slot = k8 >> 1, half = k8 & 1, bg = v >> 4, rr = v & 15;
        const int i = slot == 0 ? rr : (slot == 1 ? 31 - rr : (slot == 2 ? 32 + rr : 63 - rr));
        const int b = bg >> 1, g = bg & 1, h = g * 8 + w, t0 = 64 * i, q0 = 32 * half;
        const float slope2 = exp2f(-0.5f * (float)(h + 1)) * LOG2E;
        bf16x8 Qf[4]; float gate[3];
        { TZ_LANE
          const size_t row = (size_t)b * SEQ + t0 + q0 + r;
#pragma unroll
          for (int s = 0; s < 4; ++s) Qf[s] = *(const bf16x8*)(Q + row * 1024 + h * 64 + 16 * s + 8 * hh);
#pragma unroll
          for (int br = 0; br < 3; ++br) gate[br] = GATES[row * 48 + br * 16 + h]; }
        f32x16 O[2]; O[0] = (f32x16){}; O[1] = (f32x16){};
        unsigned OUTP[2][8];
#define OUT_ACC(sc_, first_) do { _Pragma("unroll") for (int dt_ = 0; dt_ < 2; ++dt_) { _Pragma("unroll") for (int e_ = 0; e_ < 8; ++e_) { const unsigned w_ = (first_) ? 0u : OUTP[dt_][e_]; \
            OUTP[dt_][e_] = pk2(bflo(w_) + O[dt_][2 * e_] * (sc_), bfhi(w_) + O[dt_][2 * e_ + 1] * (sc_)); } O[dt_] = (f32x16){}; } } while (0)
        float mrun = -1e30f, lrun = 0.f;
        __syncthreads();
        for (int idx = tid; idx < 32 * 65; idx += 512) IMP[idx] = 0u;
        const int ncmp = (4 * i + 3) < 255 ? (4 * i + 3) : 255, ntile = (ncmp + 63) >> 6;
        const bf16* kcb = KCMP + (size_t)bg * 256 * 64; const bf16* vcb = VCMPT + (size_t)bg * 64 * 256;
        for (int tl = 0; tl < ntile; ++tl) {
            TZ_LANE
            __syncthreads();
            load_kv_tile(KT, VT, kcb + (size_t)tl * 64 * 64, vcb + tl * 64, 256, tz, true);
            __syncthreads();
            const int n0t = 64 * tl, a1 = ((t0 + q0 + r - 31) >> 4) - n0t - 4 * hh, a2 = 254 - n0t - 4 * hh;
            attn_tile(KT, VT, Qf, O, mrun, lrun, slope2 * (float)(16 * n0t + 31 - t0) + slope2 * 64.f * (float)hh, slope2 * 16.f, a1 < a2 ? a1 : a2, -1000, r, hh);
        }
        const float mfin = mrun, linv = 1.f / fmaxf(lrun, 1e-30f);
        OUT_ACC(linv * gate[0], true);
        mrun = -1e30f; lrun = 0.f;
        for (int tl = 0; tl < ntile; ++tl) {
            TZ_LANE
            __syncthreads();
            load_kv_tile(KT, VT, kcb + (size_t)tl * 64 * 64, vcb, 256, tz, false);
            __syncthreads();
            const int n0t = 64 * tl, a1 = ((t0 + q0 + r - 31) >> 4) - n0t - 4 * hh, a2 = 254 - n0t - 4 * hh;
            imp_tile(KT, Qf, mfin, linv, slope2 * (float)(16 * n0t + 31 - t0) + slope2 * 64.f * (float)hh, slope2 * 16.f, a1 < a2 ? a1 : a2, n0t, IMP, r, hh);
        }
        __syncthreads();
        {
            const int q = (tid >> 3) & 31, oct = tid & 7;
            unsigned mykey[8];
#pragma unroll
            for (int jj = 0; jj < 8; ++jj) { const int j = oct * 8 + jj; unsigned vv = IMP[q * 65 + j]; vv = vv > 0x3fffffeu ? 0x3fffffeu : vv;
                const bool forced = (j == 0) || (j == i) || (j == i - 1);
                mykey[jj] = (j <= i) ? (((forced ? 0x3ffffffu : vv) << 6) | (unsigned)(63 - j)) : 0u; }
            __syncthreads();
            if (tid < 256) {
#pragma unroll
                for (int jj = 0; jj < 8; ++jj) IMP[q * 65 + oct * 8 + jj] = mykey[jj]; }
            __syncthreads();
            unsigned rank[8] = {0, 0, 0, 0, 0, 0, 0, 0};
            for (int j2 = 0; j2 < 64; ++j2) { const unsigned kk = IMP[q * 65 + j2];
#pragma unroll
                for (int jj = 0; jj < 8; ++jj) rank[jj] += (kk > mykey[jj]) ? 1u : 0u; }
            unsigned byte = 0;
#pragma unroll
            for (int jj = 0; jj < 8; ++jj) byte |= ((oct * 8 + jj <= i) && rank[jj] < 16u) ? (1u << jj) : 0u;
            if (tid < 256) SELB[q * 8 + oct] = (unsigned char)byte;
        }
        __syncthreads();
        unsigned long long selm, uni;
        { TZ_LANE
          selm = *(const LAS unsigned long long*)(SELB + 8 * r);
          unsigned ulo = (unsigned)selm, uhi = (unsigned)(selm >> 32);
#pragma unroll
          for (int o = 1; o < 32; o <<= 1) { ulo |= __shfl_xor(ulo, o); uhi |= __shfl_xor(uhi, o); }
          uni = ((unsigned long long)(unsigned)__builtin_amdgcn_readfirstlane(uhi) << 32) | (unsigned)__builtin_amdgcn_readfirstlane(ulo); }
        const bf16* ksb = KS + (size_t)bg * SEQ * 64; const bf16* vsb = VST + (size_t)bg * 64 * SEQ;
        for (int j = 0; j <= i; ++j) {
            if (!((uni >> j) & 1ull)) continue;
            TZ_LANE
            __syncthreads();
            load_kv_tile(KT, VT, ksb + (size_t)j * 64 * 64, vsb + j * 64, SEQ, tz, true);
            __syncthreads();
            const int lh = ((selm >> j) & 1ull) ? (j == i ? q0 + r - 4 * hh : 1000) : -1000;
            attn_tile(KT, VT, Qf, O, mrun, lrun, slope2 * (float)(64 * j - t0) + slope2 * 4.f * (float)hh, slope2, lh, -1000, r, hh);
        }
        OUT_ACC(gate[1] / fmaxf(lrun, 1e-30f), false);
        mrun = -1e30f; lrun = 0.f;
        const bf16* kwb = KW + (size_t)bg * SEQ * 64; const bf16* vwb = VWT + (size_t)bg * 64 * SEQ;
        for (int j = (i > 8 ? i - 8 : 0); j <= i; ++j) {
            TZ_LANE
            __syncthreads();
            load_kv_tile(KT, VT, kwb + (size_t)j * 64 * 64, vwb + j * 64, SEQ, tz, true);
            __syncthreads();
            const int lh = (j == i) ? q0 + r - 4 * hh : 1000, ll = (j == i - 8) ? q0 + r - 4 * hh : -1000;
            attn_tile(KT, VT, Qf, O, mrun, lrun, slope2 * (float)(64 * j - t0) + slope2 * 4.f * (float)hh, slope2, lh, ll, r, hh);
        }
        OUT_ACC(gate[2] / fmaxf(lrun, 1e-30f), false);
        { TZ_LANE
          bf16* op = OB + ((size_t)b * SEQ + t0 + q0 + r) * 1024 + h * 64;
#pragma unroll
          for (int dt = 0; dt < 2; ++dt)
#pragma unroll
              for (int q4 = 0; q4 < 4; ++q4) { v2u o; o.x = OUTP[dt][2 * q4]; o.y = OUTP[dt][2 * q4 + 1]; *(v2u*)(op + 32 * dt + 8 * q4 + 4 * hh) = o; } }
    }
    __syncthreads();
#undef OUT_ACC
}

struct Args { const float* in[32]; float* out; unsigned char* ws; int ph_lo, ph_hi, dry, pad; };
constexpr int N_PHASES = 36;

__global__ void __launch_bounds__(NWAVES * 64, 2) trunk_fwd(Args args) {
    extern __shared__ __attribute__((aligned(16))) unsigned char lds[];
    Frame F;
    F.lds = (LAS unsigned char*)lds;
    F.tid = threadIdx.x; F.lane = F.tid & 63; F.wave = __builtin_amdgcn_readfirstlane(F.tid >> 6);
    F.G = gridDim.x; { const int bx = blockIdx.x; F.vcu = (F.G % 8 == 0) ? (bx % 8) * (F.G / 8) + bx / 8 : bx; }
    F.ws = args.ws; F.dry = args.dry;
    unsigned char* ws = args.ws;
    volatile LAS unsigned* MISC = (volatile LAS unsigned*)(F.lds + LDSCTL_OFF);
    for (int u = F.tid; u < (LDS_BYTES - LDSCTL_OFF) / 4; u += NWAVES * 64) ((LAS unsigned*)(F.lds + LDSCTL_OFF))[u] = 0u;
    __syncthreads();
    XcdBarrier bar = xcd_barrier_post((unsigned*)(ws + WS_CTL) + CW_BAR, MISC + 8);

    const int lo = args.ph_lo, hi = args.ph_hi;
#ifndef PHMASK
#define PHMASK 0xFFFFFFFFFFFFFFFFull
#endif
#define INR(k) ((((PHMASK) >> (k)) & 1ull) && lo <= (k) && (k) < hi)
#define IN(k) (INR(k) && frame_refresh(F))
#define SEAM(k) do { if (INR(k) && INR((k) + 1)) xcd_barrier(bar); } while (0)
    const float* const* in = args.in;
    float* xout = args.out;
    bf16* Hb = (bf16*)(ws + WS_H); bf16* BIG = (bf16*)(ws + WS_BIG);
    bf16* Wi = (bf16*)(ws + WS_WIN); bf16* Wo = (bf16*)(ws + WS_WOUT); bf16* Wu = (bf16*)(ws + WS_WUP); bf16* Wd = (bf16*)(ws + WS_WDN);
    LAS unsigned char* ring = F.lds + RING_OFF;

#define CONV_MLP(L, base) do { conv_w(F, base, in[5] + (size_t)(L) * D * FF, D, FF, 0, FF, FF, Wu, D, 0, 1.f); conv_w(F, base, in[6] + (size_t)(L) * FF * D, FF, D, 0, D, D, Wd, FF, 0, 1.f); } while (0)
#define GEMM_PHASE(EPI, Aptr, LDA, Bptr, LDB, NN, KK, APN, E) do { pg8::Gemm g{(const pg8::bf16_t*)(Aptr), (const pg8::bf16_t*)(Bptr), M, (NN), (KK), (LDA), (LDB), (size_t)(APN)}; \
        pg8::StaticOrder S; S.init(M, (NN), F.G, (int)blockIdx.x); pg8::gemm_phase<EPI, pg8::StaticOrder, true, true>(ring, g, S, E); } while (0)
#define MLP_PHASES(P0, L) \
    if (IN(P0)) { pg8::EpiStore<1> E{BIG, FF}; GEMM_PHASE(pg8::EpiStore<1>, Hb, D, Wu, D, FF, D, 0, E); } SEAM(P0); \
    if (IN((P0) + 1)) { pg8::EpiStore<0> E{Hb, D}; GEMM_PHASE(pg8::EpiStore<0>, BIG, FF, Wd, FF, D, FF, 0, E); } SEAM((P0) + 1);

    if (IN(0)) {
        int base = 0;
        conv_w(F, base, in[7], D, 6144, 0, 6144, 6144, Wi, D, 0, 1.f);
        conv_w(F, base, in[9], 2048, D, 0, D, D, Wo, 2048, 0, 1.f);
        CONV_MLP(0, base);
        norm_phase(F, in[0], nullptr, nullptr, Hb, nullptr, in[1]);
    }
    SEAM(0);
    if (IN(1)) { pg8::EpiRet E{BIG, 6144}; GEMM_PHASE(pg8::EpiRet, Hb, D, Wi, D, 6144, D, 0, E); }
    SEAM(1);
    if (IN(2)) chunk_phase<256, 512, false>(F, BIG, 6144, 0, 1024, 2048, nullptr);
    SEAM(2);
    if (IN(3)) hn_phase<512, true>(F, BIG, 6144, 2048, 4096, in[8]);
    SEAM(3);
    if (IN(4)) { pg8::EpiStore<0> E{Hb, D}; GEMM_PHASE(pg8::EpiStore<0>, BIG + 2048, 6144, Wo, 2048, D, 2048, 0, E); }
    SEAM(4);
    if (IN(5)) norm_phase(F, in[0], Hb, xout, Hb, in[2], in[3]);
    SEAM(5);
    MLP_PHASES(6, 0)
    if (IN(8)) {
        norm_phase(F, xout, Hb, xout, Hb, in[4], in[1] + D);
        int base = 0;
        conv_w(F, base, in[10], D, 3088, 0, 512, 3088, Wi, D, 0, 0.08838834764831845f);
        conv_w(F, base, in[10], D, 3088, 512, 2560, 3088, Wi, D, 512, 1.f);
        {
            const int gw = F.vcu * NWAVES + F.wave, NGW = F.G * NWAVES;
            for (int itx = gw; itx < 16 * 16; itx += NGW) {
                const int kb = itx >> 4, cb = itx & 15, k = kb * 64 + F.lane;
                float wv[16];
#pragma unroll
                for (int r = 0; r < 16; ++r) wv[r] = in[10][(size_t)k * 3088 + 3072 + r];
                for (int c = cb * 32; c < cb * 32 + 32; ++c) { float s = 0.f;
#pragma unroll
                    for (int r = 0; r < 16; ++r) s += wv[r] * in[11][r * 512 + c];
                    Wi[(size_t)(3072 + c) * D + k] = (bf16)f2bf(s); }
            }
        }
        conv_w(F, base, in[14], D, D, 0, D, D, Wo, D, 0, 1.f);
        CONV_MLP(1, base);
    }
    SEAM(8);
    if (IN(9)) { pg8::EpiGla E{BIG, 3584, in[12]}; GEMM_PHASE(pg8::EpiGla, Hb, D, Wi, D, 3584, D, 0, E); }
    SEAM(9);
    if (IN(10)) gla_prep_phase(F, BIG, 3584, (float*)(ws + SM_GLAW));
    SEAM(10);
    if (IN(11)) chunk_phase<128, 256, true>(F, BIG, 3584, 0, 512, 1024, (const float*)(ws + SM_GLAW));
    SEAM(11);
    if (IN(12)) hn_phase<256, false>(F, BIG, 3584, 1024, 2048, in[13]);
    SEAM(12);
    if (IN(13)) { pg8::EpiStore<0> E{Hb, D}; GEMM_PHASE(pg8::EpiStore<0>, BIG + 1024, 3584, Wo, D, D, D, 0, E); }
    SEAM(13);
    if (IN(14)) norm_phase(F, xout, Hb, xout, Hb, in[2] + D, in[3] + D);
    SEAM(14);
    MLP_PHASES(15, 1)
    if (IN(17)) {
        norm_phase(F, xout, Hb, xout, Hb, in[4] + D, in[1] + 2 * D);
        int base = 0;
        conv_w(F, base, in[15], D, 2048, 0, 2048, 2048, Wi, D, 0, 1.f);
        conv_w(F, base, in[23], D, D, 0, D, D, Wo, D, 0, 1.f);
        bf16* LW = (bf16*)(ws + SM_LRUW);
        for (int n = 0; n < 8; ++n) { conv_w(F, base, in[18] + n * 16384, 128, 128, 0, 128, 128, LW + n * 32768, 128, 0, 1.f); conv_w(F, base, in[20] + n * 16384, 128, 128, 0, 128, 128, LW + n * 32768, 128, 128, 1.f); }
        CONV_MLP(2, base);
    }
    SEAM(17);
    if (IN(18)) { pg8::EpiStore<0> E{(bf16*)(ws + LRU_XY), 2048}; GEMM_PHASE(pg8::EpiStore<0>, Hb, D, Wi, D, 2048, D, 0, E); }
    SEAM(18);
    if (IN(19)) lru_conv_phase(F, (const bf16*)(ws + LRU_XY), (bf16*)(ws + LRU_XC), in[16], in[17]);
    SEAM(19);
    if (IN(20)) { pg8::EpiStore<0> E{(bf16*)(ws + LRU_GP), 2048}; GEMM_PHASE(pg8::EpiStore<0>, ws + LRU_XC, D, ws + SM_LRUW, 128, 2048, 128, 256, E); }
    SEAM(20);
    if (IN(21)) lru_scan_phase<0>(F, (const bf16*)(ws + LRU_GP), (const bf16*)(ws + LRU_XC), (const bf16*)(ws + LRU_XY), (float*)(ws + SM_SCANP), (float*)(ws + SM_SCANE), (bf16*)(ws + LRU_HS), in[19], in[21], in[22]);
    SEAM(21);
    if (IN(22)) lru_scan_phase<1>(F, (const bf16*)(ws + LRU_GP), (const bf16*)(ws + LRU_XC), (const bf16*)(ws + LRU_XY), (float*)(ws + SM_SCANP), (float*)(ws + SM_SCANE), (bf16*)(ws + LRU_HS), in[19], in[21], in[22]);
    SEAM(22);
    if (IN(23)) { pg8::EpiStore<0> E{Hb, D}; GEMM_PHASE(pg8::EpiStore<0>, ws + LRU_HS, D, Wo, D, D, D, 0, E); }
    SEAM(23);
    if (IN(24)) norm_phase(F, xout, Hb, xout, Hb, in[2] + 2 * D, in[3] + 2 * D);
    SEAM(24);
    MLP_PHASES(25, 2)
    if (IN(27)) {
        norm_phase(F, xout, Hb, xout, Hb, in[4] + 2 * D, in[1] + 3 * D);
        int base = 0;
        conv_w(F, base, in[24], D, 1840, 0, 1024, 1840, Wi, D, 0, 0.125f * LOG2E);
        conv_w(F, base, in[24], D, 1840, 1024, 1024, 1840, Wi, D, 1024, 1.f);
        conv_w(F, base, in[31], D, D, 0, D, D, Wo, D, 0, 1.f);
        conv_w(F, base, in[26], 2048, 128, 0, 128, 128, (bf16*)(ws + SM_W1K), 2048, 0, 1.f);
        conv_w(F, base, in[29], 2048, 128, 0, 128, 128, (bf16*)(ws + SM_W1V), 2048, 0, 1.f);
        conv_w(F, base, in[27], 128, 64, 0, 64, 64, (bf16*)(ws + SM_W2K), 128, 0, 1.f);
        conv_w(F, base, in[30], 128, 64, 0, 64, 64, (bf16*)(ws + SM_W2V), 128, 0, 1.f);
        CONV_MLP(3, base);
        for (int itx = F.vcu; itx < 4; itx += F.G) {
            const int kv = itx >> 1, c = (itx & 1) * 64 + F.lane;
            const float* pe = kv ? in[28] : in[25]; const float* w1 = kv ? in[29] : in[26];
            float s = 0.f;
            for (int i2 = F.wave * 256; i2 < F.wave * 256 + 256; ++i2) s += pe[i2] * w1[(size_t)i2 * 128 + c];
            LAS float* red = (LAS float*)(F.lds + 8 * 8704);
            __syncthreads();
            red[F.wave * 64 + F.lane] = s;
            __syncthreads();
            if (F.wave == 0) { float tsum = 0.f;
#pragma unroll
                for (int w2 = 0; w2 < 8; ++w2) tsum += red[w2 * 64 + F.lane];
                ((float*)(ws + SM_PEB))[kv * 128 + c] = tsum; }
        }
    }
    SEAM(27);
    if (IN(28)) { pg8::EpiNsa E{(bf16*)(ws + NSA_Q), (bf16*)(ws + NSA_KC), (bf16*)(ws + NSA_VC), (bf16*)(ws + NSA_KS), (bf16*)(ws + NSA_VST), (bf16*)(ws + NSA_KW), (bf16*)(ws + NSA_VWT), (float*)(ws + SM_GATES)};
        GEMM_PHASE(pg8::EpiNsa, Hb, D, Wi, D, 2048, D, 0, E); }
    SEAM(28);
    if (IN(29)) nsa_compress_phase(F, (const bf16*)(ws + NSA_KC), (const bf16*)(ws + NSA_VC), (const bf16*)(ws + SM_W1K), (const bf16*)(ws + SM_W1V), (const bf16*)(ws + SM_W2K), (const bf16*)(ws + SM_W2V),
                                   (const float*)(ws + SM_PEB), (bf16*)(ws + SM_KCMP), (bf16*)(ws + SM_VCMPT));
    SEAM(29);
    if (IN(30)) nsa_attn_phase(F, (const bf16*)(ws + NSA_Q), (const bf16*)(ws + SM_KCMP), (const bf16*)(ws + SM_VCMPT), (const bf16*)(ws + NSA_KS), (const bf16*)(ws + NSA_VST), (const bf16*)(ws + NSA_KW), (const bf16*)(ws + NSA_VWT),
                               (const float*)(ws + SM_GATES), (bf16*)(ws + NSA_O));
    SEAM(30);
    if (IN(31)) { pg8::EpiStore<0> E{Hb, D}; GEMM_PHASE(pg8::EpiStore<0>, ws + NSA_O, D, Wo, D, D, D, 0, E); }
    SEAM(31);
    if (IN(32)) norm_phase(F, xout, Hb, xout, Hb, in[2] + 3 * D, in[3] + 3 * D);
    SEAM(32);
    MLP_PHASES(33, 3)
    if (IN(35)) norm_phase(F, xout, Hb, xout, nullptr, in[4] + 3 * D, nullptr);
#undef IN
#undef SEAM
}

#ifndef MK_PER_PHASE
#define MK_PER_PHASE 0
#endif
extern "C" void kernel_launch(void* const* d_in, const int* in_sizes, int n_in, void* d_out, int out_size, void* d_ws, size_t ws_size, hipStream_t stream) {
    static int grid = 0;
    if (grid == 0) {
        if (n_in != 32 || in_sizes[0] != M * D || out_size != M * D || ws_size < WS_END) { fprintf(stderr, "kernel_launch: unexpected shapes / workspace (n_in %d, ws %zu); nothing launched\n", n_in, ws_size); grid = -1; return; }
        int dev = 0, cus = 0, per_cu = 0;
        if (hipGetDevice(&dev) != hipSuccess || hipDeviceGetAttribute(&cus, hipDeviceAttributeMultiprocessorCount, dev) != hipSuccess) { grid = -1; return; }
        if (hipFuncSetAttribute((const void*)trunk_fwd, hipFuncAttributeMaxDynamicSharedMemorySize, LDS_BYTES) != hipSuccess) { fprintf(stderr, "kernel_launch: hipFuncSetAttribute failed\n"); grid = -1; return; }
        if (hipOccupancyMaxActiveBlocksPerMultiprocessor(&per_cu, (const void*)trunk_fwd, NWAVES * 64, LDS_BYTES) != hipSuccess || per_cu < 1)
            fprintf(stderr, "kernel_launch: note: occupancy query reports %d workgroups per CU\n", per_cu);
        (void)hipGetLastError();
        grid = cus;
    }
    if (grid < 0) return;
    if (hipMemsetAsync((char*)d_ws + WS_CTL, 0, CTL_ZERO_BYTES, stream) != hipSuccess) return;
    Args a{};
    for (int i = 0; i < 32; ++i) a.in[i] = (const float*)d_in[i];
    a.out = (float*)d_out; a.ws = (unsigned char*)d_ws;
#if MK_PER_PHASE
    for (int p = 0; p < N_PHASES; ++p) { a.ph_lo = p; a.ph_hi = p + 1; hipLaunchKernelGGL(trunk_fwd, dim3(grid), dim3(NWAVES * 64), LDS_BYTES, stream, a); }
#else
    a.ph_lo = 0; a.ph_hi = N_PHASES;
    hipLaunchKernelGGL(trunk_fwd, dim3(grid), dim3(NWAVES * 64), LDS_BYTES, stream, a);
#endif
#ifdef PROBE_PHASES
    { const int pp[] = {PROBE_PHASES}; a.dry = 1;
      for (int p : pp) { a.ph_lo = p; a.ph_hi = p + 1; hipLaunchKernelGGL(trunk_fwd, dim3(grid), dim3(NWAVES * 64), LDS_BYTES, stream, a); } }
#endif
}
```

```cpp
#include <hip/hip_runtime.h>
#include <cstdio>
#include <cstdint>
#include <cmath>

namespace pg8 {
#define PG8_LAS __attribute__((address_space(3)))
typedef unsigned short bf16_t;
typedef short bf16x8 __attribute__((ext_vector_type(8)));
typedef float f32x4 __attribute__((ext_vector_type(4)));
typedef unsigned u32x4 __attribute__((ext_vector_type(4)));
typedef unsigned u32x2 __attribute__((ext_vector_type(2)));
constexpr int BM = 256, BK = 64, HALF = 128, HTB = HALF * BK * 2  , STAGE_BYTES = 8 * HTB, NXCD = 8, WGM = 8;

__host__ __device__ __forceinline__ int lds_byte(int r, int c) { const int st = (r >> 4) * 2 + (c >> 5), rr = r & 15, cc = c & 31, ob = rr * 64 + cc * 2; return st * 1024 + (ob ^ (((ob >> 9) & 1) << 5)); }
__host__ __device__ __forceinline__ void stage_rc(int b, int& R, int& C) { const int st = b / 1024, sb = b % 1024, swz = sb ^ (((sb >> 9) & 1) << 5); R = (st >> 1) * 16 + swz / 64; C = (st & 1) * 32 + (swz % 64) / 2; }
__host__ __device__ __forceinline__ int perm32(int rho) { const int n = rho >> 4, i = rho & 15; return 8 * (i >> 2) + 4 * n + (i & 3); }

struct Unit { int pm, pn; };
struct Gemm { const bf16_t* A; const bf16_t* Bt; int M, N, K, lda, ldb; size_t a_pn_step; };

struct StaticOrder {
    int nM, nN, nwg, G, c;
    __host__ __device__ void init(int M, int N, int G_, int c_) { nM = M / BM; nN = N / BM; nwg = nM * nN; G = G_; c = c_; }
    __host__ __device__ bool next(int i, Unit& u) const {
        const long L = (long)i * G + c; if (L >= nwg) return false;
        int wgid = (int)L; { const int q = nwg / NXCD, r = nwg % NXCD, xcd = wgid % NXCD, off = wgid / NXCD; wgid = (xcd < r ? xcd * (q + 1) : r * (q + 1) + (xcd - r) * q) + off; }
        const int nig = WGM * nN, gid = wgid / nig, fm = gid * WGM, gsz = (nM - fm) < WGM ? (nM - fm) : WGM;
        u.pm = fm + ((wgid % nig) % gsz); u.pn = (wgid % nig) / gsz; return true;
    }
    __device__ __forceinline__ void a_ready(const Unit&) const {}
    __device__ __forceinline__ void done(const Unit&) const {}
};

__device__ __forceinline__ unsigned cvt_pk_bf16(float lo, float hi) { unsigned r; asm volatile("v_cvt_pk_bf16_f32 %0, %1, %2" : "=v"(r) : "v"(lo), "v"(hi)); return r; }
__device__ __forceinline__ u32x4 pack8(const f32x4 v0, const f32x4 v1) { u32x4 w; w.x = cvt_pk_bf16(v0[0], v0[1]); w.y = cvt_pk_bf16(v0[2], v0[3]); w.z = cvt_pk_bf16(v1[0], v1[1]); w.w = cvt_pk_bf16(v1[2], v1[3]); return w; }
__device__ __forceinline__ float bf_lo(unsigned w) { return __uint_as_float(w << 16); }
__device__ __forceinline__ float bf_hi(unsigned w) { return __uint_as_float(w & 0xffff0000u); }

template <int ACT> struct EpiStore {
    static constexpr bool PERM = true, AFTER_DRAIN = false;
    bf16_t* O; int ldc;
    __device__ __forceinline__ void operator()(const f32x4 (&acc)[2][2][4][2], const Unit& u, int wr, int wc, int fr, int fq) const {
        const int row0 = u.pm * BM + wr * 64 + fr, col0 = u.pn * BM + wc * 32 + 8 * fq;
#pragma unroll
        for (int ai = 0; ai < 2; ++ai)
#pragma unroll
            for (int m = 0; m < 4; ++m) { bf16_t* rowp = O + (size_t)(row0 + ai * HALF + m * 16) * ldc + col0;
#pragma unroll
                for (int bj = 0; bj < 2; ++bj) { f32x4 v0 = acc[ai][bj][m][0], v1 = acc[ai][bj][m][1];
                    if (ACT == 1) {
#pragma unroll
                        for (int e = 0; e < 4; ++e) { const float a = fmaxf(v0[e], 0.f), b = fmaxf(v1[e], 0.f); v0[e] = a * a; v1[e] = b * b; } }
                    *(u32x4*)(rowp + bj * HALF) = pack8(v0, v1); } }
    }
};

struct EpiRet {
    static constexpr bool PERM = true, AFTER_DRAIN = false;
    bf16_t* O; int ldc;
    __device__ __forceinline__ void operator()(const f32x4 (&acc)[2][2][4][2], const Unit& u, int wr, int wc, int fr, int fq) const {
        const int row0 = u.pm * BM + wr * 64 + fr, col0 = u.pn * BM + wc * 32 + 8 * fq;
        const float lg = __log2f(1.f - exp2f(-5.f - (float)(u.pn & 3)));
        const float sgn = u.pn < 4 ? lg : -lg, mul = u.pn < 4 ? 1.f : 0.0625f;
        const bool scaled = u.pn < 8;
#pragma unroll
        for (int ai = 0; ai < 2; ++ai)
#pragma unroll
            for (int m = 0; m < 4; ++m) { const int row = row0 + ai * HALF + m * 16; bf16_t* rowp = O + (size_t)row * ldc + col0;
                const float sc = scaled ? exp2f(sgn * (float)(row & 63)) * mul : 1.f;
#pragma unroll
                for (int bj = 0; bj < 2; ++bj) *(u32x4*)(rowp + bj * HALF) = pack8(acc[ai][bj][m][0] * sc, acc[ai][bj][m][1] * sc); }
    }
};

struct EpiGla {
    static constexpr bool PERM = true, AFTER_DRAIN = false;
    bf16_t* O; int ldc; const float* bgate;
    __device__ __forceinline__ void operator()(const f32x4 (&acc)[2][2][4][2], const Unit& u, int wr, int wc, int fr, int fq) const {
        const int row0 = u.pm * BM + wr * 64 + fr, col0 = u.pn * BM + wc * 32 + 8 * fq;
        const bool gate = u.pn >= 12;
        f32x4 bv[2][2];
#pragma unroll
        for (int bj = 0; bj < 2; ++bj)
#pragma unroll
            for (int n = 0; n < 2; ++n) bv[bj][n] = gate ? *(const f32x4*)(bgate + (col0 - 3072) + bj * HALF + 4 * n) : (f32x4){0.f, 0.f, 0.f, 0.f};
#pragma unroll
        for (int ai = 0; ai < 2; ++ai)
#pragma unroll
            for (int m = 0; m < 4; ++m) { bf16_t* rowp = O + (size_t)(row0 + ai * HALF + m * 16) * ldc + col0;
#pragma unroll
                for (int bj = 0; bj < 2; ++bj) { f32x4 v0 = acc[ai][bj][m][0], v1 = acc[ai][bj][m][1];
                    if (gate) {
#pragma unroll
                        for (int e = 0; e < 4; ++e) {
                            const float z0 = v0[e] + bv[bj][0][e], z1 = v1[e] + bv[bj][1][e];
                            v0[e] = (fminf(z0, 0.f) - log1pf(__expf(-fabsf(z0)))) * 0.0625f;
                            v1[e] = (fminf(z1, 0.f) - log1pf(__expf(-fabsf(z1)))) * 0.0625f; } }
                    *(u32x4*)(rowp + bj * HALF) = pack8(v0, v1); } }
    }
};

struct EpiNsa {
    static constexpr bool PERM = true, AFTER_DRAIN = false;
    bf16_t* Q; bf16_t* KC; bf16_t* VC; bf16_t* KS; bf16_t* VST; bf16_t* KW; bf16_t* VWT; float* GATES;
    template <bool VTRANS> __device__ __forceinline__ void kv_store(const f32x4 (&acc)[2][2][4][2], bf16_t* Kt, bf16_t* Vt, int row0, int c8) const {
        const int g = c8 >> 6, d = c8 & 63;
#pragma unroll
        for (int ai = 0; ai < 2; ++ai)
#pragma unroll
            for (int m = 0; m < 4; ++m) {
                const int row = row0 + ai * HALF + m * 16, b = row >> 12, t = row & 4095;
                const size_t bg = (size_t)(b * 2 + g);
                *(u32x4*)(Kt + (bg * 4096 + t) * 64 + d) = pack8(acc[ai][0][m][0], acc[ai][0][m][1]);
                const u32x4 w = pack8(acc[ai][1][m][0], acc[ai][1][m][1]);
                if (!VTRANS) *(u32x4*)(Vt + (bg * 4096 + t) * 64 + d) = w;
                else {
                    bf16_t* vp = Vt + (bg * 64 + d) * 4096 + t;
                    vp[0 * 4096] = (bf16_t)(w.x & 0xffffu); vp[1 * 4096] = (bf16_t)(w.x >> 16);
                    vp[2 * 4096] = (bf16_t)(w.y & 0xffffu); vp[3 * 4096] = (bf16_t)(w.y >> 16);
                    vp[4 * 4096] = (bf16_t)(w.z & 0xffffu); vp[5 * 4096] = (bf16_t)(w.z >> 16);
                    vp[6 * 4096] = (bf16_t)(w.w & 0xffffu); vp[7 * 4096] = (bf16_t)(w.w >> 16);
                }
            }
    }
    __device__ __forceinline__ void operator()(const f32x4 (&acc)[2][2][4][2], const Unit& u, int wr, int wc, int fr, int fq) const {
        const int row0 = u.pm * BM + wr * 64 + fr, c8 = wc * 32 + 8 * fq;
        if (u.pn < 4) {
#pragma unroll
            for (int ai = 0; ai < 2; ++ai)
#pragma unroll
                for (int m = 0; m < 4; ++m) { bf16_t* rowp = Q + (size_t)(row0 + ai * HALF + m * 16) * 1024 + u.pn * BM + c8;
#pragma unroll
                    for (int bj = 0; bj < 2; ++bj) *(u32x4*)(rowp + bj * HALF) = pack8(acc[ai][bj][m][0], acc[ai][bj][m][1]); }
        } else if (u.pn == 4) { kv_store<false>(acc, KC, VC, row0, c8);
        } else if (u.pn == 5) { kv_store<true>(acc, KS, VST, row0, c8);
        } else if (u.pn == 6) { kv_store<true>(acc, KW, VWT, row0, c8);
        } else {
            if (c8 < 48) {
#pragma unroll
                for (int ai = 0; ai < 2; ++ai)
#pragma unroll
                    for (int m = 0; m < 4; ++m) { float* gp = GATES + (size_t)(row0 + ai * HALF + m * 16) * 48 + c8;
                        f32x4 v0 = acc[ai][0][m][0], v1 = acc[ai][0][m][1];
#pragma unroll
                        for (int e = 0; e < 4; ++e) { v0[e] = 1.f / (1.f + __expf(-v0[e])); v1[e] = 1.f / (1.f + __expf(-v1[e])); }
                        *(f32x4*)gp = v0; *(f32x4*)(gp + 4) = v1; }
            }
        }
    }
};

template <class Epi, class Sched, bool ALIGN_EPI = false, bool SP2 = false>
__device__ __forceinline__ void gemm_phase(PG8_LAS unsigned char* lds, const Gemm g, const Sched& S, const Epi& E) {
    const int tid = threadIdx.x, wid = __builtin_amdgcn_readfirstlane(tid >> 6), lane = tid & 63, wr = wid >> 2, wc = wid & 3, fr = lane & 15, fq = lane >> 4;
    const int K = g.K, nt = K / BK;
    unsigned voffA[2], voffB[2];
#pragma unroll
    for (int i = 0; i < 2; ++i) { int R, C; stage_rc(tid * 16 + i * 8192, R, C); const int Rb = Epi::PERM ? ((R & ~31) + perm32(R & 31)) : R;
        voffA[i] = (unsigned)(R * g.lda + C) * 2u; voffB[i] = (unsigned)(Rb * g.ldb + C) * 2u; }
    const size_t kstep = (size_t)(BK * 2);
    const size_t hstepA = (size_t)HALF * g.lda * 2, hstepB = (size_t)HALF * g.ldb * 2;
    const size_t tstepA = 2 * hstepA, tstepB = 2 * hstepB;
    const unsigned ldsw = (unsigned)wid * 1024u;
    const int aoff = lds_byte(wr * 64 + fr, fq * 8), boff = lds_byte(wc * 32 + fr, fq * 8);
#define PG8_SA(b, h) (((b) * 2 + (h)) * HTB)
#define PG8_SB(b, h) ((4 + (b) * 2 + (h)) * HTB)
#define PG8_STAGE(bufoff, gbase, voff) do { _Pragma("unroll") for (int _i = 0; _i < 2; ++_i) \
        __builtin_amdgcn_global_load_lds((const unsigned*)((const char*)(gbase) + (voff)[_i]), (PG8_LAS unsigned*)(lds + (bufoff) + ldsw + _i * 8192), 16, 0, 0); } while (0)
#define PG8_LDA(dst, b, h) do { _Pragma("unroll") for (int m = 0; m < 4; ++m) _Pragma("unroll") for (int k = 0; k < 2; ++k) dst[m][k] = *(const PG8_LAS bf16x8*)(lds + PG8_SA(b, h) + aoff + m * 2048 + k * 1024); } while (0)
#define PG8_LDB(dst, b, h) do { _Pragma("unroll") for (int n = 0; n < 2; ++n) _Pragma("unroll") for (int k = 0; k < 2; ++k) dst[n][k] = *(const PG8_LAS bf16x8*)(lds + PG8_SB(b, h) + boff + n * 2048 + k * 1024); } while (0)
#define PG8_MMA(ai, bj, At, Bt) do { __builtin_amdgcn_s_setprio(1); _Pragma("unroll") for (int m = 0; m < 4; ++m) _Pragma("unroll") for (int n = 0; n < 2; ++n) _Pragma("unroll") for (int k = 0; k < 2; ++k) \
        acc[ai][bj][m][n] = __builtin_amdgcn_mfma_f32_16x16x32_bf16(Bt[n][k], At[m][k], acc[ai][bj][m][n], 0, 0, 0); __builtin_amdgcn_s_setprio(0); } while (0)
#define PG8_WAIT_V(n) asm volatile("s_waitcnt vmcnt(" #n ")" ::: "memory")
#define PG8_WAIT_L(n) asm volatile("s_waitcnt lgkmcnt(" #n ")" ::: "memory")
#define PG8_BAR __builtin_amdgcn_s_barrier()
#define PG8_SCHED __builtin_amdgcn_sched_barrier(0)
    Unit cur, nxt; int ui = 0;
    if (!S.next(0, cur)) return;
    f32x4 acc[2][2][4][2];
#pragma unroll
    for (int a = 0; a < 2; ++a)
#pragma unroll
        for (int b = 0; b < 2; ++b)
#pragma unroll
            for (int m = 0; m < 4; ++m)
#pragma unroll
                for (int n = 0; n < 2; ++n) acc[a][b][m][n] = (f32x4){0.f, 0.f, 0.f, 0.f};
    bf16x8 At[4][2], B0[2][2], B1[2][2];
    const char* cA = (const char*)g.A + (size_t)cur.pm * tstepA + (size_t)cur.pn * g.a_pn_step; const char* cB = (const char*)g.Bt + (size_t)cur.pn * tstepB;
    S.a_ready(cur);
    if constexpr (SP2) {
        PG8_STAGE(PG8_SB(0, 0), cB, voffB); PG8_STAGE(PG8_SB(0, 1), cB + hstepB, voffB); PG8_STAGE(PG8_SA(0, 0), cA, voffA); PG8_STAGE(PG8_SA(0, 1), cA + hstepA, voffA);
        if (wr == 1) PG8_BAR;
        PG8_WAIT_V(2); PG8_BAR;
        PG8_STAGE(PG8_SB(1, 0), cB + kstep, voffB); PG8_STAGE(PG8_SA(1, 0), cA + kstep, voffA); PG8_STAGE(PG8_SB(1, 1), cB + hstepB + kstep, voffB);
        PG8_WAIT_V(6); PG8_BAR;
    } else {
        PG8_STAGE(PG8_SB(0, 0), cB, voffB); PG8_STAGE(PG8_SA(0, 0), cA, voffA); PG8_STAGE(PG8_SB(0, 1), cB + hstepB, voffB); PG8_STAGE(PG8_SA(0, 1), cA + hstepA, voffA);
        if (wr == 1) PG8_BAR;
        PG8_WAIT_V(4); PG8_BAR;
        PG8_STAGE(PG8_SB(1, 0), cB + kstep, voffB); PG8_STAGE(PG8_SA(1, 0), cA + kstep, voffA); PG8_STAGE(PG8_SB(1, 1), cB + hstepB + kstep, voffB);
        PG8_WAIT_V(6); PG8_BAR;
    }
    for (;;) {
        const bool has_next = S.next(ui + 1, nxt);
        const char* nA = has_next ? (const char*)g.A + (size_t)nxt.pm * tstepA + (size_t)nxt.pn * g.a_pn_step : cA; const char* nB = has_next ? (const char*)g.Bt + (size_t)nxt.pn * tstepB : cB;
        for (int t = 0; t < nt; t += 2) {
            const bool last = (t == nt - 2);
            const char* a1 = cA + (size_t)(t + 1) * kstep;
            const char* a2 = last ? nA : cA + (size_t)(t + 2) * kstep; const char* b2 = last ? nB : cB + (size_t)(t + 2) * kstep;
            const char* a3 = a2 + kstep; const char* b3 = b2 + kstep;
            if (last && has_next) S.a_ready(nxt);
            if constexpr (SP2) {
            PG8_LDB(B0, 0, 0); PG8_LDB(B1, 0, 1); PG8_SCHED; PG8_LDA(At, 0, 0); PG8_STAGE(PG8_SA(1, 1), a1 + hstepA, voffA);
            PG8_WAIT_V(8); PG8_WAIT_L(0); PG8_BAR; PG8_MMA(0, 0, At, B0); PG8_MMA(0, 1, At, B1); PG8_BAR; PG8_SCHED;
            PG8_LDA(At, 0, 1); PG8_STAGE(PG8_SB(0, 0), b2, voffB); PG8_STAGE(PG8_SB(0, 1), b2 + hstepB, voffB); PG8_STAGE(PG8_SA(0, 0), a2, voffA);
            PG8_WAIT_V(8); PG8_WAIT_L(0); PG8_BAR; PG8_MMA(1, 0, At, B0); PG8_MMA(1, 1, At, B1); PG8_BAR; PG8_SCHED;
            PG8_LDB(B0, 1, 0); PG8_LDB(B1, 1, 1); PG8_SCHED; PG8_LDA(At, 1, 0); PG8_STAGE(PG8_SA(0, 1), a2 + hstepA, voffA);
            PG8_WAIT_V(8); PG8_WAIT_L(0); PG8_BAR; PG8_MMA(0, 0, At, B0); PG8_MMA(0, 1, At, B1); PG8_BAR; PG8_SCHED;
            PG8_LDA(At, 1, 1); PG8_STAGE(PG8_SB(1, 0), b3, voffB); PG8_STAGE(PG8_SB(1, 1), b3 + hstepB, voffB); PG8_STAGE(PG8_SA(1, 0), a3, voffA);
            PG8_WAIT_V(8); PG8_WAIT_L(0); PG8_BAR; PG8_MMA(1, 0, At, B0); PG8_MMA(1, 1, At, B1); PG8_BAR; PG8_SCHED;
            } else {
            PG8_LDB(B0, 0, 0); PG8_SCHED; PG8_LDA(At, 0, 0); PG8_STAGE(PG8_SA(1, 1), a1 + hstepA, voffA);
            PG8_WAIT_L(8); PG8_BAR; PG8_WAIT_L(0); PG8_MMA(0, 0, At, B0); PG8_BAR; PG8_SCHED;
            PG8_LDB(B1, 0, 1); PG8_STAGE(PG8_SB(0, 0), b2, voffB);
            PG8_BAR; PG8_WAIT_L(0); PG8_MMA(0, 1, At, B1); PG8_BAR;
            PG8_LDA(At, 0, 1); PG8_STAGE(PG8_SA(0, 0), a2, voffA);
            PG8_BAR; PG8_WAIT_L(0); PG8_MMA(1, 0, At, B0); PG8_BAR; PG8_SCHED;
            PG8_STAGE(PG8_SB(0, 1), b2 + hstepB, voffB);
            PG8_WAIT_V(6); PG8_BAR; PG8_MMA(1, 1, At, B1); PG8_BAR;
            PG8_LDB(B0, 1, 0); PG8_SCHED; PG8_LDA(At, 1, 0); PG8_STAGE(PG8_SA(0, 1), a2 + hstepA, voffA);
            PG8_WAIT_L(8); PG8_BAR; PG8_WAIT_L(0); PG8_MMA(0, 0, At, B0); PG8_BAR; PG8_SCHED;
            PG8_LDB(B1, 1, 1); PG8_STAGE(PG8_SB(1, 0), b3, voffB);
            PG8_BAR; PG8_WAIT_L(0); PG8_MMA(0, 1, At, B1); PG8_BAR;
            PG8_LDA(At, 1, 1); PG8_STAGE(PG8_SA(1, 0), a3, voffA);
            PG8_BAR; PG8_WAIT_L(0); PG8_MMA(1, 0, At, B0); PG8_BAR; PG8_SCHED;
            PG8_STAGE(PG8_SB(1, 1), b3 + hstepB, voffB);
            PG8_WAIT_V(6); PG8_BAR; PG8_MMA(1, 1, At, B1); PG8_BAR;
            }
        }
        if constexpr (ALIGN_EPI) { if (wr == 0) PG8_BAR; }
        if constexpr (!Epi::AFTER_DRAIN) { E(acc, cur, wr, wc, fr, fq); S.done(cur); }
        if (!has_next) break;
#pragma unroll
        for (int a = 0; a < 2; ++a)
#pragma unroll
            for (int b = 0; b < 2; ++b)
#pragma unroll
                for (int m = 0; m < 4; ++m)
#pragma unroll
                    for (int n = 0; n < 2; ++n) acc[a][b][m][n] = (f32x4){0.f, 0.f, 0.f, 0.f};
        cur = nxt; cA = nA; cB = nB; ++ui;
        if constexpr (ALIGN_EPI) { if (wr == 1) PG8_BAR; }
    }
    PG8_WAIT_V(0);
    if constexpr (!ALIGN_EPI) { if (wr == 0) PG8_BAR; }
    PG8_BAR;
    if constexpr (Epi::AFTER_DRAIN) { E.fused(acc, cur, wr, wc, fr, fq, lds, wid, lane); S.done(cur); }
#undef PG8_SA
#undef PG8_SB
#undef PG8_STAGE
#undef PG8_LDA
#undef PG8_LDB
#undef PG8_MMA
#undef PG8_WAIT_V
#undef PG8_WAIT_L
#undef PG8_BAR
#undef PG8_SCHED
}
}

constexpr int BATCH = 8, SEQ = 4096, D = 1024, FF = 4096;
constexpr int M = BATCH * SEQ;
constexpr float NORM_EPS = 1e-6f;
constexpr int NWAVES = 8;
constexpr float LOG2E = 1.4426950408889634f;

constexpr size_t MiB = 1u << 20;
constexpr size_t WS_CTL = 0, CTL_ZERO_BYTES = 64 * 1024;
constexpr size_t WS_WIN = 1 * MiB, WS_WOUT = 13 * MiB, WS_WUP = 17 * MiB, WS_WDN = 25 * MiB;
constexpr size_t WS_H = 33 * MiB;
constexpr size_t WS_BIG = 97 * MiB;
constexpr size_t WS_SMALL = 481 * MiB;
constexpr size_t WS_END = 512 * MiB;
constexpr size_t SM_LRUW = WS_SMALL;
constexpr size_t SM_SCANP = WS_SMALL + 1 * MiB, SM_SCANE = WS_SMALL + 3 * MiB;
constexpr size_t SM_W1K = WS_SMALL + 5 * MiB, SM_W1V = SM_W1K + 512 * 1024;
constexpr size_t SM_W2K = WS_SMALL + 6 * MiB, SM_W2V = SM_W2K + 16 * 1024, SM_PEB = SM_W2V + 16 * 1024;
constexpr size_t SM_KCMP = WS_SMALL + 7 * MiB, SM_VCMPT = SM_KCMP + 512 * 1024;
constexpr size_t SM_GATES = WS_SMALL + 8 * MiB;
constexpr size_t SM_AT = WS_SMALL;
constexpr size_t SM_GLAW = WS_SMALL + 16 * MiB;
constexpr size_t LRU_XY = WS_BIG, LRU_XC = WS_BIG + 128 * MiB, LRU_GP = WS_BIG + 192 * MiB, LRU_HS = WS_BIG + 320 * MiB;
constexpr size_t NSA_Q = WS_BIG, NSA_KC = WS_BIG + 64 * MiB, NSA_VC = NSA_KC + 8 * MiB, NSA_KS = NSA_KC + 16 * MiB, NSA_VST = NSA_KC + 24 * MiB,
                 NSA_KW = NSA_KC + 32 * MiB, NSA_VWT = NSA_KC + 40 * MiB, NSA_O = WS_BIG + 128 * MiB;
constexpr int CW_BAR = 1024;

constexpr int RING_OFF = 0, SCR_BYTES = 143360;
constexpr int LDSCTL_OFF = SCR_BYTES;
constexpr int LDS_BYTES = 147456;

#define GAS __attribute__((address_space(1)))
#define LAS __attribute__((address_space(3)))
typedef unsigned short bf16;
typedef unsigned v4u __attribute__((ext_vector_type(4)));
typedef unsigned v2u __attribute__((ext_vector_type(2)));
typedef float f32x4 __attribute__((ext_vector_type(4)));
typedef float f32x2 __attribute__((ext_vector_type(2)));
typedef float f32x16 __attribute__((ext_vector_type(16)));
typedef short bf16x8 __attribute__((ext_vector_type(8)));
typedef short s16x4 __attribute__((ext_vector_type(4)));
#define MFMA32(a, b, c) __builtin_amdgcn_mfma_f32_32x32x16_bf16((a), (b), (c), 0, 0, 0)
__device__ __forceinline__ unsigned f2bf(float f) { unsigned u = __builtin_bit_cast(unsigned, f); return (u + 0x7fffu + ((u >> 16) & 1u)) >> 16; }
__device__ __forceinline__ unsigned pk2(float lo, float hi) { return f2bf(lo) | (f2bf(hi) << 16); }
__device__ __forceinline__ float bflo(unsigned w) { return __uint_as_float(w << 16); }
__device__ __forceinline__ float bfhi(unsigned w) { return __uint_as_float(w & 0xffff0000u); }
__device__ __forceinline__ float bf1(bf16 v) { return __uint_as_float((unsigned)v << 16); }
__device__ __forceinline__ float gelu_tanh(float x) { const float z = 0.7978845608028654f * (x + 0.044715f * x * x * x); const float t = 1.f - 2.f / (1.f + __expf(2.f * z)); return 0.5f * x * (1.f + t); }
__device__ __forceinline__ float silu(float x) { return x / (1.f + __expf(-x)); }

#define XB_TMO      128
#define XB_XCNT(j)  (256  + 64 * (j))
#define XB_XSUB(j)  (1280 + 64 * (j))
#define XB_XGEN(j)  (2304 + 64 * (j))
#define XB_TOP      3328
#define XB_TOPGEN   3392
#define XCD_BAR_WORDS 3456
#define XB_SPIN_CAP (1u << 18)
#define LAS __attribute__((address_space(3)))

__device__ __forceinline__ unsigned xb_ld(unsigned* p)              { return __hip_atomic_load(p, __ATOMIC_RELAXED, __HIP_MEMORY_SCOPE_AGENT); }
__device__ __forceinline__ unsigned xb_add(unsigned* p, unsigned v) { return __hip_atomic_fetch_add(p, v, __ATOMIC_RELAXED, __HIP_MEMORY_SCOPE_AGENT); }
__device__ __forceinline__ unsigned xb_xcc_id() { return (unsigned)__builtin_amdgcn_s_getreg((3 << 11) | 20) & 0xFu; }
#define XB_SPIN(cond, bar) do { unsigned _sp = 0; while (cond) { __builtin_amdgcn_s_sleep(1); \
    if ((++_sp & 255u) == 0u) { if (xb_ld(&(bar)[XB_TMO])) break; if (_sp > XB_SPIN_CAP) { atomicAdd(&(bar)[XB_TMO], 1u); break; } } } } while (0)

struct XcdBarrier {
    unsigned* bar; unsigned x;
    volatile LAS unsigned* st;
};

__device__ __forceinline__ XcdBarrier xcd_barrier_post(unsigned* bar, volatile LAS unsigned* st) {
    XcdBarrier b; b.bar = bar; b.x = xb_xcc_id(); b.st = st;
    if (threadIdx.x == 0) (void)xb_add(&bar[XB_XCNT(b.x)], 1u);
    return b;
}
__device__ __forceinline__ void xcd_barrier_complete(unsigned* bar, unsigned x, unsigned& nloc, unsigned& nx) {
    const unsigned G = gridDim.x * gridDim.y * gridDim.z;
    unsigned sum, cnt, mine, sp = 0u;
    for (;;) {
        sum = 0u; cnt = 0u; mine = 0u;
#pragma unroll
        for (unsigned j = 0; j < 16; ++j) { const unsigned c = xb_ld(&bar[XB_XCNT(j)]); sum += c; cnt += (c > 0u) ? 1u : 0u; mine = (j == x) ? c : mine; }
        if (sum == G) break;
        __builtin_amdgcn_s_sleep(1);
        if ((++sp & 255u) == 0u) { if (xb_ld(&bar[XB_TMO])) break; if (sp > XB_SPIN_CAP) { atomicAdd(&bar[XB_TMO], 1u); break; } }
    }
    nloc = mine > 0u ? mine : 1u; nx = cnt > 0u ? cnt : 1u;
}

__device__ __forceinline__ void xcd_barrier(const XcdBarrier& b) {
    asm volatile("s_waitcnt vmcnt(0)" ::: "memory");
    __syncthreads();
    if (threadIdx.x == 0) {
        unsigned* bar = b.bar;
        __builtin_amdgcn_s_waitcnt(0);
        unsigned nloc = b.st[0], nx = b.st[1];
        if (nloc == 0u) { xcd_barrier_complete(bar, b.x, nloc, nx); b.st[0] = nloc; b.st[1] = nx; }
        const unsigned old = xb_add(&bar[XB_XSUB(b.x)], 1u);
        const unsigned gen = old / nloc;
        if (old + 1u == (gen + 1u) * nloc) {
            __builtin_amdgcn_fence(__ATOMIC_RELEASE, "agent");
            asm volatile("s_waitcnt vmcnt(0)" ::: "memory");
            const unsigned og = xb_add(&bar[XB_TOP], 1u);
            const unsigned tg = og / nx;
            if (og + 1u == (tg + 1u) * nx) xb_add(&bar[XB_TOPGEN], 1u);
            else XB_SPIN(xb_ld(&bar[XB_TOPGEN]) == tg, bar);
            __builtin_amdgcn_fence(__ATOMIC_ACQUIRE, "agent");
            xb_add(&bar[XB_XGEN(b.x)], 1u);
            asm volatile("s_waitcnt vmcnt(0)" ::: "memory");
        } else {
            XB_SPIN(xb_ld(&bar[XB_XGEN(b.x)]) == gen, bar);
            __builtin_amdgcn_fence(__ATOMIC_ACQUIRE, "agent");
            asm volatile("s_waitcnt vmcnt(0)" ::: "memory");
        }
    }
    __syncthreads();
}

struct Frame {
    LAS unsigned char* lds;
    int tid, lane, wave;
    int vcu, G;
    unsigned char* ws;
    int dry;
};

__device__ __forceinline__ bool frame_refresh(Frame& F) { int tz = threadIdx.x; asm volatile("" : "+v"(tz)); F.tid = tz; F.lane = tz & 63; return true; }
__device__ __forceinline__ float wave_sum(float v) {
#pragma unroll
    for (int o = 1; o < 64; o <<= 1) v += __shfl_xor(v, o);
    return v;
}
__device__ __forceinline__ float grp16_sum(float v) {
#pragma unroll
    for (int o = 1; o < 16; o <<= 1) v += __shfl_xor(v, o);
    return v;
}

__device__ __forceinline__ void conv_w(Frame& F, int& base, const float* W, int K, int ldw, int n_src0, int ncols, int n_valid, bf16* WT, int ldk, int row_off, float scale) {
    LAS float* scr = (LAS float*)(F.lds + F.wave * 8704);
    const int gw = F.vcu * NWAVES + F.wave, NGW = F.G * NWAVES, lane = F.lane;
    const int nblk = ncols / 32, items = (K / 64) * nblk;
    int start = (gw - base % NGW + NGW) % NGW; base += items;
    for (int it = start; it < items; it += NGW) {
        const int kb = it / nblk, nb = it % nblk, k0 = 64 * kb, n0 = 32 * nb;
        const int nn = n_src0 + n0 + (lane & 31); const bool ok = nn < n_valid;
#pragma unroll 8
        for (int i = 0; i < 32; ++i) { const int kk = 2 * i + (lane >> 5); scr[kk * 33 + (lane & 31)] = ok ? W[(size_t)(k0 + kk) * ldw + nn] * scale : 0.f; }
        asm volatile("s_waitcnt lgkmcnt(0)" ::: "memory");
        const int c = lane & 7;
#pragma unroll
        for (int j = 0; j < 4; ++j) { const int n = (lane >> 3) + 8 * j; const LAS float* s = scr + (8 * c) * 33 + n;
            v4u o; o.x = pk2(s[0 * 33], s[1 * 33]); o.y = pk2(s[2 * 33], s[3 * 33]); o.z = pk2(s[4 * 33], s[5 * 33]); o.w = pk2(s[6 * 33], s[7 * 33]);
            *(v4u*)(WT + (size_t)(row_off + n0 + n) * ldk + k0 + 8 * c) = o; }
        asm volatile("s_waitcnt lgkmcnt(0)" ::: "memory");
    }
}

__device__ __forceinline__ void norm_phase(Frame& F, const float* xin, const bf16* Y, float* xout, bf16* H, const float* gpost, const float* gpre) {
    const int gw = F.vcu * NWAVES + F.wave, NGW = F.G * NWAVES, lane = F.lane;
    for (int m = gw; m < M; m += NGW) {
        const f32x4* xr = (const f32x4*)(xin + (size_t)m * D) + lane;
        f32x4 v[4];
#pragma unroll
        for (int j = 0; j < 4; ++j) v[j] = xr[64 * j];
        if (Y) {
            const v2u* yr = (const v2u*)(Y + (size_t)m * D) + lane;
            f32x4 y[4]; float ss = 0.f;
#pragma unroll
            for (int j = 0; j < 4; ++j) { const v2u w = yr[64 * j]; y[j] = (f32x4){bflo(w.x), bfhi(w.x), bflo(w.y), bfhi(w.y)}; ss += (y[j].x * y[j].x + y[j].y * y[j].y) + (y[j].z * y[j].z + y[j].w * y[j].w); }
            const float rstd = rsqrtf(wave_sum(ss) * (1.f / D) + NORM_EPS);
#pragma unroll
            for (int j = 0; j < 4; ++j) { const f32x4 g = *((const f32x4*)gpost + lane + 64 * j); v[j] = v[j] + y[j] * rstd * g; }
        }
        if (xout && !F.dry) { f32x4* xo = (f32x4*)(xout + (size_t)m * D) + lane;
#pragma unroll
            for (int j = 0; j < 4; ++j) xo[64 * j] = v[j]; }
        if (H && !F.dry) {
            float ss = 0.f;
#pragma unroll
            for (int j = 0; j < 4; ++j) ss += (v[j].x * v[j].x + v[j].y * v[j].y) + (v[j].z * v[j].z + v[j].w * v[j].w);
            const float rstd = rsqrtf(wave_sum(ss) * (1.f / D) + NORM_EPS);
            v2u* ho = (v2u*)(H + (size_t)m * D) + lane;
#pragma unroll
            for (int j = 0; j < 4; ++j) { const f32x4 g = *((const f32x4*)gpre + lane + 64 * j); const f32x4 o = v[j] * rstd * g;
                v2u w; w.x = pk2(o.x, o.y); w.y = pk2(o.z, o.w); ho[64 * j] = w; }
        }
    }
}

template <int DK, int DV, int CS, bool ISGLA>
__device__ __forceinline__ void recur_phase(Frame& F, bf16* base, int ld, int qoff, int koff, int voff, int laoff, float kscale) {
    constexpr int NS = DV / CS, NDG = 512 / CS, DPT = DK / NDG, TB = 16, NT = ISGLA ? 3 : 2, NB = SEQ / TB;
    constexpr int STG = NT * TB * DK, VST = TB * CS, RED = NDG * TB * CS;
    static_assert((2 * STG + 2 * VST + 2 * RED) * 4 <= SCR_BYTES, "recurrent phase LDS");
    LAS float* stage = (LAS float*)F.lds; LAS float* vst = stage + 2 * STG; LAS float* red = vst + 2 * VST;
    const int tid = F.tid, c = tid % CS, dg = tid / CS;
    constexpr int QCH = TB * DK / 8, VCH = TB * CS / 8;
    const bool ldq = tid < QCH, ldv = tid < VCH;
    const int qt_ = tid / (DK / 8), qd = (tid % (DK / 8)) * 8;
    const int vt_ = tid / (CS / 8), vc_ = (tid % (CS / 8)) * 8;
    for (int it = F.vcu; it < 32 * NS; it += F.G) {
        const int bh = it / NS, sl = it % NS, b = bh >> 2, h = bh & 3;
        bf16* rowbase = base + (size_t)b * SEQ * ld;
        const bf16* qp = rowbase + qoff + h * DK; const bf16* kp = rowbase + koff + h * DK; const bf16* lap = rowbase + laoff + h * DK;
        bf16* vp = rowbase + voff + h * DV + sl * CS;
        const float gamma = 1.f - exp2f(-5.f - (float)h);
        f32x2 S[DPT / 2];
#pragma unroll
        for (int i = 0; i < DPT / 2; ++i) S[i] = (f32x2){0.f, 0.f};
        v4u rq = {0, 0, 0, 0}, rk = {0, 0, 0, 0}, rl = {0, 0, 0, 0}, rv = {0, 0, 0, 0};
#define RC_GLOAD(n_) do { \
            if (ldq) { const size_t o_ = (size_t)((n_) * TB + qt_) * ld + qd; rq = *(const v4u*)(qp + o_); rk = *(const v4u*)(kp + o_); if (ISGLA) rl = *(const v4u*)(lap + o_); } \
            if (ldv) { rv = *(const v4u*)(vp + (size_t)((n_) * TB + vt_) * ld + vc_); } } while (0)
#define RC_SWRITE(buf_) do { \
            LAS float* st_ = stage + (buf_) * STG; \
            if (ldq) { \
                LAS float* q_ = st_ + qt_ * DK + qd; LAS float* k_ = st_ + TB * DK + qt_ * DK + qd; \
                *(LAS f32x4*)q_ = (f32x4){bflo(rq.x), bfhi(rq.x), bflo(rq.y), bfhi(rq.y)}; *(LAS f32x4*)(q_ + 4) = (f32x4){bflo(rq.z), bfhi(rq.z), bflo(rq.w), bfhi(rq.w)}; \
                *(LAS f32x4*)k_ = (f32x4){bflo(rk.x), bfhi(rk.x), bflo(rk.y), bfhi(rk.y)} * kscale; *(LAS f32x4*)(k_ + 4) = (f32x4){bflo(rk.z), bfhi(rk.z), bflo(rk.w), bfhi(rk.w)} * kscale; \
                if (ISGLA) { LAS float* a_ = st_ + 2 * TB * DK + qt_ * DK + qd; \
                    *(LAS f32x4*)a_ = (f32x4){__expf(bflo(rl.x)), __expf(bfhi(rl.x)), __expf(bflo(rl.y)), __expf(bfhi(rl.y))}; \
                    *(LAS f32x4*)(a_ + 4) = (f32x4){__expf(bflo(rl.z)), __expf(bfhi(rl.z)), __expf(bflo(rl.w)), __expf(bfhi(rl.w))}; } \
            } \
            if (ldv) { LAS float* v_ = vst + (buf_) * VST + vt_ * CS + vc_; \
                *(LAS f32x4*)v_ = (f32x4){bflo(rv.x), bfhi(rv.x), bflo(rv.y), bfhi(rv.y)}; *(LAS f32x4*)(v_ + 4) = (f32x4){bflo(rv.z), bfhi(rv.z), bflo(rv.w), bfhi(rv.w)}; } } while (0)
        __syncthreads();
        RC_GLOAD(0); RC_SWRITE(0);
        __syncthreads();
        for (int n = 0; n < NB; ++n) {
            const int cur = n & 1;
            if (n + 1 < NB) RC_GLOAD(n + 1);
            const LAS float* qs = stage + cur * STG + dg * DPT; const LAS float* ks = qs + TB * DK; const LAS float* as = qs + 2 * TB * DK;
            const LAS float* vs = vst + cur * VST + c;
            LAS float* rd = red + cur * RED + dg * TB * CS + c;
#pragma unroll
            for (int t = 0; t < TB; ++t) {
                const float vv = vs[t * CS];
                f32x2 acc = {0.f, 0.f};
#pragma unroll
                for (int i = 0; i < DPT; i += 4) {
                    const f32x4 k4 = *(const LAS f32x4*)(ks + t * DK + i), q4 = *(const LAS f32x4*)(qs + t * DK + i);
                    f32x2 d0, d1;
                    if (ISGLA) { const f32x4 a4 = *(const LAS f32x4*)(as + t * DK + i); d0 = (f32x2){a4.x, a4.y}; d1 = (f32x2){a4.z, a4.w}; } else { d0 = (f32x2){gamma, gamma}; d1 = d0; }
                    S[i / 2] = S[i / 2] * d0 + (f32x2){k4.x, k4.y} * vv; acc += (f32x2){q4.x, q4.y} * S[i / 2];
                    S[i / 2 + 1] = S[i / 2 + 1] * d1 + (f32x2){k4.z, k4.w} * vv; acc += (f32x2){q4.z, q4.w} * S[i / 2 + 1];
                }
                rd[t * CS] = acc.x + acc.y;
            }
            if (n + 1 < NB) RC_SWRITE(cur ^ 1);
            __syncthreads();
#pragma unroll
            for (int rep = 0; rep < (TB * CS + 511) / 512; ++rep) {
                const int idx = tid + rep * 512;
                if (idx < TB * CS) {
                    const LAS float* rr = red + cur * RED + idx; float s = 0.f;
#pragma unroll
                    for (int g = 0; g < NDG; ++g) s += rr[g * TB * CS];
                    const int t = idx / CS, cc = idx % CS;
                    if (!F.dry) vp[(size_t)(n * TB + t) * ld + cc] = (bf16)f2bf(s);
                }
            }
        }
    }
    __syncthreads();
}

template <int DK>
__device__ __forceinline__ void chunk_a_phase(Frame& F, const bf16* base, int ld, int qoff, int koff, bf16* AT) {
    const int tid = F.tid, w = F.wave, grp = w / 3, wt = w % 3;
    if (w >= 6) return;
    const int r = tid & 31, hh = (tid >> 5) & 1;
    for (int it = F.vcu * 2 + grp; it < 32 * 64; it += F.G * 2) {
        const int bh = it >> 6, c = it & 63, b = bh >> 2, h = bh & 3;
        const int jt = wt >> 1, itl = (wt + 1) >> 1;
        const bf16* kp = base + ((size_t)b * SEQ + 64 * c + 32 * jt + r) * ld + koff + h * DK + 8 * hh;
        const bf16* qp = base + ((size_t)b * SEQ + 64 * c + 32 * itl + r) * ld + qoff + h * DK + 8 * hh;
        f32x16 a0 = {}, a1 = {};
#pragma unroll
        for (int s = 0; s < DK / 16; s += 2) { a0 = MFMA32(*(const bf16x8*)(kp + 16 * s), *(const bf16x8*)(qp + 16 * s), a0); a1 = MFMA32(*(const bf16x8*)(kp + 16 * s + 16), *(const bf16x8*)(qp + 16 * s + 16), a1); }
        const int lim = (jt == itl) ? r - 4 * hh : 1000;
        bf16* ap = AT + (size_t)it * 4096 + (32 * itl + r) * 64 + 32 * jt + 4 * hh;
#pragma unroll
        for (int a4 = 0; a4 < 4; ++a4) { float e[4];
#pragma unroll
            for (int x = 0; x < 4; ++x) e[x] = (8 * a4 + x <= lim) ? a0[4 * a4 + x] + a1[4 * a4 + x] : 0.f;
            v2u o; o.x = pk2(e[0], e[1]); o.y = pk2(e[2], e[3]); *(v2u*)(ap + 8 * a4) = o; }
    }
}
template <int DK, int DV, bool ISGLA>
__device__ __forceinline__ void chunk_phase(Frame& F, bf16* base, int ld, int qoff, int koff, int voff, const bf16* AT, const float* Wdec) {
    constexpr int C = 64, NC = SEQ / C, NS = DV / 64, NDT = DK / 32, NDTW = NDT / 4, QP = DK + 8, VP = 72, AP = 72, NQ = (C * DK / 8) / 512;
    static_assert((2 * C * QP + C * VP + C * AP) * 2 + DK * 4 + 6 * 2048 * 4 <= SCR_BYTES, "chunk phase LDS");
    LAS bf16* QL = (LAS bf16*)F.lds; LAS bf16* KL = QL + C * QP; LAS bf16* VL = KL + C * QP; LAS bf16* AL = VL + C * VP; LAS float* WL = (LAS float*)(AL + C * AP); LAS float* RED = WL + DK;
    const int tid = F.tid, w = F.wave, et = w & 1, dq = w >> 1;
    for (int it = F.vcu; it < 32 * NS; it += F.G) {
        const int bh = it / NS, sl = it % NS, b = bh >> 2, h = bh & 3;
        bf16* rowbase = base + (size_t)b * SEQ * ld;
        const bf16* qp = rowbase + qoff + h * DK; const bf16* kp = rowbase + koff + h * DK; bf16* vp = rowbase + voff + h * DV + sl * 64;
        const bf16* atp = AT + (size_t)bh * NC * 4096; const float* wdp = Wdec + ((size_t)b * NC * 4 + h) * DK;
        const float wsc = exp2f(64.f * log2f(1.f - exp2f(-5.f - (float)h)));
        f32x16 S[NDTW];
#pragma unroll
        for (int d = 0; d < NDTW; ++d) S[d] = (f32x16){};
        v4u pq[NQ], pk[NQ], pv, pa; f32x4 pw = {0.f, 0.f, 0.f, 0.f};
#define CH_PREFETCH(c_) do { int tz = tid; asm volatile("" : "+v"(tz)); \
            _Pragma("unroll") for (int u = 0; u < NQ; ++u) { const int idx = tz + 512 * u, row = idx / (DK / 8), c8 = (idx % (DK / 8)) * 8; const size_t go = (size_t)(C * (c_) + row) * ld + c8; pq[u] = *(const v4u*)(qp + go); pk[u] = *(const v4u*)(kp + go); } \
            pv = *(const v4u*)(vp + (size_t)(C * (c_) + (tz >> 3)) * ld + (tz & 7) * 8); pa = *(const v4u*)(atp + (size_t)(c_) * 4096 + tz * 8); \
            if (ISGLA && tz < DK / 4) pw = *(const f32x4*)(wdp + (size_t)(c_) * 4 * DK + 4 * tz); } while (0)
        __syncthreads();
        CH_PREFETCH(0);
        for (int c = 0; c < NC; ++c) {
            {
                int tz = tid; asm volatile("" : "+v"(tz));
#pragma unroll
                for (int u = 0; u < NQ; ++u) { const int idx = tz + 512 * u, row = idx / (DK / 8), c8 = (idx % (DK / 8)) * 8; *(LAS v4u*)(QL + row * QP + c8) = pq[u]; *(LAS v4u*)(KL + row * QP + c8) = pk[u]; }
                *(LAS v4u*)(VL + (tz >> 3) * VP + (tz & 7) * 8) = pv; *(LAS v4u*)(AL + (tz >> 3) * AP + (tz & 7) * 8) = pa;
                if (ISGLA && tz < DK / 4) *(LAS f32x4*)(WL + 4 * tz) = pw;
            }
            if (c + 1 < NC) CH_PREFETCH(c + 1);
            __syncthreads();
            {
                int tz = tid; asm volatile("" : "+v"(tz)); const int r = tz & 31, hh = (tz >> 5) & 1;
                const int trow = 8 * hh + ((tz & 15) >> 2), tcol = 16 * ((tz >> 4) & 1) + 4 * (tz & 3);
                bf16x8 vf[4];
#pragma unroll
                for (int ks = 0; ks < 4; ++ks) { const LAS bf16* p = VL + (16 * ks + trow) * VP + 32 * et + tcol;
                    const s16x4 lo = __builtin_bit_cast(s16x4, __builtin_amdgcn_ds_read_tr16_b64_v4i16((LAS s16x4*)p)), hi = __builtin_bit_cast(s16x4, __builtin_amdgcn_ds_read_tr16_b64_v4i16((LAS s16x4*)(p + 4 * VP)));
                    vf[ks] = (bf16x8){lo[0], lo[1], lo[2], lo[3], hi[0], hi[1], hi[2], hi[3]}; }
                f32x16 O[2]; O[0] = (f32x16){}; O[1] = (f32x16){};
#pragma unroll
                for (int dl = 0; dl < NDTW; ++dl)
#pragma unroll
                    for (int s2 = 0; s2 < 2; ++s2) {
                        v4u sw; sw.x = pg8::cvt_pk_bf16(S[dl][8 * s2 + 0], S[dl][8 * s2 + 1]); sw.y = pg8::cvt_pk_bf16(S[dl][8 * s2 + 2], S[dl][8 * s2 + 3]);
                        sw.z = pg8::cvt_pk_bf16(S[dl][8 * s2 + 4], S[dl][8 * s2 + 5]); sw.w = pg8::cvt_pk_bf16(S[dl][8 * s2 + 6], S[dl][8 * s2 + 7]);
                        const bf16x8 sf = __builtin_bit_cast(bf16x8, sw);
#pragma unroll
                        for (int itl = 0; itl < 2; ++itl) { const LAS bf16* qq = QL + (32 * itl + r) * QP + 32 * (dq * NDTW + dl) + 16 * s2 + 4 * hh;
                            const v2u lo = *(const LAS v2u*)qq, hi = *(const LAS v2u*)(qq + 8);
                            O[itl] = MFMA32(sf, __builtin_bit_cast(bf16x8, (v4u){lo.x, lo.y, hi.x, hi.y}), O[itl]); }
                    }
                if (dq == 0) {
#pragma unroll
                    for (int itl = 0; itl < 2; ++itl)
#pragma unroll
                        for (int ks = 0; ks < 2 * itl + 2; ++ks) { const bf16x8 af = *(const LAS bf16x8*)(AL + (32 * itl + r) * AP + 16 * ks + 8 * hh); O[itl] = MFMA32(vf[ks], af, O[itl]); }
                } else {
                    LAS float* rp = RED + (et * 3 + dq - 1) * 2048 + (tz & 63);
#pragma unroll
                    for (int itl = 0; itl < 2; ++itl)
#pragma unroll
                        for (int q = 0; q < 16; ++q) rp[(itl * 16 + q) * 64] = O[itl][q];
                }
#pragma unroll
                for (int dl = 0; dl < NDTW; ++dl) {
#pragma unroll
                    for (int ks = 0; ks < 4; ++ks) { const LAS bf16* p = KL + (16 * ks + trow) * QP + 32 * (dq * NDTW + dl) + tcol;
                        const s16x4 lo = __builtin_bit_cast(s16x4, __builtin_amdgcn_ds_read_tr16_b64_v4i16((LAS s16x4*)p)), hi = __builtin_bit_cast(s16x4, __builtin_amdgcn_ds_read_tr16_b64_v4i16((LAS s16x4*)(p + 4 * QP)));
                        S[dl] = MFMA32(((bf16x8){lo[0], lo[1], lo[2], lo[3], hi[0], hi[1], hi[2], hi[3]}), vf[ks], S[dl]); }
                    if (ISGLA) {
#pragma unroll
                        for (int a4 = 0; a4 < 4; ++a4) { const f32x4 w4 = *(const LAS f32x4*)(WL + 32 * (dq * NDTW + dl) + 8 * a4 + 4 * hh);
#pragma unroll
                            for (int x = 0; x < 4; ++x) S[dl][4 * a4 + x] *= w4[x]; }
                    } else S[dl] *= wsc;
                }
                __syncthreads();
                if (dq == 0) {
                    const LAS float* rp = RED + (et * 3) * 2048 + (tz & 63);
#pragma unroll
                    for (int itl = 0; itl < 2; ++itl) {
#pragma unroll
                        for (int q = 0; q < 16; ++q) O[itl][q] += (rp[(itl * 16 + q) * 64] + rp[2048 + (itl * 16 + q) * 64]) + rp[4096 + (itl * 16 + q) * 64];
                        if (!F.dry) { bf16* op = vp + (size_t)(C * c + 32 * itl + r) * ld + 32 * et + 4 * hh;
#pragma unroll
                            for (int a4 = 0; a4 < 4; ++a4) { v2u o; o.x = pk2(O[itl][4 * a4], O[itl][4 * a4 + 1]); o.y = pk2(O[itl][4 * a4 + 2], O[itl][4 * a4 + 3]); *(v2u*)(op + 8 * a4) = o; } }
                    }
                }
            }
        }
    }
    __syncthreads();
#undef CH_PREFETCH
}
__device__ __forceinline__ void gla_prep_phase(Frame& F, bf16* base, int ld, float* Wdec) {
    const int tid = F.tid;
    for (int it = F.vcu; it < BATCH * 64; it += F.G) {
        bf16* p = base + (size_t)it * 64 * ld + tid;
        float bsum = 0.f;
#pragma unroll 8
        for (int t = 0; t < 64; ++t) {
            bf16* rp = p + (size_t)t * ld;
            bsum += bf1(rp[3072]);
            const float eb = __expf(bsum);
            const float q = bf1(rp[0]) * eb, k = bf1(rp[512]) / eb;
            if (!F.dry) { rp[0] = (bf16)f2bf(q); rp[512] = (bf16)f2bf(k); }
        }
        Wdec[(size_t)it * 512 + tid] = __expf(bsum);
    }
}

template <int DV, bool CENTER>
__device__ __forceinline__ void hn_phase(Frame& F, bf16* base, int ld, int ooff, int goff, const float* gn) {
    constexpr int NJ = DV / 128;
    const int gw = F.vcu * NWAVES + F.wave, NGW = F.G * NWAVES, lane = F.lane, hq = lane >> 4, li = lane & 15;
    for (int m = gw; m < M; m += NGW) {
        bf16* op = base + (size_t)m * ld + ooff + hq * DV + li * 8; const bf16* gp = base + (size_t)m * ld + goff + hq * DV + li * 8;
        float o[NJ][8]; v4u gw4[NJ]; float s = 0.f;
#pragma unroll
        for (int j = 0; j < NJ; ++j) { const v4u w = *(const v4u*)(op + 128 * j); gw4[j] = *(const v4u*)(gp + 128 * j);
            o[j][0] = bflo(w.x); o[j][1] = bfhi(w.x); o[j][2] = bflo(w.y); o[j][3] = bfhi(w.y); o[j][4] = bflo(w.z); o[j][5] = bfhi(w.z); o[j][6] = bflo(w.w); o[j][7] = bfhi(w.w);
#pragma unroll
            for (int e = 0; e < 8; ++e) s += o[j][e]; }
        float mean = 0.f;
        if (CENTER) mean = grp16_sum(s) * (1.f / DV);
        float s2 = 0.f;
#pragma unroll
        for (int j = 0; j < NJ; ++j)
#pragma unroll
            for (int e = 0; e < 8; ++e) { o[j][e] -= mean; s2 += o[j][e] * o[j][e]; }
        const float rstd = rsqrtf(grp16_sum(s2) * (1.f / DV) + NORM_EPS);
#pragma unroll
        for (int j = 0; j < NJ; ++j) {
            const float* gnp = gn + hq * DV + li * 8 + 128 * j; const f32x4 g0 = *(const f32x4*)gnp, g1 = *(const f32x4*)(gnp + 4);
            const float gg[8] = {bflo(gw4[j].x), bfhi(gw4[j].x), bflo(gw4[j].y), bfhi(gw4[j].y), bflo(gw4[j].z), bfhi(gw4[j].z), bflo(gw4[j].w), bfhi(gw4[j].w)};
            float r[8];
#pragma unroll
            for (int e = 0; e < 8; ++e) r[e] = o[j][e] * rstd * (e < 4 ? g0[e & 3] : g1[e & 3]) * silu(gg[e]);
            v4u w; w.x = pk2(r[0], r[1]); w.y = pk2(r[2], r[3]); w.z = pk2(r[4], r[5]); w.w = pk2(r[6], r[7]);
            if (!F.dry) *(v4u*)(op + 128 * j) = w;
        }
    }
}

__device__ __forceinline__ void lru_conv_phase(Frame& F, const bf16* XY, bf16* XC, const float* cw, const float* cb) {
    const int gw = F.vcu * NWAVES + F.wave, NGW = F.G * NWAVES, lane = F.lane;
    for (int m = gw; m < M; m += NGW) {
        const int t = m & (SEQ - 1);
#pragma unroll
        for (int j = 0; j < 2; ++j) {
            const int ch = lane * 8 + 512 * j;
            float acc[8];
            { const f32x4 b0 = *(const f32x4*)(cb + ch), b1 = *(const f32x4*)(cb + ch + 4);
              acc[0] = b0.x; acc[1] = b0.y; acc[2] = b0.z; acc[3] = b0.w; acc[4] = b1.x; acc[5] = b1.y; acc[6] = b1.z; acc[7] = b1.w; }
#pragma unroll
            for (int tap = 0; tap < 4; ++tap) {
                if (t - 3 + tap >= 0) {
                    const v4u w = *(const v4u*)(XY + (size_t)(m - 3 + tap) * 2048 + ch);
                    const f32x4 c0 = *(const f32x4*)(cw + tap * 1024 + ch), c1 = *(const f32x4*)(cw + tap * 1024 + ch + 4);
                    acc[0] += bflo(w.x) * c0.x; acc[1] += bfhi(w.x) * c0.y; acc[2] += bflo(w.y) * c0.z; acc[3] += bfhi(w.y) * c0.w;
                    acc[4] += bflo(w.z) * c1.x; acc[5] += bfhi(w.z) * c1.y; acc[6] += bflo(w.w) * c1.z; acc[7] += bfhi(w.w) * c1.w;
                }
            }
            v4u o; o.x = pk2(acc[0], acc[1]); o.y = pk2(acc[2], acc[3]); o.z = pk2(acc[4], acc[5]); o.w = pk2(acc[6], acc[7]);
            *(v4u*)(XC + (size_t)m * 1024 + ch) = o;
        }
    }
}
template <int PASS>
__device__ __forceinline__ void lru_scan_phase(Frame& F, const bf16* GP, const bf16* XC, const bf16* XY, float* SP, float* SE, bf16* HS, const float* b_a, const float* b_x, const float* lam) {
    const int tid = F.tid, ch = 2 * tid, gcol = (ch >> 7) * 256 + (ch & 127);
    const float ba0 = b_a[ch], ba1 = b_a[ch + 1], bx0 = b_x[ch], bx1 = b_x[ch + 1];
    const float lm0 = lam[ch], lm1 = lam[ch + 1];
    const float sp0 = -8.f * (fmaxf(-lm0, 0.f) + log1pf(__expf(-fabsf(lm0)))), sp1 = -8.f * (fmaxf(-lm1, 0.f) + log1pf(__expf(-fabsf(lm1))));
    for (int it = F.vcu; it < BATCH * 64; it += F.G) {
        const int b = it >> 6, ci = it & 63; const size_t m0 = (size_t)b * SEQ + ci * 64;
        float h0 = 0.f, h1 = 0.f, s0 = 0.f, s1 = 0.f;
        if (PASS == 1) {
            for (int j = 0; j < ci; ++j) { const f32x2 p = *(const f32x2*)(SP + (size_t)(b * 64 + j) * 1024 + ch), e = *(const f32x2*)(SE + (size_t)(b * 64 + j) * 1024 + ch);
                h0 = p.x * h0 + e.x; h1 = p.y * h1 + e.y; }
        }
#pragma unroll 8
        for (int t = 0; t < 64; ++t) {
            const unsigned pa = *(const unsigned*)(GP + (m0 + t) * 2048 + gcol), px = *(const unsigned*)(GP + (m0 + t) * 2048 + gcol + 128), xc = *(const unsigned*)(XC + (m0 + t) * 1024 + ch);
            const float l0 = sp0 / (1.f + __expf(-(bflo(pa) + ba0))), l1 = sp1 / (1.f + __expf(-(bfhi(pa) + ba1)));
            const float a0 = __expf(l0), a1 = __expf(l1);
            const float u0 = sqrtf(fmaxf(1.f - a0 * a0, 0.f)) * bflo(xc) / (1.f + __expf(-(bflo(px) + bx0))), u1 = sqrtf(fmaxf(1.f - a1 * a1, 0.f)) * bfhi(xc) / (1.f + __expf(-(bfhi(px) + bx1)));
            h0 = a0 * h0 + u0; h1 = a1 * h1 + u1;
            if (PASS == 0) { s0 += l0; s1 += l1; }
            else { const unsigned y = *(const unsigned*)(XY + (m0 + t) * 2048 + 1024 + ch);
                *(unsigned*)(HS + (m0 + t) * 1024 + ch) = pk2(h0 * gelu_tanh(bflo(y)), h1 * gelu_tanh(bfhi(y))); }
        }
        if (PASS == 0) { *(f32x2*)(SP + (size_t)it * 1024 + ch) = (f32x2){__expf(s0), __expf(s1)}; *(f32x2*)(SE + (size_t)it * 1024 + ch) = (f32x2){h0, h1}; }
    }
}

__device__ __forceinline__ void nsa_compress_phase(Frame& F, const bf16* KC, const bf16* VC, const bf16* W1K, const bf16* W1V, const bf16* W2K, const bf16* W2V, const float* PEB, bf16* KCMP, bf16* VCMPT) {
    LAS float* part = (LAS float*)F.lds;
    LAS bf16* hid = (LAS bf16*)(F.lds + 32768);
    const int tid = F.tid, lane = F.lane, w = F.wave, r = lane & 31, hh = lane >> 5;
    for (int it = F.vcu; it < 256; it += F.G) {
        const int kv = it >> 7, bg = (it >> 3) & 15, ntile = it & 7;
        const bf16* A = (kv ? VC : KC) + (size_t)bg * SEQ * 64 + (size_t)(32 * ntile) * 1024;
        const bf16* W1 = kv ? W1V : W1K; const bf16* W2 = kv ? W2V : W2K; const float* bias = PEB + kv * 128;
        const int ct = w & 3, kh = w >> 2;
        f32x16 acc = {};
        const bf16* ap = A + (size_t)r * 1024 + 1024 * kh + 8 * hh; const bf16* bp = W1 + (size_t)(32 * ct + r) * 2048 + 1024 * kh + 8 * hh;
#pragma unroll 8
        for (int s = 0; s < 64; ++s) { const bf16x8 a = *(const bf16x8*)(ap + 16 * s), bb = *(const bf16x8*)(bp + 16 * s); acc = MFMA32(a, bb, acc); }
        __syncthreads();
#pragma unroll
        for (int q = 0; q < 16; ++q) { const int row = (q & 3) + 8 * (q >> 2) + 4 * hh; part[kh * 4096 + row * 128 + 32 * ct + r] = acc[q]; }
        __syncthreads();
        { const int row = tid >> 4, col = (tid & 15) * 8; unsigned pk[4];
#pragma unroll
          for (int e = 0; e < 8; e += 2) { const float a0 = part[row * 128 + col + e] + part[4096 + row * 128 + col + e] + bias[col + e];
              const float a1 = part[row * 128 + col + e + 1] + part[4096 + row * 128 + col + e + 1] + bias[col + e + 1];
              pk[e >> 1] = pk2(gelu_tanh(a0), gelu_tanh(a1)); }
          *(LAS v4u*)(hid + row * 136 + col) = (v4u){pk[0], pk[1], pk[2], pk[3]}; }
        __syncthreads();
        if (w < 2) {
            f32x16 a2 = {};
#pragma unroll
            for (int s = 0; s < 8; ++s) { const bf16x8 a = *(const LAS bf16x8*)(hid + r * 136 + 16 * s + 8 * hh), bb = *(const bf16x8*)(W2 + (size_t)(32 * w + r) * 128 + 16 * s + 8 * hh); a2 = MFMA32(a, bb, a2); }
            const int d = 32 * w + r;
            if (kv == 0) {
#pragma unroll
                for (int q = 0; q < 16; ++q) { const int n = 32 * ntile + (q & 3) + 8 * (q >> 2) + 4 * hh; KCMP[((size_t)bg * 256 + n) * 64 + d] = (bf16)(n == 255 ? 0u : f2bf(a2[q])); }
            } else {
#pragma unroll
                for (int q4 = 0; q4 < 4; ++q4) { const int n = 32 * ntile + 8 * q4 + 4 * hh; float v[4];
#pragma unroll
                    for (int e = 0; e < 4; ++e) v[e] = (n + e == 255) ? 0.f : a2[4 * q4 + e];
                    v2u o; o.x = pk2(v[0], v[1]); o.y = pk2(v[2], v[3]); *(v2u*)(VCMPT + ((size_t)bg * 64 + d) * 256 + n) = o; }
            }
        }
    }
    __syncthreads();
}

constexpr int KP = 72;
__device__ __forceinline__ void qk_tile(const LAS bf16* KT, const bf16x8 (&Qf)[4], f32x16& S0, f32x16& S1, int r, int hh) {
    S0 = (f32x16){}; S1 = (f32x16){};
#pragma unroll
    for (int s = 0; s < 4; ++s) {
        const bf16x8 a0 = *(const LAS bf16x8*)(KT + r * KP + 16 * s + 8 * hh), a1 = *(const LAS bf16x8*)(KT + (32 + r) * KP + 16 * s + 8 * hh);
        S0 = MFMA32(a0, Qf[s], S0); S1 = MFMA32(a1, Qf[s], S1);
    }
}
__device__ __forceinline__ void attn_tile(const LAS bf16* KT, const LAS bf16* VT, const bf16x8 (&Qf)[4], f32x16 (&O)[2], float& mrun, float& lrun,
                                          float biasl, float bstep, int limhi, int limlo, int r, int hh) {
    f32x16 S0, S1; qk_tile(KT, Qf, S0, S1, r, hh);
    float mx = -INFINITY;
#pragma unroll
    for (int q = 0; q < 16; ++q) { const int c = (q & 3) + 8 * (q >> 2);
        S0[q] = (c <= limhi && c > limlo) ? S0[q] + __builtin_fmaf(bstep, (float)c, biasl) : -INFINITY;
        S1[q] = (c + 32 <= limhi && c + 32 > limlo) ? S1[q] + __builtin_fmaf(bstep, (float)(c + 32), biasl) : -INFINITY;
        mx = fmaxf(mx, fmaxf(S0[q], S1[q])); }
    mx = fmaxf(mx, __shfl_xor(mx, 32));
    const float mnew = fmaxf(mrun, mx), alpha = __builtin_amdgcn_exp2f(mrun - mnew);
    float rs = 0.f;
#pragma unroll
    for (int q = 0; q < 16; ++q) { S0[q] = __builtin_amdgcn_exp2f(S0[q] - mnew); S1[q] = __builtin_amdgcn_exp2f(S1[q] - mnew); rs += S0[q] + S1[q]; }
    rs += __shfl_xor(rs, 32);
    lrun = lrun * alpha + rs; mrun = mnew;
#pragma unroll
    for (int dt = 0; dt < 2; ++dt)
#pragma unroll
        for (int q = 0; q < 16; ++q) O[dt][q] *= alpha;
    bf16x8 Pf[2][2];
#pragma unroll
    for (int s = 0; s < 2; ++s) {
        v4u w0, w1;
        w0.x = pg8::cvt_pk_bf16(S0[8 * s + 0], S0[8 * s + 1]); w0.y = pg8::cvt_pk_bf16(S0[8 * s + 2], S0[8 * s + 3]); w0.z = pg8::cvt_pk_bf16(S0[8 * s + 4], S0[8 * s + 5]); w0.w = pg8::cvt_pk_bf16(S0[8 * s + 6], S0[8 * s + 7]);
        w1.x = pg8::cvt_pk_bf16(S1[8 * s + 0], S1[8 * s + 1]); w1.y = pg8::cvt_pk_bf16(S1[8 * s + 2], S1[8 * s + 3]); w1.z = pg8::cvt_pk_bf16(S1[8 * s + 4], S1[8 * s + 5]); w1.w = pg8::cvt_pk_bf16(S1[8 * s + 6], S1[8 * s + 7]);
        Pf[0][s] = __builtin_bit_cast(bf16x8, w0); Pf[1][s] = __builtin_bit_cast(bf16x8, w1);
    }
#pragma unroll
    for (int dt = 0; dt < 2; ++dt)
#pragma unroll
        for (int kt = 0; kt < 2; ++kt)
#pragma unroll
            for (int s = 0; s < 2; ++s) {
                const LAS bf16* vp = VT + (32 * dt + r) * KP + 32 * kt + 16 * s + 4 * hh;
                const v2u lo = *(const LAS v2u*)vp, hi = *(const LAS v2u*)(vp + 8);
                const bf16x8 a = __builtin_bit_cast(bf16x8, (v4u){lo.x, lo.y, hi.x, hi.y});
                O[dt] = MFMA32(a, Pf[kt][s], O[dt]);
            }
}
__device__ __forceinline__ void imp_tile(const LAS bf16* KT, const bf16x8 (&Qf)[4], float mfin, float linv, float biasl, float bstep, int limhi, int n0t, LAS unsigned* IMP, int r, int hh) {
    f32x16 S0, S1; qk_tile(KT, Qf, S0, S1, r, hh);
#pragma unroll
    for (int q = 0; q < 16; ++q) { const int c = (q & 3) + 8 * (q >> 2);
        S0[q] = (c <= limhi) ? __builtin_amdgcn_exp2f(S0[q] + __builtin_fmaf(bstep, (float)c, biasl) - mfin) * linv : 0.f;
        S1[q] = (c + 32 <= limhi) ? __builtin_amdgcn_exp2f(S1[q] + __builtin_fmaf(bstep, (float)(c + 32), biasl) - mfin) * linv : 0.f; }
    LAS unsigned* row = IMP + r * 65;
#pragma unroll
    for (int kt = 0; kt < 2; ++kt)
#pragma unroll
        for (int a = 0; a < 4; ++a) {
            const float e0 = kt ? S1[4 * a] : S0[4 * a], e1 = kt ? S1[4 * a + 1] : S0[4 * a + 1], e2 = kt ? S1[4 * a + 2] : S0[4 * a + 2], e3 = kt ? S1[4 * a + 3] : S0[4 * a + 3];
            const int j = (n0t + 32 * kt + 8 * a + 4 * hh) >> 2;
            const unsigned gq = (unsigned)((e0 + e1 + e2 + e3) * 8388608.f + 0.5f), lq = (unsigned)(e3 * 8388608.f + 0.5f);
            if (gq) __hip_atomic_fetch_add((unsigned*)(row + j), gq, __ATOMIC_RELAXED, __HIP_MEMORY_SCOPE_WORKGROUP);
            if (lq && j + 1 < 64) __hip_atomic_fetch_add((unsigned*)(row + j + 1), lq, __ATOMIC_RELAXED, __HIP_MEMORY_SCOPE_WORKGROUP);
        }
}
__device__ __forceinline__ void load_kv_tile(LAS bf16* KT, LAS bf16* VT, const bf16* ksrc  , const bf16* vsrc  , int vstride, int tid, bool with_v) {
    const int row = tid >> 3, ch = (tid & 7) * 8;
    const v4u k = *(const v4u*)(ksrc + row * 64 + ch);
    v4u v = {0, 0, 0, 0}; if (with_v) v = *(const v4u*)(vsrc + (size_t)row * vstride + ch);
    *(LAS v4u*)(KT + row * KP + ch) = k;
    if (with_v) *(LAS v4u*)(VT + row * KP + ch) = v;
}
#define TZ_LANE int tz = tid; asm volatile("" : "+v"(tz)); const int r = tz & 31, hh = (tz >> 5) & 1;
__device__ __forceinline__ void nsa_attn_phase(Frame& F, const bf16* Q, const bf16* KCMP, const bf16* VCMPT, const bf16* KS, const bf16* VST, const bf16* KW, const bf16* VWT, const float* GATES, bf16* OB) {
    LAS bf16* KT = (LAS bf16*)F.lds; LAS bf16* VT = KT + 64 * KP;
    LAS unsigned* IMP = (LAS unsigned*)(F.lds + 2 * 64 * KP * 2);
    LAS unsigned char* SELB = (LAS unsigned char*)(IMP + 32 * 65);
    const int tid = F.tid, w = F.wave;
    for (int it = F.vcu; it < 2048; it += F.G) {
        const int k8 = it >> 8, v = it & 255, slot = k8 >> 1, half = k8 & 1, bg = v >> 4, rr = v & 15;
        const int i = slot == 0 ? rr : (slot == 1 ? 31 - rr : (slot == 2 ? 32 + rr : 63 - rr));
        const int b = bg >> 1, g = bg & 1, h = g * 8 + w, t0 = 64 * i, q0 = 32 * half;
        const float slope2 = exp2f(-0.5f * (float)(h + 1)) * LOG2E;
        bf16x8 Qf[4]; float gate[3];
        { TZ_LANE
          const size_t row = (size_t)b * SEQ + t0 + q0 + r;
#pragma unroll
          for (int s = 0; s < 4; ++s) Qf[s] = *(const bf16x8*)(Q + row * 1024 + h * 64 + 16 * s + 8 * hh);
#pragma unroll
          for (int br = 0; br < 3; ++br) gate[br] = GATES[row * 48 + br * 16 + h]; }
        f32x16 O[2]; O[0] = (f32x16){}; O[1] = (f32x16){};
        unsigned OUTP[2][8];
#define OUT_ACC(sc_, first_) do { _Pragma("unroll") for (int dt_ = 0; dt_ < 2; ++dt_) { _Pragma("unroll") for (int e_ = 0; e_ < 8; ++e_) { const unsigned w_ = (first_) ? 0u : OUTP[dt_][e_]; \
            OUTP[dt_][e_] = pk2(bflo(w_) + O[dt_][2 * e_] * (sc_), bfhi(w_) + O[dt_][2 * e_ + 1] * (sc_)); } O[dt_] = (f32x16){}; } } while (0)
        float mrun = -1e30f, lrun = 0.f;
        __syncthreads();
        for (int idx = tid; idx < 32 * 65; idx += 512) IMP[idx] = 0u;
        const int ncmp = (4 * i + 3) < 255 ? (4 * i + 3) : 255, ntile = (ncmp + 63) >> 6;
        const bf16* kcb = KCMP + (size_t)bg * 256 * 64; const bf16* vcb = VCMPT + (size_t)bg * 64 * 256;
        for (int tl = 0; tl < ntile; ++tl) {
            TZ_LANE
            __syncthreads();
            load_kv_tile(KT, VT, kcb + (size_t)tl * 64 * 64, vcb + tl * 64, 256, tz, true);
            __syncthreads();
            const int n0t = 64 * tl, a1 = ((t0 + q0 + r - 31) >> 4) - n0t - 4 * hh, a2 = 254 - n0t - 4 * hh;
            attn_tile(KT, VT, Qf, O, mrun, lrun, slope2 * (float)(16 * n0t + 31 - t0) + slope2 * 64.f * (float)hh, slope2 * 16.f, a1 < a2 ? a1 : a2, -1000, r, hh);
        }
        const float mfin = mrun, linv = 1.f / fmaxf(lrun, 1e-30f);
        OUT_ACC(linv * gate[0], true);
        mrun = -1e30f; lrun = 0.f;
        for (int tl = 0; tl < ntile; ++tl) {
            TZ_LANE
            __syncthreads();
            load_kv_tile(KT, VT, kcb + (size_t)tl * 64 * 64, vcb, 256, tz, false);
            __syncthreads();
            const int n0t = 64 * tl, a1 = ((t0 + q0 + r - 31) >> 4) - n0t - 4 * hh, a2 = 254 - n0t - 4 * hh;
            imp_tile(KT, Qf, mfin, linv, slope2 * (float)(16 * n0t + 31 - t0) + slope2 * 64.f * (float)hh, slope2 * 16.f, a1 < a2 ? a1 : a2, n0t, IMP, r, hh);
        }
        __syncthreads();
        {
            const int q = (tid >> 3) & 31, oct = tid & 7;
            unsigned mykey[8];
#pragma unroll
            for (int jj = 0; jj < 8; ++jj) { const int j = oct * 8 + jj; unsigned vv = IMP[q * 65 + j]; vv = vv > 0x3fffffeu ? 0x3fffffeu : vv;
                const bool forced = (j == 0) || (j == i) || (j == i - 1);
                mykey[jj] = (j <= i) ? (((forced ? 0x3ffffffu : vv) << 6) | (unsigned)(63 - j)) : 0u; }
            __syncthreads();
            if (tid < 256) {
#pragma unroll
                for (int jj = 0; jj < 8; ++jj) IMP[q * 65 + oct * 8 + jj] = mykey[jj]; }
            __syncthreads();
            unsigned rank[8] = {0, 0, 0, 0, 0, 0, 0, 0};
            for (int j2 = 0; j2 < 64; ++j2) { const unsigned kk = IMP[q * 65 + j2];
#pragma unroll
                for (int jj = 0; jj < 8; ++jj) rank[jj] += (kk > mykey[jj]) ? 1u : 0u; }
            unsigned byte = 0;
#pragma unroll
            for (int jj = 0; jj < 8; ++jj) byte |= ((oct * 8 + jj <= i) && rank[jj] < 16u) ? (1u << jj) : 0u;
            if (tid < 256) SELB[q * 8 + oct] = (unsigned char)byte;
        }
        __syncthreads();
        unsigned long long selm, uni;
        { TZ_LANE
          selm = *(const LAS unsigned long long*)(SELB + 8 * r);
          unsigned ulo = (unsigned)selm, uhi = (unsigned)(selm >> 32);
#pragma unroll
          for (int o = 1; o < 32; o <<= 1) { ulo |= __shfl_xor(ulo, o); uhi |= __shfl_xor(uhi, o); }
          uni = ((unsigned long long)(unsigned)__builtin_amdgcn_readfirstlane(uhi) << 32) | (unsigned)__builtin_amdgcn_readfirstlane(ulo); }
        const bf16* ksb = KS + (size_t)bg * SEQ * 64; const bf16* vsb = VST + (size_t)bg * 64 * SEQ;
        for (int j = 0; j <= i; ++j) {
            if (!((uni >> j) & 1ull)) continue;
            TZ_LANE
            __syncthreads();
            load_kv_tile(KT, VT, ksb + (size_t)j * 64 * 64, vsb + j * 64, SEQ, tz, true);
            __syncthreads();
            const int lh = ((selm >> j) & 1ull) ? (j == i ? q0 + r - 4 * hh : 1000) : -1000;
            attn_tile(KT, VT, Qf, O, mrun, lrun, slope2 * (float)(64 * j - t0) + slope2 * 4.f * (float)hh, slope2, lh, -1000, r, hh);
        }
        OUT_ACC(gate[1] / fmaxf(lrun, 1e-30f), false);
        mrun = -1e30f; lrun = 0.f;
        const bf16* kwb = KW + (size_t)bg * SEQ * 64; const bf16* vwb = VWT + (size_t)bg * 64 * SEQ;
        for (int j = (i > 8 ? i - 8 : 0); j <= i; ++j) {
            TZ_LANE
            __syncthreads();
            load_kv_tile(KT, VT, kwb + (size_t)j * 64 * 64, vwb + j * 64, SEQ, tz, true);
            __syncthreads();
            const int lh = (j == i) ? q0 + r - 4 * hh : 1000, ll = (j == i - 8) ? q0 + r - 4 * hh : -1000;
            attn_tile(KT, VT, Qf, O, mrun, lrun, slope2 * (float)(64 * j - t0) + slope2 * 4.f * (float)hh, slope2, lh, ll, r, hh);
        }
        OUT_ACC(gate[2] / fmaxf(lrun, 1e-30f), false);
        { TZ_LANE
          bf16* op = OB + ((size_t)b * SEQ + t0 + q0 + r) * 1024 + h * 64;
#pragma unroll
          for (int dt = 0; dt < 2; ++dt)
#pragma unroll
              for (int q4 = 0; q4 < 4; ++q4) { v2u o; o.x = OUTP[dt][2 * q4]; o.y = OUTP[dt][2 * q4 + 1]; *(v2u*)(op + 32 * dt + 8 * q4 + 4 * hh) = o; } }
    }
    __syncthreads();
#undef OUT_ACC
}

struct Args { const float* in[32]; float* out; unsigned char* ws; int ph_lo, ph_hi, dry, pad; };
constexpr int N_PHASES = 38;

__global__ void __launch_bounds__(NWAVES * 64, 2) trunk_fwd(Args args) {
    extern __shared__ __attribute__((aligned(16))) unsigned char lds[];
    Frame F;
    F.lds = (LAS unsigned char*)lds;
    F.tid = threadIdx.x; F.lane = F.tid & 63; F.wave = __builtin_amdgcn_readfirstlane(F.tid >> 6);
    F.G = gridDim.x; { const int bx = blockIdx.x; F.vcu = (F.G % 8 == 0) ? (bx % 8) * (F.G / 8) + bx / 8 : bx; }
    F.ws = args.ws; F.dry = args.dry;
    unsigned char* ws = args.ws;
    volatile LAS unsigned* MISC = (volatile LAS unsigned*)(F.lds + LDSCTL_OFF);
    for (int u = F.tid; u < (LDS_BYTES - LDSCTL_OFF) / 4; u += NWAVES * 64) ((LAS unsigned*)(F.lds + LDSCTL_OFF))[u] = 0u;
    __syncthreads();
    XcdBarrier bar = xcd_barrier_post((unsigned*)(ws + WS_CTL) + CW_BAR, MISC + 8);

    const int lo = args.ph_lo, hi = args.ph_hi;
#ifndef PHMASK
#define PHMASK 0xFFFFFFFFFFFFFFFFull
#endif
#define INR(k) ((((PHMASK) >> (k)) & 1ull) && lo <= (k) && (k) < hi)
#define IN(k) (INR(k) && frame_refresh(F))
#define SEAM(k) do { if (INR(k) && INR((k) + 1)) xcd_barrier(bar); } while (0)
    const float* const* in = args.in;
    float* xout = args.out;
    bf16* Hb = (bf16*)(ws + WS_H); bf16* BIG = (bf16*)(ws + WS_BIG);
    bf16* Wi = (bf16*)(ws + WS_WIN); bf16* Wo = (bf16*)(ws + WS_WOUT); bf16* Wu = (bf16*)(ws + WS_WUP); bf16* Wd = (bf16*)(ws + WS_WDN);
    LAS unsigned char* ring = F.lds + RING_OFF;

#define CONV_MLP(L, base) do { conv_w(F, base, in[5] + (size_t)(L) * D * FF, D, FF, 0, FF, FF, Wu, D, 0, 1.f); conv_w(F, base, in[6] + (size_t)(L) * FF * D, FF, D, 0, D, D, Wd, FF, 0, 1.f); } while (0)
#define GEMM_PHASE(EPI, Aptr, LDA, Bptr, LDB, NN, KK, APN, E) do { pg8::Gemm g{(const pg8::bf16_t*)(Aptr), (const pg8::bf16_t*)(Bptr), M, (NN), (KK), (LDA), (LDB), (size_t)(APN)}; \
        pg8::StaticOrder S; S.init(M, (NN), F.G, (int)blockIdx.x); pg8::gemm_phase<EPI, pg8::StaticOrder, true, true>(ring, g, S, E); } while (0)
#define MLP_PHASES(P0, L) \
    if (IN(P0)) { pg8::EpiStore<1> E{BIG, FF}; GEMM_PHASE(pg8::EpiStore<1>, Hb, D, Wu, D, FF, D, 0, E); } SEAM(P0); \
    if (IN((P0) + 1)) { pg8::EpiStore<0> E{Hb, D}; GEMM_PHASE(pg8::EpiStore<0>, BIG, FF, Wd, FF, D, FF, 0, E); } SEAM((P0) + 1);

    if (IN(0)) {
        int base = 0;
        conv_w(F, base, in[7], D, 6144, 0, 6144, 6144, Wi, D, 0, 1.f);
        conv_w(F, base, in[9], 2048, D, 0, D, D, Wo, 2048, 0, 1.f);
        CONV_MLP(0, base);
        norm_phase(F, in[0], nullptr, nullptr, Hb, nullptr, in[1]);
    }
    SEAM(0);
    if (IN(1)) { pg8::EpiRet E{BIG, 6144}; GEMM_PHASE(pg8::EpiRet, Hb, D, Wi, D, 6144, D, 0, E); }
    SEAM(1);
    if (IN(2)) chunk_a_phase<256>(F, BIG, 6144, 0, 1024, (bf16*)(ws + SM_AT));
    SEAM(2);
    if (IN(3)) chunk_phase<256, 512, false>(F, BIG, 6144, 0, 1024, 2048, (const bf16*)(ws + SM_AT), nullptr);
    SEAM(3);
    if (IN(4)) hn_phase<512, true>(F, BIG, 6144, 2048, 4096, in[8]);
    SEAM(4);
    if (IN(5)) { pg8::EpiStore<0> E{Hb, D}; GEMM_PHASE(pg8::EpiStore<0>, BIG + 2048, 6144, Wo, 2048, D, 2048, 0, E); }
    SEAM(5);
    if (IN(6)) norm_phase(F, in[0], Hb, xout, Hb, in[2], in[3]);
    SEAM(6);
    MLP_PHASES(7, 0)
    if (IN(9)) {
        norm_phase(F, xout, Hb, xout, Hb, in[4], in[1] + D);
        int base = 0;
        conv_w(F, base, in[10], D, 3088, 0, 512, 3088, Wi, D, 0, 0.08838834764831845f);
        conv_w(F, base, in[10], D, 3088, 512, 2560, 3088, Wi, D, 512, 1.f);
        {
            const int gw = F.vcu * NWAVES + F.wave, NGW = F.G * NWAVES;
            for (int itx = gw; itx < 16 * 16; itx += NGW) {
                const int kb = itx >> 4, cb = itx & 15, k = kb * 64 + F.lane;
                float wv[16];
#pragma unroll
                for (int r = 0; r < 16; ++r) wv[r] = in[10][(size_t)k * 3088 + 3072 + r];
                for (int c = cb * 32; c < cb * 32 + 32; ++c) { float s = 0.f;
#pragma unroll
                    for (int r = 0; r < 16; ++r) s += wv[r] * in[11][r * 512 + c];
                    Wi[(size_t)(3072 + c) * D + k] = (bf16)f2bf(s); }
            }
        }
        conv_w(F, base, in[14], D, D, 0, D, D, Wo, D, 0, 1.f);
        CONV_MLP(1, base);
    }
    SEAM(9);
    if (IN(10)) { pg8::EpiGla E{BIG, 3584, in[12]}; GEMM_PHASE(pg8::EpiGla, Hb, D, Wi, D, 3584, D, 0, E); }
    SEAM(10);
    if (IN(11)) gla_prep_phase(F, BIG, 3584, (float*)(ws + SM_GLAW));
    SEAM(11);
    if (IN(12)) chunk_a_phase<128>(F, BIG, 3584, 0, 512, (bf16*)(ws + SM_AT));
    SEAM(12);
    if (IN(13)) chunk_phase<128, 256, true>(F, BIG, 3584, 0, 512, 1024, (const bf16*)(ws + SM_AT), (const float*)(ws + SM_GLAW));
    SEAM(13);
    if (IN(14)) hn_phase<256, false>(F, BIG, 3584, 1024, 2048, in[13]);
    SEAM(14);
    if (IN(15)) { pg8::EpiStore<0> E{Hb, D}; GEMM_PHASE(pg8::EpiStore<0>, BIG + 1024, 3584, Wo, D, D, D, 0, E); }
    SEAM(15);
    if (IN(16)) norm_phase(F, xout, Hb, xout, Hb, in[2] + D, in[3] + D);
    SEAM(16);
    MLP_PHASES(17, 1)
    if (IN(19)) {
        norm_phase(F, xout, Hb, xout, Hb, in[4] + D, in[1] + 2 * D);
        int base = 0;
        conv_w(F, base, in[15], D, 2048, 0, 2048, 2048, Wi, D, 0, 1.f);
        conv_w(F, base, in[23], D, D, 0, D, D, Wo, D, 0, 1.f);
        bf16* LW = (bf16*)(ws + SM_LRUW);
        for (int n = 0; n < 8; ++n) { conv_w(F, base, in[18] + n * 16384, 128, 128, 0, 128, 128, LW + n * 32768, 128, 0, 1.f); conv_w(F, base, in[20] + n * 16384, 128, 128, 0, 128, 128, LW + n * 32768, 128, 128, 1.f); }
        CONV_MLP(2, base);
    }
    SEAM(19);
    if (IN(20)) { pg8::EpiStore<0> E{(bf16*)(ws + LRU_XY), 2048}; GEMM_PHASE(pg8::EpiStore<0>, Hb, D, Wi, D, 2048, D, 0, E); }
    SEAM(20);
    if (IN(21)) lru_conv_phase(F, (const bf16*)(ws + LRU_XY), (bf16*)(ws + LRU_XC), in[16], in[17]);
    SEAM(21);
    if (IN(22)) { pg8::EpiStore<0> E{(bf16*)(ws + LRU_GP), 2048}; GEMM_PHASE(pg8::EpiStore<0>, ws + LRU_XC, D, ws + SM_LRUW, 128, 2048, 128, 256, E); }
    SEAM(22);
    if (IN(23)) lru_scan_phase<0>(F, (const bf16*)(ws + LRU_GP), (const bf16*)(ws + LRU_XC), (const bf16*)(ws + LRU_XY), (float*)(ws + SM_SCANP), (float*)(ws + SM_SCANE), (bf16*)(ws + LRU_HS), in[19], in[21], in[22]);
    SEAM(23);
    if (IN(24)) lru_scan_phase<1>(F, (const bf16*)(ws + LRU_GP), (const bf16*)(ws + LRU_XC), (const bf16*)(ws + LRU_XY), (float*)(ws + SM_SCANP), (float*)(ws + SM_SCANE), (bf16*)(ws + LRU_HS), in[19], in[21], in[22]);
    SEAM(24);
    if (IN(25)) { pg8::EpiStore<0> E{Hb, D}; GEMM_PHASE(pg8::EpiStore<0>, ws + LRU_HS, D, Wo, D, D, D, 0, E); }
    SEAM(25);
    if (IN(26)) norm_phase(F, xout, Hb, xout, Hb, in[2] + 2 * D, in[3] + 2 * D);
    SEAM(26);
    MLP_PHASES(27, 2)
    if (IN(29)) {
        norm_phase(F, xout, Hb, xout, Hb, in[4] + 2 * D, in[1] + 3 * D);
        int base = 0;
        conv_w(F, base, in[24], D, 1840, 0, 1024, 1840, Wi, D, 0, 0.125f * LOG2E);
        conv_w(F, base, in[24], D, 1840, 1024, 1024, 1840, Wi, D, 1024, 1.f);
        conv_w(F, base, in[31], D, D, 0, D, D, Wo, D, 0, 1.f);
        conv_w(F, base, in[26], 2048, 128, 0, 128, 128, (bf16*)(ws + SM_W1K), 2048, 0, 1.f);
        conv_w(F, base, in[29], 2048, 128, 0, 128, 128, (bf16*)(ws + SM_W1V), 2048, 0, 1.f);
        conv_w(F, base, in[27], 128, 64, 0, 64, 64, (bf16*)(ws + SM_W2K), 128, 0, 1.f);
        conv_w(F, base, in[30], 128, 64, 0, 64, 64, (bf16*)(ws + SM_W2V), 128, 0, 1.f);
        CONV_MLP(3, base);
        for (int itx = F.vcu; itx < 4; itx += F.G) {
            const int kv = itx >> 1, c = (itx & 1) * 64 + F.lane;
            const float* pe = kv ? in[28] : in[25]; const float* w1 = kv ? in[29] : in[26];
            float s = 0.f;
            for (int i2 = F.wave * 256; i2 < F.wave * 256 + 256; ++i2) s += pe[i2] * w1[(size_t)i2 * 128 + c];
            LAS float* red = (LAS float*)(F.lds + 8 * 8704);
            __syncthreads();
            red[F.wave * 64 + F.lane] = s;
            __syncthreads();
            if (F.wave == 0) { float tsum = 0.f;
#pragma unroll
                for (int w2 = 0; w2 < 8; ++w2) tsum += red[w2 * 64 + F.lane];
                ((float*)(ws + SM_PEB))[kv * 128 + c] = tsum; }
        }
    }
    SEAM(29);
    if (IN(30)) { pg8::EpiNsa E{(bf16*)(ws + NSA_Q), (bf16*)(ws + NSA_KC), (bf16*)(ws + NSA_VC), (bf16*)(ws + NSA_KS), (bf16*)(ws + NSA_VST), (bf16*)(ws + NSA_KW), (bf16*)(ws + NSA_VWT), (float*)(ws + SM_GATES)};
        GEMM_PHASE(pg8::EpiNsa, Hb, D, Wi, D, 2048, D, 0, E); }
    SEAM(30);
    if (IN(31)) nsa_compress_phase(F, (const bf16*)(ws + NSA_KC), (const bf16*)(ws + NSA_VC), (const bf16*)(ws + SM_W1K), (const bf16*)(ws + SM_W1V), (const bf16*)(ws + SM_W2K), (const bf16*)(ws + SM_W2V),
                                   (const float*)(ws + SM_PEB), (bf16*)(ws + SM_KCMP), (bf16*)(ws + SM_VCMPT));
    SEAM(31);
    if (IN(32)) nsa_attn_phase(F, (const bf16*)(ws + NSA_Q), (const bf16*)(ws + SM_KCMP), (const bf16*)(ws + SM_VCMPT), (const bf16*)(ws + NSA_KS), (const bf16*)(ws + NSA_VST), (const bf16*)(ws + NSA_KW), (const bf16*)(ws + NSA_VWT),
                               (const float*)(ws + SM_GATES), (bf16*)(ws + NSA_O));
    SEAM(32);
    if (IN(33)) { pg8::EpiStore<0> E{Hb, D}; GEMM_PHASE(pg8::EpiStore<0>, ws + NSA_O, D, Wo, D, D, D, 0, E); }
    SEAM(33);
    if (IN(34)) norm_phase(F, xout, Hb, xout, Hb, in[2] + 3 * D, in[3] + 3 * D);
    SEAM(34);
    MLP_PHASES(35, 3)
    if (IN(37)) norm_phase(F, xout, Hb, xout, nullptr, in[4] + 3 * D, nullptr);
#undef IN
#undef SEAM
}

#ifndef MK_PER_PHASE
#define MK_PER_PHASE 0
#endif
extern "C" void kernel_launch(void* const* d_in, const int* in_sizes, int n_in, void* d_out, int out_size, void* d_ws, size_t ws_size, hipStream_t stream) {
    static int grid = 0;
    if (grid == 0) {
        if (n_in != 32 || in_sizes[0] != M * D || out_size != M * D || ws_size < WS_END) { fprintf(stderr, "kernel_launch: unexpected shapes / workspace (n_in %d, ws %zu); nothing launched\n", n_in, ws_size); grid = -1; return; }
        int dev = 0, cus = 0, per_cu = 0;
        if (hipGetDevice(&dev) != hipSuccess || hipDeviceGetAttribute(&cus, hipDeviceAttributeMultiprocessorCount, dev) != hipSuccess) { grid = -1; return; }
        if (hipFuncSetAttribute((const void*)trunk_fwd, hipFuncAttributeMaxDynamicSharedMemorySize, LDS_BYTES) != hipSuccess) { fprintf(stderr, "kernel_launch: hipFuncSetAttribute failed\n"); grid = -1; return; }
        if (hipOccupancyMaxActiveBlocksPerMultiprocessor(&per_cu, (const void*)trunk_fwd, NWAVES * 64, LDS_BYTES) != hipSuccess || per_cu < 1)
            fprintf(stderr, "kernel_launch: note: occupancy query reports %d workgroups per CU\n", per_cu);
        (void)hipGetLastError();
        grid = cus;
    }
    if (grid < 0) return;
    if (hipMemsetAsync((char*)d_ws + WS_CTL, 0, CTL_ZERO_BYTES, stream) != hipSuccess) return;
    Args a{};
    for (int i = 0; i < 32; ++i) a.in[i] = (const float*)d_in[i];
    a.out = (float*)d_out; a.ws = (unsigned char*)d_ws;
#if MK_PER_PHASE
    for (int p = 0; p < N_PHASES; ++p) { a.ph_lo = p; a.ph_hi = p + 1; hipLaunchKernelGGL(trunk_fwd, dim3(grid), dim3(NWAVES * 64), LDS_BYTES, stream, a); }
#else
    a.ph_lo = 0; a.ph_hi = N_PHASES;
    hipLaunchKernelGGL(trunk_fwd, dim3(grid), dim3(NWAVES * 64), LDS_BYTES, stream, a);
#endif
#ifdef PROBE_PHASES
    { const int pp[] = {PROBE_PHASES}; a.dry = 1;
      for (int p : pp) { a.ph_lo = p; a.ph_hi = p + 1; hipLaunchKernelGGL(trunk_fwd, dim3(grid), dim3(NWAVES * 64), LDS_BYTES, stream, a); } }
#endif
}
```

```cpp
#include <hip/hip_runtime.h>
#include <cstdio>
#include <cstdint>
#include <cmath>

namespace pg8 {
#define PG8_LAS __attribute__((address_space(3)))
typedef unsigned short bf16_t;
typedef short bf16x8 __attribute__((ext_vector_type(8)));
typedef float f32x4 __attribute__((ext_vector_type(4)));
typedef unsigned u32x4 __attribute__((ext_vector_type(4)));
typedef unsigned u32x2 __attribute__((ext_vector_type(2)));
constexpr int BM = 256, BK = 64, HALF = 128, HTB = HALF * BK * 2  , STAGE_BYTES = 8 * HTB, NXCD = 8, WGM = 8;

__host__ __device__ __forceinline__ int lds_byte(int r, int c) { const int st = (r >> 4) * 2 + (c >> 5), rr = r & 15, cc = c & 31, ob = rr * 64 + cc * 2; return st * 1024 + (ob ^ (((ob >> 9) & 1) << 5)); }
__host__ __device__ __forceinline__ void stage_rc(int b, int& R, int& C) { const int st = b / 1024, sb = b % 1024, swz = sb ^ (((sb >> 9) & 1) << 5); R = (st >> 1) * 16 + swz / 64; C = (st & 1) * 32 + (swz % 64) / 2; }
__host__ __device__ __forceinline__ int perm32(int rho) { const int n = rho >> 4, i = rho & 15; return 8 * (i >> 2) + 4 * n + (i & 3); }

struct Unit { int pm, pn; };
struct Gemm { const bf16_t* A; const bf16_t* Bt; int M, N, K, lda, ldb; size_t a_pn_step; };

struct StaticOrder {
    int nM, nN, nwg, G, c;
    __host__ __device__ void init(int M, int N, int G_, int c_) { nM = M / BM; nN = N / BM; nwg = nM * nN; G = G_; c = c_; }
    __host__ __device__ bool next(int i, Unit& u) const {
        const long L = (long)i * G + c; if (L >= nwg) return false;
        int wgid = (int)L; { const int q = nwg / NXCD, r = nwg % NXCD, xcd = wgid % NXCD, off = wgid / NXCD; wgid = (xcd < r ? xcd * (q + 1) : r * (q + 1) + (xcd - r) * q) + off; }
        const int nig = WGM * nN, gid = wgid / nig, fm = gid * WGM, gsz = (nM - fm) < WGM ? (nM - fm) : WGM;
        u.pm = fm + ((wgid % nig) % gsz); u.pn = (wgid % nig) / gsz; return true;
    }
    __device__ __forceinline__ void a_ready(const Unit&) const {}
    __device__ __forceinline__ void done(const Unit&) const {}
};

__device__ __forceinline__ unsigned cvt_pk_bf16(float lo, float hi) { unsigned r; asm volatile("v_cvt_pk_bf16_f32 %0, %1, %2" : "=v"(r) : "v"(lo), "v"(hi)); return r; }
__device__ __forceinline__ u32x4 pack8(const f32x4 v0, const f32x4 v1) { u32x4 w; w.x = cvt_pk_bf16(v0[0], v0[1]); w.y = cvt_pk_bf16(v0[2], v0[3]); w.z = cvt_pk_bf16(v1[0], v1[1]); w.w = cvt_pk_bf16(v1[2], v1[3]); return w; }
__device__ __forceinline__ float bf_lo(unsigned w) { return __uint_as_float(w << 16); }
__device__ __forceinline__ float bf_hi(unsigned w) { return __uint_as_float(w & 0xffff0000u); }

template <int ACT> struct EpiStore {
    static constexpr bool PERM = true, AFTER_DRAIN = false;
    bf16_t* O; int ldc; const float* rs;
    __device__ __forceinline__ void operator()(const f32x4 (&acc)[2][2][4][2], const Unit& u, int wr, int wc, int fr, int fq) const {
        const int row0 = u.pm * BM + wr * 64 + fr, col0 = u.pn * BM + wc * 32 + 8 * fq;
#pragma unroll
        for (int ai = 0; ai < 2; ++ai)
#pragma unroll
            for (int m = 0; m < 4; ++m) { bf16_t* rowp = O + (size_t)(row0 + ai * HALF + m * 16) * ldc + col0;
                const float rsc = rs ? rs[row0 + ai * HALF + m * 16] : 1.f;
#pragma unroll
                for (int bj = 0; bj < 2; ++bj) { f32x4 v0 = acc[ai][bj][m][0] * rsc, v1 = acc[ai][bj][m][1] * rsc;
                    if (ACT == 1) {
#pragma unroll
                        for (int e = 0; e < 4; ++e) { const float a = fmaxf(v0[e], 0.f), b = fmaxf(v1[e], 0.f); v0[e] = a * a; v1[e] = b * b; } }
                    *(u32x4*)(rowp + bj * HALF) = pack8(v0, v1); } }
    }
};

struct EpiRet {
    static constexpr bool PERM = true, AFTER_DRAIN = false;
    bf16_t* O; int ldc; const float* rs;
    __device__ __forceinline__ void operator()(const f32x4 (&acc)[2][2][4][2], const Unit& u, int wr, int wc, int fr, int fq) const {
        const int row0 = u.pm * BM + wr * 64 + fr, col0 = u.pn * BM + wc * 32 + 8 * fq;
        const float lg = __log2f(1.f - exp2f(-5.f - (float)(u.pn & 3)));
        const float sgn = u.pn < 4 ? lg : -lg, mul = u.pn < 4 ? 1.f : 0.0625f;
        const bool scaled = u.pn < 8;
#pragma unroll
        for (int ai = 0; ai < 2; ++ai)
#pragma unroll
            for (int m = 0; m < 4; ++m) { const int row = row0 + ai * HALF + m * 16; bf16_t* rowp = O + (size_t)row * ldc + col0;
                const float sc = (scaled ? exp2f(sgn * (float)(row & 63)) * mul : 1.f) * rs[row];
#pragma unroll
                for (int bj = 0; bj < 2; ++bj) *(u32x4*)(rowp + bj * HALF) = pack8(acc[ai][bj][m][0] * sc, acc[ai][bj][m][1] * sc); }
    }
};

struct EpiGla {
    static constexpr bool PERM = true, AFTER_DRAIN = false;
    bf16_t* O; int ldc; const float* bgate; const float* rs;
    __device__ __forceinline__ void operator()(const f32x4 (&acc)[2][2][4][2], const Unit& u, int wr, int wc, int fr, int fq) const {
        const int row0 = u.pm * BM + wr * 64 + fr, col0 = u.pn * BM + wc * 32 + 8 * fq;
        const bool gate = u.pn >= 12;
        f32x4 bv[2][2];
#pragma unroll
        for (int bj = 0; bj < 2; ++bj)
#pragma unroll
            for (int n = 0; n < 2; ++n) bv[bj][n] = gate ? *(const f32x4*)(bgate + (col0 - 3072) + bj * HALF + 4 * n) : (f32x4){0.f, 0.f, 0.f, 0.f};
#pragma unroll
        for (int ai = 0; ai < 2; ++ai)
#pragma unroll
            for (int m = 0; m < 4; ++m) { bf16_t* rowp = O + (size_t)(row0 + ai * HALF + m * 16) * ldc + col0;
                const float rsc = rs[row0 + ai * HALF + m * 16];
#pragma unroll
                for (int bj = 0; bj < 2; ++bj) { f32x4 v0 = acc[ai][bj][m][0] * rsc, v1 = acc[ai][bj][m][1] * rsc;
                    if (gate) {
#pragma unroll
                        for (int e = 0; e < 4; ++e) {
                            const float z0 = v0[e] + bv[bj][0][e], z1 = v1[e] + bv[bj][1][e];
                            v0[e] = (fminf(z0, 0.f) - log1pf(__expf(-fabsf(z0)))) * 0.0625f;
                            v1[e] = (fminf(z1, 0.f) - log1pf(__expf(-fabsf(z1)))) * 0.0625f; } }
                    *(u32x4*)(rowp + bj * HALF) = pack8(v0, v1); } }
    }
};

struct EpiNsa {
    static constexpr bool PERM = true, AFTER_DRAIN = false;
    bf16_t* Q; bf16_t* KC; bf16_t* VC; bf16_t* KS; bf16_t* VST; bf16_t* KW; bf16_t* VWT; float* GATES; const float* rs;
    template <bool VTRANS> __device__ __forceinline__ void kv_store(const f32x4 (&acc)[2][2][4][2], bf16_t* Kt, bf16_t* Vt, int row0, int c8) const {
        const int g = c8 >> 6, d = c8 & 63;
#pragma unroll
        for (int ai = 0; ai < 2; ++ai)
#pragma unroll
            for (int m = 0; m < 4; ++m) {
                const int row = row0 + ai * HALF + m * 16, b = row >> 12, t = row & 4095;
                const size_t bg = (size_t)(b * 2 + g); const float rsc = rs[row];
                *(u32x4*)(Kt + (bg * 4096 + t) * 64 + d) = pack8(acc[ai][0][m][0] * rsc, acc[ai][0][m][1] * rsc);
                const u32x4 w = pack8(acc[ai][1][m][0] * rsc, acc[ai][1][m][1] * rsc);
                if (!VTRANS) *(u32x4*)(Vt + (bg * 4096 + t) * 64 + d) = w;
                else {
                    bf16_t* vp = Vt + (bg * 64 + d) * 4096 + t;
                    vp[0 * 4096] = (bf16_t)(w.x & 0xffffu); vp[1 * 4096] = (bf16_t)(w.x >> 16);
                    vp[2 * 4096] = (bf16_t)(w.y & 0xffffu); vp[3 * 4096] = (bf16_t)(w.y >> 16);
                    vp[4 * 4096] = (bf16_t)(w.z & 0xffffu); vp[5 * 4096] = (bf16_t)(w.z >> 16);
                    vp[6 * 4096] = (bf16_t)(w.w & 0xffffu); vp[7 * 4096] = (bf16_t)(w.w >> 16);
                }
            }
    }
    __device__ __forceinline__ void operator()(const f32x4 (&acc)[2][2][4][2], const Unit& u, int wr, int wc, int fr, int fq) const {
        const int row0 = u.pm * BM + wr * 64 + fr, c8 = wc * 32 + 8 * fq;
        if (u.pn < 4) {
#pragma unroll
            for (int ai = 0; ai < 2; ++ai)
#pragma unroll
                for (int m = 0; m < 4; ++m) { bf16_t* rowp = Q + (size_t)(row0 + ai * HALF + m * 16) * 1024 + u.pn * BM + c8; const float rsc = rs[row0 + ai * HALF + m * 16];
#pragma unroll
                    for (int bj = 0; bj < 2; ++bj) *(u32x4*)(rowp + bj * HALF) = pack8(acc[ai][bj][m][0] * rsc, acc[ai][bj][m][1] * rsc); }
        } else if (u.pn == 4) { kv_store<false>(acc, KC, VC, row0, c8);
        } else if (u.pn == 5) { kv_store<true>(acc, KS, VST, row0, c8);
        } else if (u.pn == 6) { kv_store<true>(acc, KW, VWT, row0, c8);
        } else {
            if (c8 < 48) {
#pragma unroll
                for (int ai = 0; ai < 2; ++ai)
#pragma unroll
                    for (int m = 0; m < 4; ++m) { float* gp = GATES + (size_t)(row0 + ai * HALF + m * 16) * 48 + c8; const float rsc = rs[row0 + ai * HALF + m * 16];
                        f32x4 v0 = acc[ai][0][m][0] * rsc, v1 = acc[ai][0][m][1] * rsc;
#pragma unroll
                        for (int e = 0; e < 4; ++e) { v0[e] = 1.f / (1.f + __expf(-v0[e])); v1[e] = 1.f / (1.f + __expf(-v1[e])); }
                        *(f32x4*)gp = v0; *(f32x4*)(gp + 4) = v1; }
            }
        }
    }
};

template <class Epi, class Sched, bool ALIGN_EPI = false, bool SP2 = false>
__device__ __forceinline__ void gemm_phase(PG8_LAS unsigned char* lds, const Gemm g, const Sched& S, const Epi& E) {
    const int tid = threadIdx.x, wid = __builtin_amdgcn_readfirstlane(tid >> 6), lane = tid & 63, wr = wid >> 2, wc = wid & 3, fr = lane & 15, fq = lane >> 4;
    const int K = g.K, nt = K / BK;
    unsigned voffA[2], voffB[2];
#pragma unroll
    for (int i = 0; i < 2; ++i) { int R, C; stage_rc(tid * 16 + i * 8192, R, C); const int Rb = Epi::PERM ? ((R & ~31) + perm32(R & 31)) : R;
        voffA[i] = (unsigned)(R * g.lda + C) * 2u; voffB[i] = (unsigned)(Rb * g.ldb + C) * 2u; }
    const size_t kstep = (size_t)(BK * 2);
    const size_t hstepA = (size_t)HALF * g.lda * 2, hstepB = (size_t)HALF * g.ldb * 2;
    const size_t tstepA = 2 * hstepA, tstepB = 2 * hstepB;
    const unsigned ldsw = (unsigned)wid * 1024u;
    const int aoff = lds_byte(wr * 64 + fr, fq * 8), boff = lds_byte(wc * 32 + fr, fq * 8);
#define PG8_SA(b, h) (((b) * 2 + (h)) * HTB)
#define PG8_SB(b, h) ((4 + (b) * 2 + (h)) * HTB)
#define PG8_STAGE(bufoff, gbase, voff) do { _Pragma("unroll") for (int _i = 0; _i < 2; ++_i) \
        __builtin_amdgcn_global_load_lds((const unsigned*)((const char*)(gbase) + (voff)[_i]), (PG8_LAS unsigned*)(lds + (bufoff) + ldsw + _i * 8192), 16, 0, 0); } while (0)
#define PG8_LDA(dst, b, h) do { _Pragma("unroll") for (int m = 0; m < 4; ++m) _Pragma("unroll") for (int k = 0; k < 2; ++k) dst[m][k] = *(const PG8_LAS bf16x8*)(lds + PG8_SA(b, h) + aoff + m * 2048 + k * 1024); } while (0)
#define PG8_LDB(dst, b, h) do { _Pragma("unroll") for (int n = 0; n < 2; ++n) _Pragma("unroll") for (int k = 0; k < 2; ++k) dst[n][k] = *(const PG8_LAS bf16x8*)(lds + PG8_SB(b, h) + boff + n * 2048 + k * 1024); } while (0)
#define PG8_MMA(ai, bj, At, Bt) do { __builtin_amdgcn_s_setprio(1); _Pragma("unroll") for (int m = 0; m < 4; ++m) _Pragma("unroll") for (int n = 0; n < 2; ++n) _Pragma("unroll") for (int k = 0; k < 2; ++k) \
        acc[ai][bj][m][n] = __builtin_amdgcn_mfma_f32_16x16x32_bf16(Bt[n][k], At[m][k], acc[ai][bj][m][n], 0, 0, 0); __builtin_amdgcn_s_setprio(0); } while (0)
#define PG8_WAIT_V(n) asm volatile("s_waitcnt vmcnt(" #n ")" ::: "memory")
#define PG8_WAIT_L(n) asm volatile("s_waitcnt lgkmcnt(" #n ")" ::: "memory")
#define PG8_BAR __builtin_amdgcn_s_barrier()
#define PG8_SCHED __builtin_amdgcn_sched_barrier(0)
    Unit cur, nxt; int ui = 0;
    if (!S.next(0, cur)) return;
    f32x4 acc[2][2][4][2];
#pragma unroll
    for (int a = 0; a < 2; ++a)
#pragma unroll
        for (int b = 0; b < 2; ++b)
#pragma unroll
            for (int m = 0; m < 4; ++m)
#pragma unroll
                for (int n = 0; n < 2; ++n) acc[a][b][m][n] = (f32x4){0.f, 0.f, 0.f, 0.f};
    bf16x8 At[4][2], B0[2][2], B1[2][2];
    const char* cA = (const char*)g.A + (size_t)cur.pm * tstepA + (size_t)cur.pn * g.a_pn_step; const char* cB = (const char*)g.Bt + (size_t)cur.pn * tstepB;
    S.a_ready(cur);
    if constexpr (SP2) {
        PG8_STAGE(PG8_SB(0, 0), cB, voffB); PG8_STAGE(PG8_SB(0, 1), cB + hstepB, voffB); PG8_STAGE(PG8_SA(0, 0), cA, voffA); PG8_STAGE(PG8_SA(0, 1), cA + hstepA, voffA);
        if (wr == 1) PG8_BAR;
        PG8_WAIT_V(2); PG8_BAR;
        PG8_STAGE(PG8_SB(1, 0), cB + kstep, voffB); PG8_STAGE(PG8_SA(1, 0), cA + kstep, voffA); PG8_STAGE(PG8_SB(1, 1), cB + hstepB + kstep, voffB);
        PG8_WAIT_V(6); PG8_BAR;
    } else {
        PG8_STAGE(PG8_SB(0, 0), cB, voffB); PG8_STAGE(PG8_SA(0, 0), cA, voffA); PG8_STAGE(PG8_SB(0, 1), cB + hstepB, voffB); PG8_STAGE(PG8_SA(0, 1), cA + hstepA, voffA);
        if (wr == 1) PG8_BAR;
        PG8_WAIT_V(4); PG8_BAR;
        PG8_STAGE(PG8_SB(1, 0), cB + kstep, voffB); PG8_STAGE(PG8_SA(1, 0), cA + kstep, voffA); PG8_STAGE(PG8_SB(1, 1), cB + hstepB + kstep, voffB);
        PG8_WAIT_V(6); PG8_BAR;
    }
    for (;;) {
        const bool has_next = S.next(ui + 1, nxt);
        const char* nA = has_next ? (const char*)g.A + (size_t)nxt.pm * tstepA + (size_t)nxt.pn * g.a_pn_step : cA; const char* nB = has_next ? (const char*)g.Bt + (size_t)nxt.pn * tstepB : cB;
        for (int t = 0; t < nt; t += 2) {
            const bool last = (t == nt - 2);
            const char* a1 = cA + (size_t)(t + 1) * kstep;
            const char* a2 = last ? nA : cA + (size_t)(t + 2) * kstep; const char* b2 = last ? nB : cB + (size_t)(t + 2) * kstep;
            const char* a3 = a2 + kstep; const char* b3 = b2 + kstep;
            if (last && has_next) S.a_ready(nxt);
            if constexpr (SP2) {
            PG8_LDB(B0, 0, 0); PG8_LDB(B1, 0, 1); PG8_SCHED; PG8_LDA(At, 0, 0); PG8_STAGE(PG8_SA(1, 1), a1 + hstepA, voffA);
            PG8_WAIT_V(8); PG8_WAIT_L(0); PG8_BAR; PG8_MMA(0, 0, At, B0); PG8_MMA(0, 1, At, B1); PG8_BAR; PG8_SCHED;
            PG8_LDA(At, 0, 1); PG8_STAGE(PG8_SB(0, 0), b2, voffB); PG8_STAGE(PG8_SB(0, 1), b2 + hstepB, voffB); PG8_STAGE(PG8_SA(0, 0), a2, voffA);
            PG8_WAIT_V(8); PG8_WAIT_L(0); PG8_BAR; PG8_MMA(1, 0, At, B0); PG8_MMA(1, 1, At, B1); PG8_BAR; PG8_SCHED;
            PG8_LDB(B0, 1, 0); PG8_LDB(B1, 1, 1); PG8_SCHED; PG8_LDA(At, 1, 0); PG8_STAGE(PG8_SA(0, 1), a2 + hstepA, voffA);
            PG8_WAIT_V(8); PG8_WAIT_L(0); PG8_BAR; PG8_MMA(0, 0, At, B0); PG8_MMA(0, 1, At, B1); PG8_BAR; PG8_SCHED;
            PG8_LDA(At, 1, 1); PG8_STAGE(PG8_SB(1, 0), b3, voffB); PG8_STAGE(PG8_SB(1, 1), b3 + hstepB, voffB); PG8_STAGE(PG8_SA(1, 0), a3, voffA);
            PG8_WAIT_V(8); PG8_WAIT_L(0); PG8_BAR; PG8_MMA(1, 0, At, B0); PG8_MMA(1, 1, At, B1); PG8_BAR; PG8_SCHED;
            } else {
            PG8_LDB(B0, 0, 0); PG8_SCHED; PG8_LDA(At, 0, 0); PG8_STAGE(PG8_SA(1, 1), a1 + hstepA, voffA);
            PG8_WAIT_L(8); PG8_BAR; PG8_WAIT_L(0); PG8_MMA(0, 0, At, B0); PG8_BAR; PG8_SCHED;
            PG8_LDB(B1, 0, 1); PG8_STAGE(PG8_SB(0, 0), b2, voffB);
            PG8_BAR; PG8_WAIT_L(0); PG8_MMA(0, 1, At, B1); PG8_BAR;
            PG8_LDA(At, 0, 1); PG8_STAGE(PG8_SA(0, 0), a2, voffA);
            PG8_BAR; PG8_WAIT_L(0); PG8_MMA(1, 0, At, B0); PG8_BAR; PG8_SCHED;
            PG8_STAGE(PG8_SB(0, 1), b2 + hstepB, voffB);
            PG8_WAIT_V(6); PG8_BAR; PG8_MMA(1, 1, At, B1); PG8_BAR;
            PG8_LDB(B0, 1, 0); PG8_SCHED; PG8_LDA(At, 1, 0); PG8_STAGE(PG8_SA(0, 1), a2 + hstepA, voffA);
            PG8_WAIT_L(8); PG8_BAR; PG8_WAIT_L(0); PG8_MMA(0, 0, At, B0); PG8_BAR; PG8_SCHED;
            PG8_LDB(B1, 1, 1); PG8_STAGE(PG8_SB(1, 0), b3, voffB);
            PG8_BAR; PG8_WAIT_L(0); PG8_MMA(0, 1, At, B1); PG8_BAR;
            PG8_LDA(At, 1, 1); PG8_STAGE(PG8_SA(1, 0), a3, voffA);
            PG8_BAR; PG8_WAIT_L(0); PG8_MMA(1, 0, At, B0); PG8_BAR; PG8_SCHED;
            PG8_STAGE(PG8_SB(1, 1), b3 + hstepB, voffB);
            PG8_WAIT_V(6); PG8_BAR; PG8_MMA(1, 1, At, B1); PG8_BAR;
            }
        }
        if constexpr (ALIGN_EPI) { if (wr == 0) PG8_BAR; }
        if constexpr (!Epi::AFTER_DRAIN) { E(acc, cur, wr, wc, fr, fq); S.done(cur); }
        if (!has_next) break;
#pragma unroll
        for (int a = 0; a < 2; ++a)
#pragma unroll
            for (int b = 0; b < 2; ++b)
#pragma unroll
                for (int m = 0; m < 4; ++m)
#pragma unroll
                    for (int n = 0; n < 2; ++n) acc[a][b][m][n] = (f32x4){0.f, 0.f, 0.f, 0.f};
        cur = nxt; cA = nA; cB = nB; ++ui;
        if constexpr (ALIGN_EPI) { if (wr == 1) PG8_BAR; }
    }
    PG8_WAIT_V(0);
    if constexpr (!ALIGN_EPI) { if (wr == 0) PG8_BAR; }
    PG8_BAR;
    if constexpr (Epi::AFTER_DRAIN) { E.fused(acc, cur, wr, wc, fr, fq, lds, wid, lane); S.done(cur); }
#undef PG8_SA
#undef PG8_SB
#undef PG8_STAGE
#undef PG8_LDA
#undef PG8_LDB
#undef PG8_MMA
#undef PG8_WAIT_V
#undef PG8_WAIT_L
#undef PG8_BAR
#undef PG8_SCHED
}
}

constexpr int BATCH = 8, SEQ = 4096, D = 1024, FF = 4096;
constexpr int M = BATCH * SEQ;
constexpr float NORM_EPS = 1e-6f;
constexpr int NWAVES = 8;
constexpr float LOG2E = 1.4426950408889634f;

constexpr size_t MiB = 1u << 20;
constexpr size_t WS_CTL = 0, CTL_ZERO_BYTES = 64 * 1024;
constexpr size_t WS_WIN = 1 * MiB, WS_WOUT = 13 * MiB, WS_WUP = 17 * MiB, WS_WDN = 25 * MiB;
constexpr size_t WS_H = 33 * MiB;
constexpr size_t WS_BIG = 97 * MiB;
constexpr size_t WS_SMALL = 481 * MiB;
constexpr size_t WS_END = 512 * MiB;
constexpr size_t SM_LRUW = WS_SMALL;
constexpr size_t SM_SCANP = WS_SMALL + 1 * MiB, SM_SCANE = WS_SMALL + 3 * MiB;
constexpr size_t SM_W1K = WS_SMALL + 5 * MiB, SM_W1V = SM_W1K + 512 * 1024;
constexpr size_t SM_W2K = WS_SMALL + 6 * MiB, SM_W2V = SM_W2K + 16 * 1024, SM_PEB = SM_W2V + 16 * 1024;
constexpr size_t SM_KCMP = WS_SMALL + 7 * MiB, SM_VCMPT = SM_KCMP + 512 * 1024;
constexpr size_t SM_GATES = WS_SMALL + 8 * MiB;
constexpr size_t SM_AT = WS_SMALL;
constexpr size_t SM_RS = WS_SMALL + 18 * MiB;
constexpr size_t SM_GLAW = WS_SMALL + 16 * MiB;
constexpr size_t LRU_XY = WS_BIG, LRU_XC = WS_BIG + 128 * MiB, LRU_GP = WS_BIG + 192 * MiB, LRU_HS = WS_BIG + 320 * MiB;
constexpr size_t NSA_Q = WS_BIG, NSA_KC = WS_BIG + 64 * MiB, NSA_VC = NSA_KC + 8 * MiB, NSA_KS = NSA_KC + 16 * MiB, NSA_VST = NSA_KC + 24 * MiB,
                 NSA_KW = NSA_KC + 32 * MiB, NSA_VWT = NSA_KC + 40 * MiB, NSA_O = WS_BIG + 128 * MiB;
constexpr int CW_BAR = 1024;

constexpr int RING_OFF = 0, SCR_BYTES = 143360;
constexpr int LDSCTL_OFF = SCR_BYTES;
constexpr int LDS_BYTES = 147456;

#define GAS __attribute__((address_space(1)))
#define LAS __attribute__((address_space(3)))
typedef unsigned short bf16;
typedef unsigned v4u __attribute__((ext_vector_type(4)));
typedef unsigned v2u __attribute__((ext_vector_type(2)));
typedef float f32x4 __attribute__((ext_vector_type(4)));
typedef float f32x2 __attribute__((ext_vector_type(2)));
typedef float f32x16 __attribute__((ext_vector_type(16)));
typedef short bf16x8 __attribute__((ext_vector_type(8)));
typedef short s16x4 __attribute__((ext_vector_type(4)));
#define MFMA32(a, b, c) __builtin_amdgcn_mfma_f32_32x32x16_bf16((a), (b), (c), 0, 0, 0)
__device__ __forceinline__ unsigned f2bf(float f) { unsigned u = __builtin_bit_cast(unsigned, f); return (u + 0x7fffu + ((u >> 16) & 1u)) >> 16; }
__device__ __forceinline__ unsigned pk2(float lo, float hi) { return f2bf(lo) | (f2bf(hi) << 16); }
__device__ __forceinline__ float bflo(unsigned w) { return __uint_as_float(w << 16); }
__device__ __forceinline__ float bfhi(unsigned w) { return __uint_as_float(w & 0xffff0000u); }
__device__ __forceinline__ float bf1(bf16 v) { return __uint_as_float((unsigned)v << 16); }
__device__ __forceinline__ float gelu_tanh(float x) { const float z = 0.7978845608028654f * (x + 0.044715f * x * x * x); const float t = 1.f - 2.f / (1.f + __expf(2.f * z)); return 0.5f * x * (1.f + t); }
__device__ __forceinline__ float silu(float x) { return x / (1.f + __expf(-x)); }

#define XB_TMO      128
#define XB_XCNT(j)  (256  + 64 * (j))
#define XB_XSUB(j)  (1280 + 64 * (j))
#define XB_XGEN(j)  (2304 + 64 * (j))
#define XB_TOP      3328
#define XB_TOPGEN   3392
#define XCD_BAR_WORDS 3456
#define XB_SPIN_CAP (1u << 18)
#define LAS __attribute__((address_space(3)))

__device__ __forceinline__ unsigned xb_ld(unsigned* p)              { return __hip_atomic_load(p, __ATOMIC_RELAXED, __HIP_MEMORY_SCOPE_AGENT); }
__device__ __forceinline__ unsigned xb_add(unsigned* p, unsigned v) { return __hip_atomic_fetch_add(p, v, __ATOMIC_RELAXED, __HIP_MEMORY_SCOPE_AGENT); }
__device__ __forceinline__ unsigned xb_xcc_id() { return (unsigned)__builtin_amdgcn_s_getreg((3 << 11) | 20) & 0xFu; }
#define XB_SPIN(cond, bar) do { unsigned _sp = 0; while (cond) { __builtin_amdgcn_s_sleep(1); \
    if ((++_sp & 255u) == 0u) { if (xb_ld(&(bar)[XB_TMO])) break; if (_sp > XB_SPIN_CAP) { atomicAdd(&(bar)[XB_TMO], 1u); break; } } } } while (0)

struct XcdBarrier {
    unsigned* bar; unsigned x;
    volatile LAS unsigned* st;
};

__device__ __forceinline__ XcdBarrier xcd_barrier_post(unsigned* bar, volatile LAS unsigned* st) {
    XcdBarrier b; b.bar = bar; b.x = xb_xcc_id(); b.st = st;
    if (threadIdx.x == 0) (void)xb_add(&bar[XB_XCNT(b.x)], 1u);
    return b;
}
__device__ __forceinline__ void xcd_barrier_complete(unsigned* bar, unsigned x, unsigned& nloc, unsigned& nx) {
    const unsigned G = gridDim.x * gridDim.y * gridDim.z;
    unsigned sum, cnt, mine, sp = 0u;
    for (;;) {
        sum = 0u; cnt = 0u; mine = 0u;
#pragma unroll
        for (unsigned j = 0; j < 16; ++j) { const unsigned c = xb_ld(&bar[XB_XCNT(j)]); sum += c; cnt += (c > 0u) ? 1u : 0u; mine = (j == x) ? c : mine; }
        if (sum == G) break;
        __builtin_amdgcn_s_sleep(1);
        if ((++sp & 255u) == 0u) { if (xb_ld(&bar[XB_TMO])) break; if (sp > XB_SPIN_CAP) { atomicAdd(&bar[XB_TMO], 1u); break; } }
    }
    nloc = mine > 0u ? mine : 1u; nx = cnt > 0u ? cnt : 1u;
}

__device__ __forceinline__ void xcd_barrier(const XcdBarrier& b) {
    asm volatile("s_waitcnt vmcnt(0)" ::: "memory");
    __syncthreads();
    if (threadIdx.x == 0) {
        unsigned* bar = b.bar;
        __builtin_amdgcn_s_waitcnt(0);
        unsigned nloc = b.st[0], nx = b.st[1];
        if (nloc == 0u) { xcd_barrier_complete(bar, b.x, nloc, nx); b.st[0] = nloc; b.st[1] = nx; }
        const unsigned old = xb_add(&bar[XB_XSUB(b.x)], 1u);
        const unsigned gen = old / nloc;
        if (old + 1u == (gen + 1u) * nloc) {
            __builtin_amdgcn_fence(__ATOMIC_RELEASE, "agent");
            asm volatile("s_waitcnt vmcnt(0)" ::: "memory");
            const unsigned og = xb_add(&bar[XB_TOP], 1u);
            const unsigned tg = og / nx;
            if (og + 1u == (tg + 1u) * nx) xb_add(&bar[XB_TOPGEN], 1u);
            else XB_SPIN(xb_ld(&bar[XB_TOPGEN]) == tg, bar);
            __builtin_amdgcn_fence(__ATOMIC_ACQUIRE, "agent");
            xb_add(&bar[XB_XGEN(b.x)], 1u);
            asm volatile("s_waitcnt vmcnt(0)" ::: "memory");
        } else {
            XB_SPIN(xb_ld(&bar[XB_XGEN(b.x)]) == gen, bar);
            __builtin_amdgcn_fence(__ATOMIC_ACQUIRE, "agent");
            asm volatile("s_waitcnt vmcnt(0)" ::: "memory");
        }
    }
    __syncthreads();
}

struct Frame {
    LAS unsigned char* lds;
    int tid, lane, wave;
    int vcu, G;
    unsigned char* ws;
    int dry;
};

__device__ __forceinline__ bool frame_refresh(Frame& F) { int tz = threadIdx.x; asm volatile("" : "+v"(tz)); F.tid = tz; F.lane = tz & 63; return true; }
__device__ __forceinline__ float wave_sum(float v) {
#pragma unroll
    for (int o = 1; o < 64; o <<= 1) v += __shfl_xor(v, o);
    return v;
}
__device__ __forceinline__ float grp16_sum(float v) {
#pragma unroll
    for (int o = 1; o < 16; o <<= 1) v += __shfl_xor(v, o);
    return v;
}

__device__ __forceinline__ void conv_w(Frame& F, int& base, const float* W, int K, int ldw, int n_src0, int ncols, int n_valid, bf16* WT, int ldk, int row_off, float scale, const float* gk = nullptr) {
    LAS float* scr = (LAS float*)(F.lds + F.wave * 8704);
    const int gw = F.vcu * NWAVES + F.wave, NGW = F.G * NWAVES, lane = F.lane;
    const int nblk = ncols / 32, items = (K / 64) * nblk;
    int start = (gw - base % NGW + NGW) % NGW; base += items;
    for (int it = start; it < items; it += NGW) {
        const int kb = it / nblk, nb = it % nblk, k0 = 64 * kb, n0 = 32 * nb;
        const int n4 = (lane & 7) * 4, nn = n_src0 + n0 + n4; const bool ok = nn < n_valid;
        f32x4 v[8];
#pragma unroll
        for (int i = 0; i < 8; ++i) { const int kk = (lane >> 3) + 8 * i; v[i] = ok ? *(const f32x4*)(W + (size_t)(k0 + kk) * ldw + nn) : (f32x4){0.f, 0.f, 0.f, 0.f}; }
#pragma unroll
        for (int i = 0; i < 8; ++i) { const int kk = (lane >> 3) + 8 * i; const float sc = gk ? scale * gk[k0 + kk] : scale;
            scr[kk * 33 + n4] = v[i].x * sc; scr[kk * 33 + n4 + 1] = v[i].y * sc; scr[kk * 33 + n4 + 2] = v[i].z * sc; scr[kk * 33 + n4 + 3] = v[i].w * sc; }
        asm volatile("s_waitcnt lgkmcnt(0)" ::: "memory");
        const int c = lane & 7;
#pragma unroll
        for (int j = 0; j < 4; ++j) { const int n = (lane >> 3) + 8 * j; const LAS float* sp = scr + (8 * c) * 33 + n;
            v4u o; o.x = pk2(sp[0 * 33], sp[1 * 33]); o.y = pk2(sp[2 * 33], sp[3 * 33]); o.z = pk2(sp[4 * 33], sp[5 * 33]); o.w = pk2(sp[6 * 33], sp[7 * 33]);
            *(v4u*)(WT + (size_t)(row_off + n0 + n) * ldk + k0 + 8 * c) = o; }
        asm volatile("s_waitcnt lgkmcnt(0)" ::: "memory");
    }
}

template <int MODE  >
__device__ __forceinline__ void norm_phase(Frame& F, const float* xin, bf16* X, const bf16* Y, const float* gpost, float* RS, float* outf) {
    const int gw = F.vcu * NWAVES + F.wave, NGW = F.G * NWAVES, lane = F.lane;
    if (F.dry) { X = (bf16*)(F.ws + WS_BIG + (MODE == 1 ? 0 : 128 * MiB)); RS = (float*)(F.ws + WS_BIG + 256 * MiB); outf = (float*)(F.ws + WS_BIG); }
    const bf16* Xr = (MODE == 1 && F.dry) ? (const bf16*)(F.ws + WS_H) : X;
    for (int m = gw; m < M; m += NGW) {
        float v[16];
        if (MODE == 0) {
#pragma unroll
            for (int j = 0; j < 2; ++j) { const f32x4 a = *(const f32x4*)(xin + (size_t)m * D + lane * 8 + 512 * j), b2 = *(const f32x4*)(xin + (size_t)m * D + lane * 8 + 512 * j + 4);
                v[8 * j] = a.x; v[8 * j + 1] = a.y; v[8 * j + 2] = a.z; v[8 * j + 3] = a.w; v[8 * j + 4] = b2.x; v[8 * j + 5] = b2.y; v[8 * j + 6] = b2.z; v[8 * j + 7] = b2.w; }
        } else {
            v4u xw[2], yw[2];
#pragma unroll
            for (int j = 0; j < 2; ++j) { xw[j] = *(const v4u*)(Xr + (size_t)m * D + lane * 8 + 512 * j); yw[j] = *(const v4u*)(Y + (size_t)m * D + lane * 8 + 512 * j); }
            float y[16], ss = 0.f;
#pragma unroll
            for (int j = 0; j < 2; ++j) { y[8 * j] = bflo(yw[j].x); y[8 * j + 1] = bfhi(yw[j].x); y[8 * j + 2] = bflo(yw[j].y); y[8 * j + 3] = bfhi(yw[j].y); y[8 * j + 4] = bflo(yw[j].z); y[8 * j + 5] = bfhi(yw[j].z); y[8 * j + 6] = bflo(yw[j].w); y[8 * j + 7] = bfhi(yw[j].w);
                v[8 * j] = bflo(xw[j].x); v[8 * j + 1] = bfhi(xw[j].x); v[8 * j + 2] = bflo(xw[j].y); v[8 * j + 3] = bfhi(xw[j].y); v[8 * j + 4] = bflo(xw[j].z); v[8 * j + 5] = bfhi(xw[j].z); v[8 * j + 6] = bflo(xw[j].w); v[8 * j + 7] = bfhi(xw[j].w); }
#pragma unroll
            for (int e = 0; e < 16; ++e) ss += y[e] * y[e];
            const float rstd = rsqrtf(wave_sum(ss) * (1.f / D) + NORM_EPS);
#pragma unroll
            for (int j = 0; j < 2; ++j) { const f32x4 g0 = *(const f32x4*)(gpost + lane * 8 + 512 * j), g1 = *(const f32x4*)(gpost + lane * 8 + 512 * j + 4);
                v[8 * j] += y[8 * j] * rstd * g0.x; v[8 * j + 1] += y[8 * j + 1] * rstd * g0.y; v[8 * j + 2] += y[8 * j + 2] * rstd * g0.z; v[8 * j + 3] += y[8 * j + 3] * rstd * g0.w;
                v[8 * j + 4] += y[8 * j + 4] * rstd * g1.x; v[8 * j + 5] += y[8 * j + 5] * rstd * g1.y; v[8 * j + 6] += y[8 * j + 6] * rstd * g1.z; v[8 * j + 7] += y[8 * j + 7] * rstd * g1.w; }
        }
        if (MODE == 2) {
#pragma unroll
            for (int j = 0; j < 2; ++j) { float* op = outf + (size_t)m * D + lane * 8 + 512 * j;
                *(f32x4*)op = (f32x4){v[8 * j], v[8 * j + 1], v[8 * j + 2], v[8 * j + 3]}; *(f32x4*)(op + 4) = (f32x4){v[8 * j + 4], v[8 * j + 5], v[8 * j + 6], v[8 * j + 7]}; }
        } else {
            float s2 = 0.f;
#pragma unroll
            for (int e = 0; e < 16; ++e) s2 += v[e] * v[e];
            s2 = wave_sum(s2);
#pragma unroll
            for (int j = 0; j < 2; ++j) { v4u o; o.x = pk2(v[8 * j], v[8 * j + 1]); o.y = pk2(v[8 * j + 2], v[8 * j + 3]); o.z = pk2(v[8 * j + 4], v[8 * j + 5]); o.w = pk2(v[8 * j + 6], v[8 * j + 7]);
                *(v4u*)(X + (size_t)m * D + lane * 8 + 512 * j) = o; }
            if (lane == 0) RS[m] = rsqrtf(s2 * (1.f / D) + NORM_EPS);
        }
    }
}

template <int DK, int DV, int CS, bool ISGLA>
__device__ __forceinline__ void recur_phase(Frame& F, bf16* base, int ld, int qoff, int koff, int voff, int laoff, float kscale) {
    constexpr int NS = DV / CS, NDG = 512 / CS, DPT = DK / NDG, TB = 16, NT = ISGLA ? 3 : 2, NB = SEQ / TB;
    constexpr int STG = NT * TB * DK, VST = TB * CS, RED = NDG * TB * CS;
    static_assert((2 * STG + 2 * VST + 2 * RED) * 4 <= SCR_BYTES, "recurrent phase LDS");
    LAS float* stage = (LAS float*)F.lds; LAS float* vst = stage + 2 * STG; LAS float* red = vst + 2 * VST;
    const int tid = F.tid, c = tid % CS, dg = tid / CS;
    constexpr int QCH = TB * DK / 8, VCH = TB * CS / 8;
    const bool ldq = tid < QCH, ldv = tid < VCH;
    const int qt_ = tid / (DK / 8), qd = (tid % (DK / 8)) * 8;
    const int vt_ = tid / (CS / 8), vc_ = (tid % (CS / 8)) * 8;
    for (int it = F.vcu; it < 32 * NS; it += F.G) {
        const int bh = it / NS, sl = it % NS, b = bh >> 2, h = bh & 3;
        bf16* rowbase = base + (size_t)b * SEQ * ld;
        const bf16* qp = rowbase + qoff + h * DK; const bf16* kp = rowbase + koff + h * DK; const bf16* lap = rowbase + laoff + h * DK;
        bf16* vp = rowbase + voff + h * DV + sl * CS;
        const float gamma = 1.f - exp2f(-5.f - (float)h);
        f32x2 S[DPT / 2];
#pragma unroll
        for (int i = 0; i < DPT / 2; ++i) S[i] = (f32x2){0.f, 0.f};
        v4u rq = {0, 0, 0, 0}, rk = {0, 0, 0, 0}, rl = {0, 0, 0, 0}, rv = {0, 0, 0, 0};
#define RC_GLOAD(n_) do { \
            if (ldq) { const size_t o_ = (size_t)((n_) * TB + qt_) * ld + qd; rq = *(const v4u*)(qp + o_); rk = *(const v4u*)(kp + o_); if (ISGLA) rl = *(const v4u*)(lap + o_); } \
            if (ldv) { rv = *(const v4u*)(vp + (size_t)((n_) * TB + vt_) * ld + vc_); } } while (0)
#define RC_SWRITE(buf_) do { \
            LAS float* st_ = stage + (buf_) * STG; \
            if (ldq) { \
                LAS float* q_ = st_ + qt_ * DK + qd; LAS float* k_ = st_ + TB * DK + qt_ * DK + qd; \
                *(LAS f32x4*)q_ = (f32x4){bflo(rq.x), bfhi(rq.x), bflo(rq.y), bfhi(rq.y)}; *(LAS f32x4*)(q_ + 4) = (f32x4){bflo(rq.z), bfhi(rq.z), bflo(rq.w), bfhi(rq.w)}; \
                *(LAS f32x4*)k_ = (f32x4){bflo(rk.x), bfhi(rk.x), bflo(rk.y), bfhi(rk.y)} * kscale; *(LAS f32x4*)(k_ + 4) = (f32x4){bflo(rk.z), bfhi(rk.z), bflo(rk.w), bfhi(rk.w)} * kscale; \
                if (ISGLA) { LAS float* a_ = st_ + 2 * TB * DK + qt_ * DK + qd; \
                    *(LAS f32x4*)a_ = (f32x4){__expf(bflo(rl.x)), __expf(bfhi(rl.x)), __expf(bflo(rl.y)), __expf(bfhi(rl.y))}; \
                    *(LAS f32x4*)(a_ + 4) = (f32x4){__expf(bflo(rl.z)), __expf(bfhi(rl.z)), __expf(bflo(rl.w)), __expf(bfhi(rl.w))}; } \
            } \
            if (ldv) { LAS float* v_ = vst + (buf_) * VST + vt_ * CS + vc_; \
                *(LAS f32x4*)v_ = (f32x4){bflo(rv.x), bfhi(rv.x), bflo(rv.y), bfhi(rv.y)}; *(LAS f32x4*)(v_ + 4) = (f32x4){bflo(rv.z), bfhi(rv.z), bflo(rv.w), bfhi(rv.w)}; } } while (0)
        __syncthreads();
        RC_GLOAD(0); RC_SWRITE(0);
        __syncthreads();
        for (int n = 0; n < NB; ++n) {
            const int cur = n & 1;
            if (n + 1 < NB) RC_GLOAD(n + 1);
            const LAS float* qs = stage + cur * STG + dg * DPT; const LAS float* ks = qs + TB * DK; const LAS float* as = qs + 2 * TB * DK;
            const LAS float* vs = vst + cur * VST + c;
            LAS float* rd = red + cur * RED + dg * TB * CS + c;
#pragma unroll
            for (int t = 0; t < TB; ++t) {
                const float vv = vs[t * CS];
                f32x2 acc = {0.f, 0.f};
#pragma unroll
                for (int i = 0; i < DPT; i += 4) {
                    const f32x4 k4 = *(const LAS f32x4*)(ks + t * DK + i), q4 = *(const LAS f32x4*)(qs + t * DK + i);
                    f32x2 d0, d1;
                    if (ISGLA) { const f32x4 a4 = *(const LAS f32x4*)(as + t * DK + i); d0 = (f32x2){a4.x, a4.y}; d1 = (f32x2){a4.z, a4.w}; } else { d0 = (f32x2){gamma, gamma}; d1 = d0; }
                    S[i / 2] = S[i / 2] * d0 + (f32x2){k4.x, k4.y} * vv; acc += (f32x2){q4.x, q4.y} * S[i / 2];
                    S[i / 2 + 1] = S[i / 2 + 1] * d1 + (f32x2){k4.z, k4.w} * vv; acc += (f32x2){q4.z, q4.w} * S[i / 2 + 1];
                }
                rd[t * CS] = acc.x + acc.y;
            }
            if (n + 1 < NB) RC_SWRITE(cur ^ 1);
            __syncthreads();
#pragma unroll
            for (int rep = 0; rep < (TB * CS + 511) / 512; ++rep) {
                const int idx = tid + rep * 512;
                if (idx < TB * CS) {
                    const LAS float* rr = red + cur * RED + idx; float s = 0.f;
#pragma unroll
                    for (int g = 0; g < NDG; ++g) s += rr[g * TB * CS];
                    const int t = idx / CS, cc = idx % CS;
                    if (!F.dry) vp[(size_t)(n * TB + t) * ld + cc] = (bf16)f2bf(s);
                }
            }
        }
    }
    __syncthreads();
}

template <int DK>
__device__ __forceinline__ void chunk_a_phase(Frame& F, const bf16* base, int ld, int qoff, int koff, bf16* AT) {
    const int tid = F.tid, w = F.wave, grp = w / 3, wt = w % 3;
    if (w >= 6) return;
    const int r = tid & 31, hh = (tid >> 5) & 1;
    for (int it = F.vcu * 2 + grp; it < 32 * 64; it += F.G * 2) {
        const int bh = it >> 6, c = it & 63, b = bh >> 2, h = bh & 3;
        const int jt = wt >> 1, itl = (wt + 1) >> 1;
        const bf16* kp = base + ((size_t)b * SEQ + 64 * c + 32 * jt + r) * ld + koff + h * DK + 8 * hh;
        const bf16* qp = base + ((size_t)b * SEQ + 64 * c + 32 * itl + r) * ld + qoff + h * DK + 8 * hh;
        f32x16 a0 = {}, a1 = {};
#pragma unroll
        for (int s = 0; s < DK / 16; s += 2) { a0 = MFMA32(*(const bf16x8*)(kp + 16 * s), *(const bf16x8*)(qp + 16 * s), a0); a1 = MFMA32(*(const bf16x8*)(kp + 16 * s + 16), *(const bf16x8*)(qp + 16 * s + 16), a1); }
        const int lim = (jt == itl) ? r - 4 * hh : 1000;
        bf16* ap = AT + (size_t)it * 4096 + (32 * itl + r) * 64 + 32 * jt + 4 * hh;
#pragma unroll
        for (int a4 = 0; a4 < 4; ++a4) { float e[4];
#pragma unroll
            for (int x = 0; x < 4; ++x) e[x] = (8 * a4 + x <= lim) ? a0[4 * a4 + x] + a1[4 * a4 + x] : 0.f;
            v2u o; o.x = pk2(e[0], e[1]); o.y = pk2(e[2], e[3]); *(v2u*)(ap + 8 * a4) = o; }
    }
}
template <int DK, int DV, bool ISGLA>
__device__ __forceinline__ void chunk_phase(Frame& F, bf16* base, int ld, int qoff, int koff, int voff, const bf16* AT, const float* Wdec) {
    constexpr int C = 64, NC = SEQ / C, NS = DV / 64, NDT = DK / 32, NDTW = NDT / 4, QP = DK + 8, VP = 72, AP = 72, NQ = (C * DK / 8) / 512;
    static_assert((2 * C * QP + C * VP + C * AP) * 2 + DK * 4 + 6 * 2048 * 4 <= SCR_BYTES, "chunk phase LDS");
    LAS bf16* QL = (LAS bf16*)F.lds; LAS bf16* KL = QL + C * QP; LAS bf16* VL = KL + C * QP; LAS bf16* AL = VL + C * VP; LAS float* WL = (LAS float*)(AL + C * AP); LAS float* RED = WL + DK;
    const int tid = F.tid, w = F.wave, et = w & 1, dq = w >> 1;
    for (int it = F.vcu; it < 32 * NS; it += F.G) {
        const int bh = it / NS, sl = it % NS, b = bh >> 2, h = bh & 3;
        bf16* rowbase = base + (size_t)b * SEQ * ld;
        const bf16* qp = rowbase + qoff + h * DK; const bf16* kp = rowbase + koff + h * DK; bf16* vp = rowbase + voff + h * DV + sl * 64;
        const bf16* atp = AT + (size_t)bh * NC * 4096; const float* wdp = Wdec + ((size_t)b * NC * 4 + h) * DK;
        const float wsc = exp2f(64.f * log2f(1.f - exp2f(-5.f - (float)h)));
        f32x16 S[NDTW];
#pragma unroll
        for (int d = 0; d < NDTW; ++d) S[d] = (f32x16){};
        v4u pq[NQ], pk[NQ], pv, pa; f32x4 pw = {0.f, 0.f, 0.f, 0.f};
#define CH_PREFETCH(c_) do { int tz = tid; asm volatile("" : "+v"(tz)); \
            _Pragma("unroll") for (int u = 0; u < NQ; ++u) { const int idx = tz + 512 * u, row = idx / (DK / 8), c8 = (idx % (DK / 8)) * 8; const size_t go = (size_t)(C * (c_) + row) * ld + c8; pq[u] = *(const v4u*)(qp + go); pk[u] = *(const v4u*)(kp + go); } \
            pv = *(const v4u*)(vp + (size_t)(C * (c_) + (tz >> 3)) * ld + (tz & 7) * 8); pa = *(const v4u*)(atp + (size_t)(c_) * 4096 + tz * 8); \
            if (ISGLA && tz < DK / 4) pw = *(const f32x4*)(wdp + (size_t)(c_) * 4 * DK + 4 * tz); } while (0)
        __syncthreads();
        CH_PREFETCH(0);
        for (int c = 0; c < NC; ++c) {
            {
                int tz = tid; asm volatile("" : "+v"(tz));
#pragma unroll
                for (int u = 0; u < NQ; ++u) { const int idx = tz + 512 * u, row = idx / (DK / 8), c8 = (idx % (DK / 8)) * 8; *(LAS v4u*)(QL + row * QP + c8) = pq[u]; *(LAS v4u*)(KL + row * QP + c8) = pk[u]; }
                *(LAS v4u*)(VL + (tz >> 3) * VP + (tz & 7) * 8) = pv; *(LAS v4u*)(AL + (tz >> 3) * AP + (tz & 7) * 8) = pa;
                if (ISGLA && tz < DK / 4) *(LAS f32x4*)(WL + 4 * tz) = pw;
            }
            if (c + 1 < NC) CH_PREFETCH(c + 1);
            __syncthreads();
            {
                int tz = tid; asm volatile("" : "+v"(tz)); const int r = tz & 31, hh = (tz >> 5) & 1;
                const int trow = 8 * hh + ((tz & 15) >> 2), tcol = 16 * ((tz >> 4) & 1) + 4 * (tz & 3);
                bf16x8 vf[4];
#pragma unroll
                for (int ks = 0; ks < 4; ++ks) { const LAS bf16* p = VL + (16 * ks + trow) * VP + 32 * et + tcol;
                    const s16x4 lo = __builtin_bit_cast(s16x4, __builtin_amdgcn_ds_read_tr16_b64_v4i16((LAS s16x4*)p)), hi = __builtin_bit_cast(s16x4, __builtin_amdgcn_ds_read_tr16_b64_v4i16((LAS s16x4*)(p + 4 * VP)));
                    vf[ks] = (bf16x8){lo[0], lo[1], lo[2], lo[3], hi[0], hi[1], hi[2], hi[3]}; }
                f32x16 O[2]; O[0] = (f32x16){}; O[1] = (f32x16){};
#pragma unroll
                for (int dl = 0; dl < NDTW; ++dl)
#pragma unroll
                    for (int s2 = 0; s2 < 2; ++s2) {
                        v4u sw; sw.x = pg8::cvt_pk_bf16(S[dl][8 * s2 + 0], S[dl][8 * s2 + 1]); sw.y = pg8::cvt_pk_bf16(S[dl][8 * s2 + 2], S[dl][8 * s2 + 3]);
                        sw.z = pg8::cvt_pk_bf16(S[dl][8 * s2 + 4], S[dl][8 * s2 + 5]); sw.w = pg8::cvt_pk_bf16(S[dl][8 * s2 + 6], S[dl][8 * s2 + 7]);
                        const bf16x8 sf = __builtin_bit_cast(bf16x8, sw);
#pragma unroll
                        for (int itl = 0; itl < 2; ++itl) { const LAS bf16* qq = QL + (32 * itl + r) * QP + 32 * (dq * NDTW + dl) + 16 * s2 + 4 * hh;
                            const v2u lo = *(const LAS v2u*)qq, hi = *(const LAS v2u*)(qq + 8);
                            O[itl] = MFMA32(sf, __builtin_bit_cast(bf16x8, (v4u){lo.x, lo.y, hi.x, hi.y}), O[itl]); }
                    }
                if (dq == 0) {
#pragma unroll
                    for (int itl = 0; itl < 2; ++itl)
#pragma unroll
                        for (int ks = 0; ks < 2 * itl + 2; ++ks) { const bf16x8 af = *(const LAS bf16x8*)(AL + (32 * itl + r) * AP + 16 * ks + 8 * hh); O[itl] = MFMA32(vf[ks], af, O[itl]); }
                } else {
                    LAS float* rp = RED + (et * 3 + dq - 1) * 2048 + (tz & 63);
#pragma unroll
                    for (int itl = 0; itl < 2; ++itl)
#pragma unroll
                        for (int q = 0; q < 16; ++q) rp[(itl * 16 + q) * 64] = O[itl][q];
                }
#pragma unroll
                for (int dl = 0; dl < NDTW; ++dl) {
#pragma unroll
                    for (int ks = 0; ks < 4; ++ks) { const LAS bf16* p = KL + (16 * ks + trow) * QP + 32 * (dq * NDTW + dl) + tcol;
                        const s16x4 lo = __builtin_bit_cast(s16x4, __builtin_amdgcn_ds_read_tr16_b64_v4i16((LAS s16x4*)p)), hi = __builtin_bit_cast(s16x4, __builtin_amdgcn_ds_read_tr16_b64_v4i16((LAS s16x4*)(p + 4 * QP)));
                        S[dl] = MFMA32(((bf16x8){lo[0], lo[1], lo[2], lo[3], hi[0], hi[1], hi[2], hi[3]}), vf[ks], S[dl]); }
                    if (ISGLA) {
#pragma unroll
                        for (int a4 = 0; a4 < 4; ++a4) { const f32x4 w4 = *(const LAS f32x4*)(WL + 32 * (dq * NDTW + dl) + 8 * a4 + 4 * hh);
#pragma unroll
                            for (int x = 0; x < 4; ++x) S[dl][4 * a4 + x] *= w4[x]; }
                    } else S[dl] *= wsc;
                }
                __syncthreads();
                if (dq == 0) {
                    const LAS float* rp = RED + (et * 3) * 2048 + (tz & 63);
#pragma unroll
                    for (int itl = 0; itl < 2; ++itl) {
#pragma unroll
                        for (int q = 0; q < 16; ++q) O[itl][q] += (rp[(itl * 16 + q) * 64] + rp[2048 + (itl * 16 + q) * 64]) + rp[4096 + (itl * 16 + q) * 64];
                        if (!F.dry) { bf16* op = vp + (size_t)(C * c + 32 * itl + r) * ld + 32 * et + 4 * hh;
#pragma unroll
                            for (int a4 = 0; a4 < 4; ++a4) { v2u o; o.x = pk2(O[itl][4 * a4], O[itl][4 * a4 + 1]); o.y = pk2(O[itl][4 * a4 + 2], O[itl][4 * a4 + 3]); *(v2u*)(op + 8 * a4) = o; } }
                    }
                }
            }
        }
    }
    __syncthreads();
#undef CH_PREFETCH
}
__device__ __forceinline__ void gla_prep_phase(Frame& F, bf16* base, int ld, float* Wdec) {
    const int tid = F.tid;
    for (int it = F.vcu; it < BATCH * 64; it += F.G) {
        bf16* p = base + (size_t)it * 64 * ld + tid;
        float bsum = 0.f;
#pragma unroll 8
        for (int t = 0; t < 64; ++t) {
            bf16* rp = p + (size_t)t * ld;
            bsum += bf1(rp[3072]);
            const float eb = __expf(bsum);
            const float q = bf1(rp[0]) * eb, k = bf1(rp[512]) / eb;
            if (!F.dry) { rp[0] = (bf16)f2bf(q); rp[512] = (bf16)f2bf(k); }
        }
        Wdec[(size_t)it * 512 + tid] = __expf(bsum);
    }
}

template <int DV, bool CENTER>
__device__ __forceinline__ void hn_phase(Frame& F, bf16* base, int ld, int ooff, int goff, const float* gn) {
    constexpr int NJ = DV / 128;
    const int gw = F.vcu * NWAVES + F.wave, NGW = F.G * NWAVES, lane = F.lane, hq = lane >> 4, li = lane & 15;
    for (int m = gw; m < M; m += NGW) {
        bf16* op = base + (size_t)m * ld + ooff + hq * DV + li * 8; const bf16* gp = base + (size_t)m * ld + goff + hq * DV + li * 8;
        float o[NJ][8]; v4u gw4[NJ]; float s = 0.f;
#pragma unroll
        for (int j = 0; j < NJ; ++j) { const v4u w = *(const v4u*)(op + 128 * j); gw4[j] = *(const v4u*)(gp + 128 * j);
            o[j][0] = bflo(w.x); o[j][1] = bfhi(w.x); o[j][2] = bflo(w.y); o[j][3] = bfhi(w.y); o[j][4] = bflo(w.z); o[j][5] = bfhi(w.z); o[j][6] = bflo(w.w); o[j][7] = bfhi(w.w);
#pragma unroll
            for (int e = 0; e < 8; ++e) s += o[j][e]; }
        float mean = 0.f;
        if (CENTER) mean = grp16_sum(s) * (1.f / DV);
        float s2 = 0.f;
#pragma unroll
        for (int j = 0; j < NJ; ++j)
#pragma unroll
            for (int e = 0; e < 8; ++e) { o[j][e] -= mean; s2 += o[j][e] * o[j][e]; }
        const float rstd = rsqrtf(grp16_sum(s2) * (1.f / DV) + NORM_EPS);
#pragma unroll
        for (int j = 0; j < NJ; ++j) {
            const float* gnp = gn + hq * DV + li * 8 + 128 * j; const f32x4 g0 = *(const f32x4*)gnp, g1 = *(const f32x4*)(gnp + 4);
            const float gg[8] = {bflo(gw4[j].x), bfhi(gw4[j].x), bflo(gw4[j].y), bfhi(gw4[j].y), bflo(gw4[j].z), bfhi(gw4[j].z), bflo(gw4[j].w), bfhi(gw4[j].w)};
            float r[8];
#pragma unroll
            for (int e = 0; e < 8; ++e) r[e] = o[j][e] * rstd * (e < 4 ? g0[e & 3] : g1[e & 3]) * silu(gg[e]);
            v4u w; w.x = pk2(r[0], r[1]); w.y = pk2(r[2], r[3]); w.z = pk2(r[4], r[5]); w.w = pk2(r[6], r[7]);
            if (!F.dry) *(v4u*)(op + 128 * j) = w;
        }
    }
}

__device__ __forceinline__ void lru_conv_phase(Frame& F, const bf16* XY, bf16* XC, const float* cw, const float* cb) {
    const int gw = F.vcu * NWAVES + F.wave, NGW = F.G * NWAVES, lane = F.lane;
    for (int m = gw; m < M; m += NGW) {
        const int t = m & (SEQ - 1);
#pragma unroll
        for (int j = 0; j < 2; ++j) {
            const int ch = lane * 8 + 512 * j;
            float acc[8];
            { const f32x4 b0 = *(const f32x4*)(cb + ch), b1 = *(const f32x4*)(cb + ch + 4);
              acc[0] = b0.x; acc[1] = b0.y; acc[2] = b0.z; acc[3] = b0.w; acc[4] = b1.x; acc[5] = b1.y; acc[6] = b1.z; acc[7] = b1.w; }
#pragma unroll
            for (int tap = 0; tap < 4; ++tap) {
                if (t - 3 + tap >= 0) {
                    const v4u w = *(const v4u*)(XY + (size_t)(m - 3 + tap) * 2048 + ch);
                    const f32x4 c0 = *(const f32x4*)(cw + tap * 1024 + ch), c1 = *(const f32x4*)(cw + tap * 1024 + ch + 4);
                    acc[0] += bflo(w.x) * c0.x; acc[1] += bfhi(w.x) * c0.y; acc[2] += bflo(w.y) * c0.z; acc[3] += bfhi(w.y) * c0.w;
                    acc[4] += bflo(w.z) * c1.x; acc[5] += bfhi(w.z) * c1.y; acc[6] += bflo(w.w) * c1.z; acc[7] += bfhi(w.w) * c1.w;
                }
            }
            v4u o; o.x = pk2(acc[0], acc[1]); o.y = pk2(acc[2], acc[3]); o.z = pk2(acc[4], acc[5]); o.w = pk2(acc[6], acc[7]);
            *(v4u*)(XC + (size_t)m * 1024 + ch) = o;
        }
    }
}
template <int PASS>
__device__ __forceinline__ void lru_scan_phase(Frame& F, const bf16* GP, const bf16* XC, const bf16* XY, float* SP, float* SE, bf16* HS, const float* b_a, const float* b_x, const float* lam) {
    const int tid = F.tid, ch = 2 * tid, gcol = (ch >> 7) * 256 + (ch & 127);
    const float ba0 = b_a[ch], ba1 = b_a[ch + 1], bx0 = b_x[ch], bx1 = b_x[ch + 1];
    const float lm0 = lam[ch], lm1 = lam[ch + 1];
    const float sp0 = -8.f * (fmaxf(-lm0, 0.f) + log1pf(__expf(-fabsf(lm0)))), sp1 = -8.f * (fmaxf(-lm1, 0.f) + log1pf(__expf(-fabsf(lm1))));
    for (int it = F.vcu; it < BATCH * 64; it += F.G) {
        const int b = it >> 6, ci = it & 63; const size_t m0 = (size_t)b * SEQ + ci * 64;
        float h0 = 0.f, h1 = 0.f, s0 = 0.f, s1 = 0.f;
        if (PASS == 1) {
            for (int j = 0; j < ci; ++j) { const f32x2 p = *(const f32x2*)(SP + (size_t)(b * 64 + j) * 1024 + ch), e = *(const f32x2*)(SE + (size_t)(b * 64 + j) * 1024 + ch);
                h0 = p.x * h0 + e.x; h1 = p.y * h1 + e.y; }
        }
#pragma unroll 8
        for (int t = 0; t < 64; ++t) {
            const unsigned pa = *(const unsigned*)(GP + (m0 + t) * 2048 + gcol), px = *(const unsigned*)(GP + (m0 + t) * 2048 + gcol + 128), xc = *(const unsigned*)(XC + (m0 + t) * 1024 + ch);
            const float l0 = sp0 / (1.f + __expf(-(bflo(pa) + ba0))), l1 = sp1 / (1.f + __expf(-(bfhi(pa) + ba1)));
            const float a0 = __expf(l0), a1 = __expf(l1);
            const float u0 = sqrtf(fmaxf(1.f - a0 * a0, 0.f)) * bflo(xc) / (1.f + __expf(-(bflo(px) + bx0))), u1 = sqrtf(fmaxf(1.f - a1 * a1, 0.f)) * bfhi(xc) / (1.f + __expf(-(bfhi(px) + bx1)));
            h0 = a0 * h0 + u0; h1 = a1 * h1 + u1;
            if (PASS == 0) { s0 += l0; s1 += l1; }
            else { const unsigned y = *(const unsigned*)(XY + (m0 + t) * 2048 + 1024 + ch);
                *(unsigned*)(HS + (m0 + t) * 1024 + ch) = pk2(h0 * gelu_tanh(bflo(y)), h1 * gelu_tanh(bfhi(y))); }
        }
        if (PASS == 0) { *(f32x2*)(SP + (size_t)it * 1024 + ch) = (f32x2){__expf(s0), __expf(s1)}; *(f32x2*)(SE + (size_t)it * 1024 + ch) = (f32x2){h0, h1}; }
    }
}

__device__ __forceinline__ void nsa_compress_phase(Frame& F, const bf16* KC, const bf16* VC, const bf16* W1K, const bf16* W1V, const bf16* W2K, const bf16* W2V, const float* PEB, bf16* KCMP, bf16* VCMPT) {
    LAS float* part = (LAS float*)F.lds;
    LAS bf16* hid = (LAS bf16*)(F.lds + 32768);
    const int tid = F.tid, lane = F.lane, w = F.wave, r = lane & 31, hh = lane >> 5;
    for (int it = F.vcu; it < 256; it += F.G) {
        const int kv = it >> 7, bg = (it >> 3) & 15, ntile = it & 7;
        const bf16* A = (kv ? VC : KC) + (size_t)bg * SEQ * 64 + (size_t)(32 * ntile) * 1024;
        const bf16* W1 = kv ? W1V : W1K; const bf16* W2 = kv ? W2V : W2K; const float* bias = PEB + kv * 128;
        const int ct = w & 3, kh = w >> 2;
        f32x16 acc = {};
        const bf16* ap = A + (size_t)r * 1024 + 1024 * kh + 8 * hh; const bf16* bp = W1 + (size_t)(32 * ct + r) * 2048 + 1024 * kh + 8 * hh;
#pragma unroll 8
        for (int s = 0; s < 64; ++s) { const bf16x8 a = *(const bf16x8*)(ap + 16 * s), bb = *(const bf16x8*)(bp + 16 * s); acc = MFMA32(a, bb, acc); }
        __syncthreads();
#pragma unroll
        for (int q = 0; q < 16; ++q) { const int row = (q & 3) + 8 * (q >> 2) + 4 * hh; part[kh * 4096 + row * 128 + 32 * ct + r] = acc[q]; }
        __syncthreads();
        { const int row = tid >> 4, col = (tid & 15) * 8; unsigned pk[4];
#pragma unroll
          for (int e = 0; e < 8; e += 2) { const float a0 = part[row * 128 + col + e] + part[4096 + row * 128 + col + e] + bias[col + e];
              const float a1 = part[row * 128 + col + e + 1] + part[4096 + row * 128 + col + e + 1] + bias[col + e + 1];
              pk[e >> 1] = pk2(gelu_tanh(a0), gelu_tanh(a1)); }
          *(LAS v4u*)(hid + row * 136 + col) = (v4u){pk[0], pk[1], pk[2], pk[3]}; }
        __syncthreads();
        if (w < 2) {
            f32x16 a2 = {};
#pragma unroll
            for (int s = 0; s < 8; ++s) { const bf16x8 a = *(const LAS bf16x8*)(hid + r * 136 + 16 * s + 8 * hh), bb = *(const bf16x8*)(W2 + (size_t)(32 * w + r) * 128 + 16 * s + 8 * hh); a2 = MFMA32(a, bb, a2); }
            const int d = 32 * w + r;
            if (kv == 0) {
#pragma unroll
                for (int q = 0; q < 16; ++q) { const int n = 32 * ntile + (q & 3) + 8 * (q >> 2) + 4 * hh; KCMP[((size_t)bg * 256 + n) * 64 + d] = (bf16)(n == 255 ? 0u : f2bf(a2[q])); }
            } else {
#pragma unroll
                for (int q4 = 0; q4 < 4; ++q4) { const int n = 32 * ntile + 8 * q4 + 4 * hh; float v[4];
#pragma unroll
                    for (int e = 0; e < 4; ++e) v[e] = (n + e == 255) ? 0.f : a2[4 * q4 + e];
                    v2u o; o.x = pk2(v[0], v[1]); o.y = pk2(v[2], v[3]); *(v2u*)(VCMPT + ((size_t)bg * 64 + d) * 256 + n) = o; }
            }
        }
    }
    __syncthreads();
}

constexpr int KP = 72;
__device__ __forceinline__ void qk_tile(const LAS bf16* KT, const bf16x8 (&Qf)[4], f32x16& S0, f32x16& S1, int r, int hh) {
    S0 = (f32x16){}; S1 = (f32x16){};
#pragma unroll
    for (int s = 0; s < 4; ++s) {
        const bf16x8 a0 = *(const LAS bf16x8*)(KT + r * KP + 16 * s + 8 * hh), a1 = *(const LAS bf16x8*)(KT + (32 + r) * KP + 16 * s + 8 * hh);
        S0 = MFMA32(a0, Qf[s], S0); S1 = MFMA32(a1, Qf[s], S1);
    }
}
__device__ __forceinline__ void attn_tile(const LAS bf16* KT, const LAS bf16* VT, const bf16x8 (&Qf)[4], f32x16 (&O)[2], float& mrun, float& lrun,
                                          float biasl, float bstep, int limhi, int limlo, int r, int hh) {
    f32x16 S0, S1; qk_tile(KT, Qf, S0, S1, r, hh);
    float mx = -INFINITY;
#pragma unroll
    for (int q = 0; q < 16; ++q) { const int c = (q & 3) + 8 * (q >> 2);
        S0[q] = (c <= limhi && c > limlo) ? S0[q] + __builtin_fmaf(bstep, (float)c, biasl) : -INFINITY;
        S1[q] = (c + 32 <= limhi && c + 32 > limlo) ? S1[q] + __builtin_fmaf(bstep, (float)(c + 32), biasl) : -INFINITY;
        mx = fmaxf(mx, fmaxf(S0[q], S1[q])); }
    mx = fmaxf(mx, __shfl_xor(mx, 32));
    const float mnew = fmaxf(mrun, mx), alpha = __builtin_amdgcn_exp2f(mrun - mnew);
    float rs = 0.f;
#pragma unroll
    for (int q = 0; q < 16; ++q) { S0[q] = __builtin_amdgcn_exp2f(S0[q] - mnew); S1[q] = __builtin_amdgcn_exp2f(S1[q] - mnew); rs += S0[q] + S1[q]; }
    rs += __shfl_xor(rs, 32);
    lrun = lrun * alpha + rs; mrun = mnew;
#pragma unroll
    for (int dt = 0; dt < 2; ++dt)
#pragma unroll
        for (int q = 0; q < 16; ++q) O[dt][q] *= alpha;
    bf16x8 Pf[2][2];
#pragma unroll
    for (int s = 0; s < 2; ++s) {
        v4u w0, w1;
        w0.x = pg8::cvt_pk_bf16(S0[8 * s + 0], S0[8 * s + 1]); w0.y = pg8::cvt_pk_bf16(S0[8 * s + 2], S0[8 * s + 3]); w0.z = pg8::cvt_pk_bf16(S0[8 * s + 4], S0[8 * s + 5]); w0.w = pg8::cvt_pk_bf16(S0[8 * s + 6], S0[8 * s + 7]);
        w1.x = pg8::cvt_pk_bf16(S1[8 * s + 0], S1[8 * s + 1]); w1.y = pg8::cvt_pk_bf16(S1[8 * s + 2], S1[8 * s + 3]); w1.z = pg8::cvt_pk_bf16(S1[8 * s + 4], S1[8 * s + 5]); w1.w = pg8::cvt_pk_bf16(S1[8 * s + 6], S1[8 * s + 7]);
        Pf[0][s] = __builtin_bit_cast(bf16x8, w0); Pf[1][s] = __builtin_bit_cast(bf16x8, w1);
    }
#pragma unroll
    for (int dt = 0; dt < 2; ++dt)
#pragma unroll
        for (int kt = 0; kt < 2; ++kt)
#pragma unroll
            for (int s = 0; s < 2; ++s) {
                const LAS bf16* vp = VT + (32 * dt + r) * KP + 32 * kt + 16 * s + 4 * hh;
                const v2u lo = *(const LAS v2u*)vp, hi = *(const LAS v2u*)(vp + 8);
                const bf16x8 a = __builtin_bit_cast(bf16x8, (v4u){lo.x, lo.y, hi.x, hi.y});
                O[dt] = MFMA32(a, Pf[kt][s], O[dt]);
            }
}
__device__ __forceinline__ void imp_tile(const LAS bf16* KT, const bf16x8 (&Qf)[4], float mfin, float linv, float biasl, float bstep, int limhi, int n0t, LAS unsigned* IMP, int r, int hh) {
    f32x16 S0, S1; qk_tile(KT, Qf, S0, S1, r, hh);
#pragma unroll
    for (int q = 0; q < 16; ++q) { const int c = (q & 3) + 8 * (q >> 2);
        S0[q] = (c <= limhi) ? __builtin_amdgcn_exp2f(S0[q] + __builtin_fmaf(bstep, (float)c, biasl) - mfin) * linv : 0.f;
        S1[q] = (c + 32 <= limhi) ? __builtin_amdgcn_exp2f(S1[q] + __builtin_fmaf(bstep, (float)(c + 32), biasl) - mfin) * linv : 0.f; }
    LAS unsigned* row = IMP + r * 65;
#pragma unroll
    for (int kt = 0; kt < 2; ++kt)
#pragma unroll
        for (int a = 0; a < 4; ++a) {
            const float e0 = kt ? S1[4 * a] : S0[4 * a], e1 = kt ? S1[4 * a + 1] : S0[4 * a + 1], e2 = kt ? S1[4 * a + 2] : S0[4 * a + 2], e3 = kt ? S1[4 * a + 3] : S0[4 * a + 3];
            const int j = (n0t + 32 * kt + 8 * a + 4 * hh) >> 2;
            const unsigned gq = (unsigned)((e0 + e1 + e2 + e3) * 8388608.f + 0.5f), lq = (unsigned)(e3 * 8388608.f + 0.5f);
            if (gq) __hip_atomic_fetch_add((unsigned*)(row + j), gq, __ATOMIC_RELAXED, __HIP_MEMORY_SCOPE_WORKGROUP);
            if (lq && j + 1 < 64) __hip_atomic_fetch_add((unsigned*)(row + j + 1), lq, __ATOMIC_RELAXED, __HIP_MEMORY_SCOPE_WORKGROUP);
        }
}
__device__ __forceinline__ void load_kv_tile(LAS bf16* KT, LAS bf16* VT, const bf16* ksrc  , const bf16* vsrc  , int vstride, int tid, bool with_v) {
    const int row = tid >> 3, ch = (tid & 7) * 8;
    const v4u k = *(const v4u*)(ksrc + row * 64 + ch);
    v4u v = {0, 0, 0, 0}; if (with_v) v = *(const v4u*)(vsrc + (size_t)row * vstride + ch);
    *(LAS v4u*)(KT + row * KP + ch) = k;
    if (with_v) *(LAS v4u*)(VT + row * KP + ch) = v;
}
#define TZ_LANE int tz = tid; asm volatile("" : "+v"(tz)); const int r = tz & 31, hh = (tz >> 5) & 1;
__device__ __forceinline__ void nsa_attn_phase(Frame& F, const bf16* Q, const bf16* KCMP, const bf16* VCMPT, const bf16* KS, const bf16* VST, const bf16* KW, const bf16* VWT, const float* GATES, bf16* OB) {
    LAS bf16* KT = (LAS bf16*)F.lds; LAS bf16* VT = KT + 64 * KP;
    LAS unsigned* IMP = (LAS unsigned*)(F.lds + 2 * 64 * KP * 2);
    LAS unsigned char* SELB = (LAS unsigned char*)(IMP + 32 * 65);
    const int tid = F.tid, w = F.wave;
    for (int it = F.vcu; it < 2048; it += F.G) {
        const int k8 = it >> 8, v = it & 255, slot = k8 >> 1, half = k8 & 1, bg = v >> 4, rr = v & 15;
        const int i = slot == 0 ? rr : (slot == 1 ? 31 - rr : (slot == 2 ? 32 + rr : 63 - rr));
        const int b = bg >> 1, g = bg & 1, h = g * 8 + w, t0 = 64 * i, q0 = 32 * half;
        const float slope2 = exp2f(-0.5f * (float)(h + 1)) * LOG2E;
        bf16x8 Qf[4]; float gate[3];
        { TZ_LANE
          const size_t row = (size_t)b * SEQ + t0 + q0 + r;
#pragma unroll
          for (int s = 0; s < 4; ++s) Qf[s] = *(const bf16x8*)(Q + row * 1024 + h * 64 + 16 * s + 8 * hh);
#pragma unroll
          for (int br = 0; br < 3; ++br) gate[br] = GATES[row * 48 + br * 16 + h]; }
        f32x16 O[2]; O[0] = (f32x16){}; O[1] = (f32x16){};
        unsigned OUTP[2][8];
#define OUT_ACC(sc_, first_) do { _Pragma("unroll") for (int dt_ = 0; dt_ < 2; ++dt_) { _Pragma("unroll") for (int e_ = 0; e_ < 8; ++e_) { const unsigned w_ = (first_) ? 0u : OUTP[dt_][e_]; \
            OUTP[dt_][e_] = pk2(bflo(w_) + O[dt_][2 * e_] * (sc_), bfhi(w_) + O[dt_][2 * e_ + 1] * (sc_)); } O[dt_] = (f32x16){}; } } while (0)
        float mrun = -1e30f, lrun = 0.f;
        __syncthreads();
        for (int idx = tid; idx < 32 * 65; idx += 512) IMP[idx] = 0u;
        const int ncmp = (4 * i + 3) < 255 ? (4 * i + 3) : 255, ntile = (ncmp + 63) >> 6;
        const bf16* kcb = KCMP + (size_t)bg * 256 * 64; const bf16* vcb = VCMPT + (size_t)bg * 64 * 256;
        for (int tl = 0; tl < ntile; ++tl) {
            TZ_LANE
            __syncthreads();
            load_kv_tile(KT, VT, kcb + (size_t)tl * 64 * 64, vcb + tl * 64, 256, tz, true);
            __syncthreads();
            const int n0t = 64 * tl, a1 = ((t0 + q0 + r - 31) >> 4) - n0t - 4 * hh, a2 = 254 - n0t - 4 * hh;
            attn_tile(KT, VT, Qf, O, mrun, lrun, slope2 * (float)(16 * n0t + 31 - t0) + slope2 * 64.f * (float)hh, slope2 * 16.f, a1 < a2 ? a1 : a2, -1000, r, hh);
        }
        const float mfin = mrun, linv = 1.f / fmaxf(lrun, 1e-30f);
        OUT_ACC(linv * gate[0], true);
        mrun = -1e30f; lrun = 0.f;
        for (int tl = 0; tl < ntile; ++tl) {
            TZ_LANE
            __syncthreads();
            load_kv_tile(KT, VT, kcb + (size_t)tl * 64 * 64, vcb, 256, tz, false);
            __syncthreads();
            const int n0t = 64 * tl, a1 = ((t0 + q0 + r - 31) >> 4) - n0t - 4 * hh, a2 = 254 - n0t - 4 * hh;
            imp_tile(KT, Qf, mfin, linv, slope2 * (float)(16 * n0t + 31 - t0) + slope2 * 64.f * (float)hh, slope2 * 16.f, a1 < a2 ? a1 : a2, n0t, IMP, r, hh);
        }
        __syncthreads();
        {
            const int q = (tid >> 3) & 31, oct = tid & 7;
            unsigned mykey[8];
#pragma unroll
            for (int jj = 0; jj < 8; ++jj) { const int j = oct * 8 + jj; unsigned vv = IMP[q * 65 + j]; vv = vv > 0x3fffffeu ? 0x3fffffeu : vv;
                const bool forced = (j == 0) || (j == i) || (j == i - 1);
                mykey[jj] = (j <= i) ? (((forced ? 0x3ffffffu : vv) << 6) | (unsigned)(63 - j)) : 0u; }
            __syncthreads();
            if (tid < 256) {
#pragma unroll
                for (int jj = 0; jj < 8; ++jj) IMP[q * 65 + oct * 8 + jj] = mykey[jj]; }
            __syncthreads();
            unsigned rank[8] = {0, 0, 0, 0, 0, 0, 0, 0};
            for (int j2 = 0; j2 < 64; ++j2) { const unsigned kk = IMP[q * 65 + j2];
#pragma unroll
                for (int jj = 0; jj < 8; ++jj) rank[jj] += (kk > mykey[jj]) ? 1u : 0u; }
            unsigned byte = 0;
#pragma unroll
            for (int jj = 0; jj < 8; ++jj) byte |= ((oct * 8 + jj <= i) && rank[jj] < 16u) ? (1u << jj) : 0u;
            if (tid < 256) SELB[q * 8 + oct] = (unsigned char)byte;
        }
        __syncthreads();
        unsigned long long selm, uni;
        { TZ_LANE
          selm = *(const LAS unsigned long long*)(SELB + 8 * r);
          unsigned ulo = (unsigned)selm, uhi = (unsigned)(selm >> 32);
#pragma unroll
          for (int o = 1; o < 32; o <<= 1) { ulo |= __shfl_xor(ulo, o); uhi |= __shfl_xor(uhi, o); }
          uni = ((unsigned long long)(unsigned)__builtin_amdgcn_readfirstlane(uhi) << 32) | (unsigned)__builtin_amdgcn_readfirstlane(ulo); }
        const bf16* ksb = KS + (size_t)bg * SEQ * 64; const bf16* vsb = VST + (size_t)bg * 64 * SEQ;
        for (int j = 0; j <= i; ++j) {
            if (!((uni >> j) & 1ull)) continue;
            TZ_LANE
            __syncthreads();
            load_kv_tile(KT, VT, ksb + (size_t)j * 64 * 64, vsb + j * 64, SEQ, tz, true);
            __syncthreads();
            const int lh = ((selm >> j) & 1ull) ? (j == i ? q0 + r - 4 * hh : 1000) : -1000;
            attn_tile(KT, VT, Qf, O, mrun, lrun, slope2 * (float)(64 * j - t0) + slope2 * 4.f * (float)hh, slope2, lh, -1000, r, hh);
        }
        OUT_ACC(gate[1] / fmaxf(lrun, 1e-30f), false);
        mrun = -1e30f; lrun = 0.f;
        const bf16* kwb = KW + (size_t)bg * SEQ * 64; const bf16* vwb = VWT + (size_t)bg * 64 * SEQ;
        for (int j = (i > 8 ? i - 8 : 0); j <= i; ++j) {
            TZ_LANE
            __syncthreads();
            load_kv_tile(KT, VT, kwb + (size_t)j * 64 * 64, vwb + j * 64, SEQ, tz, true);
            __syncthreads();
            const int lh = (j == i) ? q0 + r - 4 * hh : 1000, ll = (j == i - 8) ? q0 + r - 4 * hh : -1000;
            attn_tile(KT, VT, Qf, O, mrun, lrun, slope2 * (float)(64 * j - t0) + slope2 * 4.f * (float)hh, slope2, lh, ll, r, hh);
        }
        OUT_ACC(gate[2] / fmaxf(lrun, 1e-30f), false);
        { TZ_LANE
          bf16* op = OB + ((size_t)b * SEQ + t0 + q0 + r) * 1024 + h * 64;
#pragma unroll
          for (int dt = 0; dt < 2; ++dt)
#pragma unroll
              for (int q4 = 0; q4 < 4; ++q4) { v2u o; o.x = OUTP[dt][2 * q4]; o.y = OUTP[dt][2 * q4 + 1]; *(v2u*)(op + 32 * dt + 8 * q4 + 4 * hh) = o; } }
    }
    __syncthreads();
#undef OUT_ACC
}

struct Args { const float* in[32]; float* out; unsigned char* ws; int ph_lo, ph_hi, dry, pad; };
constexpr int N_PHASES = 38;

__global__ void __launch_bounds__(NWAVES * 64, 2) trunk_fwd(Args args) {
    extern __shared__ __attribute__((aligned(16))) unsigned char lds[];
    Frame F;
    F.lds = (LAS unsigned char*)lds;
    F.tid = threadIdx.x; F.lane = F.tid & 63; F.wave = __builtin_amdgcn_readfirstlane(F.tid >> 6);
    F.G = gridDim.x; { const int bx = blockIdx.x; F.vcu = (F.G % 8 == 0) ? (bx % 8) * (F.G / 8) + bx / 8 : bx; }
    F.ws = args.ws; F.dry = args.dry;
    unsigned char* ws = args.ws;
    volatile LAS unsigned* MISC = (volatile LAS unsigned*)(F.lds + LDSCTL_OFF);
    for (int u = F.tid; u < (LDS_BYTES - LDSCTL_OFF) / 4; u += NWAVES * 64) ((LAS unsigned*)(F.lds + LDSCTL_OFF))[u] = 0u;
    __syncthreads();
    XcdBarrier bar = xcd_barrier_post((unsigned*)(ws + WS_CTL) + CW_BAR, MISC + 8);

    const int lo = args.ph_lo, hi = args.ph_hi;
#ifndef PHMASK
#define PHMASK 0xFFFFFFFFFFFFFFFFull
#endif
#define INR(k) ((((PHMASK) >> (k)) & 1ull) && lo <= (k) && (k) < hi)
#define IN(k) (INR(k) && frame_refresh(F))
#define SEAM(k) do { if (INR(k) && INR((k) + 1)) xcd_barrier(bar); } while (0)
    const float* const* in = args.in;
    float* xout = args.out;
    bf16* Hb = (bf16*)(ws + WS_H); bf16* BIG = (bf16*)(ws + WS_BIG);
    bf16* Yb = (bf16*)args.out; bf16* Ylast = (bf16*)(ws + WS_BIG + 256 * MiB); float* RS = (float*)(ws + SM_RS);
    bf16* Wi = (bf16*)(ws + WS_WIN); bf16* Wo = (bf16*)(ws + WS_WOUT); bf16* Wu = (bf16*)(ws + WS_WUP); bf16* Wd = (bf16*)(ws + WS_WDN);
    LAS unsigned char* ring = F.lds + RING_OFF;

#define CONV_MLP(L, base) do { conv_w(F, base, in[5] + (size_t)(L) * D * FF, D, FF, 0, FF, FF, Wu, D, 0, 1.f, in[3] + (L) * D); conv_w(F, base, in[6] + (size_t)(L) * FF * D, FF, D, 0, D, D, Wd, FF, 0, 1.f); } while (0)
#define GEMM_PHASE(EPI, Aptr, LDA, Bptr, LDB, NN, KK, APN, E) do { pg8::Gemm g{(const pg8::bf16_t*)(Aptr), (const pg8::bf16_t*)(Bptr), M, (NN), (KK), (LDA), (LDB), (size_t)(APN)}; \
        pg8::StaticOrder S; S.init(M, (NN), F.G, (int)blockIdx.x); pg8::gemm_phase<EPI, pg8::StaticOrder, true, true>(ring, g, S, E); } while (0)
#define MLP_PHASES(P0, L, YDST) \
    if (IN(P0)) { pg8::EpiStore<1> E{BIG, FF, RS}; GEMM_PHASE(pg8::EpiStore<1>, Hb, D, Wu, D, FF, D, 0, E); } SEAM(P0); \
    if (IN((P0) + 1)) { pg8::EpiStore<0> E{YDST, D, nullptr}; GEMM_PHASE(pg8::EpiStore<0>, BIG, FF, Wd, FF, D, FF, 0, E); } SEAM((P0) + 1);

    if (IN(0)) {
        int base = 0;
        conv_w(F, base, in[7], D, 6144, 0, 6144, 6144, Wi, D, 0, 1.f, in[1]);
        conv_w(F, base, in[9], 2048, D, 0, D, D, Wo, 2048, 0, 1.f);
        CONV_MLP(0, base);
        norm_phase<0>(F, in[0], Hb, nullptr, nullptr, RS, nullptr);
    }
    SEAM(0);
    if (IN(1)) { pg8::EpiRet E{BIG, 6144, RS}; GEMM_PHASE(pg8::EpiRet, Hb, D, Wi, D, 6144, D, 0, E); }
    SEAM(1);
    if (IN(2)) chunk_a_phase<256>(F, BIG, 6144, 0, 1024, (bf16*)(ws + SM_AT));
    SEAM(2);
    if (IN(3)) chunk_phase<256, 512, false>(F, BIG, 6144, 0, 1024, 2048, (const bf16*)(ws + SM_AT), nullptr);
    SEAM(3);
    if (IN(4)) hn_phase<512, true>(F, BIG, 6144, 2048, 4096, in[8]);
    SEAM(4);
    if (IN(5)) { pg8::EpiStore<0> E{Yb, D, nullptr}; GEMM_PHASE(pg8::EpiStore<0>, BIG + 2048, 6144, Wo, 2048, D, 2048, 0, E); }
    SEAM(5);
    if (IN(6)) norm_phase<1>(F, nullptr, Hb, Yb, in[2], RS, nullptr);
    SEAM(6);
    MLP_PHASES(7, 0, Yb)
    if (IN(9)) {
        norm_phase<1>(F, nullptr, Hb, Yb, in[4], RS, nullptr);
        int base = 0;
        conv_w(F, base, in[10], D, 3088, 0, 512, 3088, Wi, D, 0, 0.08838834764831845f, in[1] + D);
        conv_w(F, base, in[10], D, 3088, 512, 2560, 3088, Wi, D, 512, 1.f, in[1] + D);
        {
            const int gw = F.vcu * NWAVES + F.wave, NGW = F.G * NWAVES;
            for (int itx = gw; itx < 16 * 64; itx += NGW) {
                const int kb = itx >> 6, cb = itx & 63, k = kb * 64 + F.lane;
                const float gk = in[1][D + k];
                float wv[16];
#pragma unroll
                for (int r4 = 0; r4 < 4; ++r4) { const f32x4 t4 = *(const f32x4*)(in[10] + (size_t)k * 3088 + 3072 + 4 * r4); wv[4 * r4] = t4.x * gk; wv[4 * r4 + 1] = t4.y * gk; wv[4 * r4 + 2] = t4.z * gk; wv[4 * r4 + 3] = t4.w * gk; }
#pragma unroll
                for (int c = cb * 8; c < cb * 8 + 8; ++c) { float sacc = 0.f;
#pragma unroll
                    for (int r = 0; r < 16; ++r) sacc += wv[r] * in[11][r * 512 + c];
                    Wi[(size_t)(3072 + c) * D + k] = (bf16)f2bf(sacc); }
            }
        }
        conv_w(F, base, in[14], D, D, 0, D, D, Wo, D, 0, 1.f);
        CONV_MLP(1, base);
    }
    SEAM(9);
    if (IN(10)) { pg8::EpiGla E{BIG, 3584, in[12], RS}; GEMM_PHASE(pg8::EpiGla, Hb, D, Wi, D, 3584, D, 0, E); }
    SEAM(10);
    if (IN(11)) gla_prep_phase(F, BIG, 3584, (float*)(ws + SM_GLAW));
    SEAM(11);
    if (IN(12)) chunk_a_phase<128>(F, BIG, 3584, 0, 512, (bf16*)(ws + SM_AT));
    SEAM(12);
    if (IN(13)) chunk_phase<128, 256, true>(F, BIG, 3584, 0, 512, 1024, (const bf16*)(ws + SM_AT), (const float*)(ws + SM_GLAW));
    SEAM(13);
    if (IN(14)) hn_phase<256, false>(F, BIG, 3584, 1024, 2048, in[13]);
    SEAM(14);
    if (IN(15)) { pg8::EpiStore<0> E{Yb, D, nullptr}; GEMM_PHASE(pg8::EpiStore<0>, BIG + 1024, 3584, Wo, D, D, D, 0, E); }
    SEAM(15);
    if (IN(16)) norm_phase<1>(F, nullptr, Hb, Yb, in[2] + D, RS, nullptr);
    SEAM(16);
    MLP_PHASES(17, 1, Yb)
    if (IN(19)) {
        norm_phase<1>(F, nullptr, Hb, Yb, in[4] + D, RS, nullptr);
        int base = 0;
        conv_w(F, base, in[15], D, 2048, 0, 2048, 2048, Wi, D, 0, 1.f, in[1] + 2 * D);
        conv_w(F, base, in[23], D, D, 0, D, D, Wo, D, 0, 1.f);
        bf16* LW = (bf16*)(ws + SM_LRUW);
        for (int n = 0; n < 8; ++n) { conv_w(F, base, in[18] + n * 16384, 128, 128, 0, 128, 128, LW + n * 32768, 128, 0, 1.f); conv_w(F, base, in[20] + n * 16384, 128, 128, 0, 128, 128, LW + n * 32768, 128, 128, 1.f); }
        CONV_MLP(2, base);
    }
    SEAM(19);
    if (IN(20)) { pg8::EpiStore<0> E{(bf16*)(ws + LRU_XY), 2048, RS}; GEMM_PHASE(pg8::EpiStore<0>, Hb, D, Wi, D, 2048, D, 0, E); }
    SEAM(20);
    if (IN(21)) lru_conv_phase(F, (const bf16*)(ws + LRU_XY), (bf16*)(ws + LRU_XC), in[16], in[17]);
    SEAM(21);
    if (IN(22)) { pg8::EpiStore<0> E{(bf16*)(ws + LRU_GP), 2048, nullptr}; GEMM_PHASE(pg8::EpiStore<0>, ws + LRU_XC, D, ws + SM_LRUW, 128, 2048, 128, 256, E); }
    SEAM(22);
    if (IN(23)) lru_scan_phase<0>(F, (const bf16*)(ws + LRU_GP), (const bf16*)(ws + LRU_XC), (const bf16*)(ws + LRU_XY), (float*)(ws + SM_SCANP), (float*)(ws + SM_SCANE), (bf16*)(ws + LRU_HS), in[19], in[21], in[22]);
    SEAM(23);
    if (IN(24)) lru_scan_phase<1>(F, (const bf16*)(ws + LRU_GP), (const bf16*)(ws + LRU_XC), (const bf16*)(ws + LRU_XY), (float*)(ws + SM_SCANP), (float*)(ws + SM_SCANE), (bf16*)(ws + LRU_HS), in[19], in[21], in[22]);
    SEAM(24);
    if (IN(25)) { pg8::EpiStore<0> E{Yb, D, nullptr}; GEMM_PHASE(pg8::EpiStore<0>, ws + LRU_HS, D, Wo, D, D, D, 0, E); }
    SEAM(25);
    if (IN(26)) norm_phase<1>(F, nullptr, Hb, Yb, in[2] + 2 * D, RS, nullptr);
    SEAM(26);
    MLP_PHASES(27, 2, Yb)
    if (IN(29)) {
        norm_phase<1>(F, nullptr, Hb, Yb, in[4] + 2 * D, RS, nullptr);
        int base = 0;
        conv_w(F, base, in[24], D, 1840, 0, 1024, 1840, Wi, D, 0, 0.125f * LOG2E, in[1] + 3 * D);
        conv_w(F, base, in[24], D, 1840, 1024, 1024, 1840, Wi, D, 1024, 1.f, in[1] + 3 * D);
        conv_w(F, base, in[31], D, D, 0, D, D, Wo, D, 0, 1.f);
        conv_w(F, base, in[26], 2048, 128, 0, 128, 128, (bf16*)(ws + SM_W1K), 2048, 0, 1.f);
        conv_w(F, base, in[29], 2048, 128, 0, 128, 128, (bf16*)(ws + SM_W1V), 2048, 0, 1.f);
        conv_w(F, base, in[27], 128, 64, 0, 64, 64, (bf16*)(ws + SM_W2K), 128, 0, 1.f);
        conv_w(F, base, in[30], 128, 64, 0, 64, 64, (bf16*)(ws + SM_W2V), 128, 0, 1.f);
        CONV_MLP(3, base);
        for (int itx = F.vcu; itx < 4; itx += F.G) {
            const int kv = itx >> 1, c = (itx & 1) * 64 + F.lane;
            const float* pe = kv ? in[28] : in[25]; const float* w1 = kv ? in[29] : in[26];
            float s = 0.f;
            for (int i2 = F.wave * 256; i2 < F.wave * 256 + 256; ++i2) s += pe[i2] * w1[(size_t)i2 * 128 + c];
            LAS float* red = (LAS float*)(F.lds + 8 * 8704);
            __syncthreads();
            red[F.wave * 64 + F.lane] = s;
            __syncthreads();
            if (F.wave == 0) { float tsum = 0.f;
#pragma unroll
                for (int w2 = 0; w2 < 8; ++w2) tsum += red[w2 * 64 + F.lane];
                ((float*)(ws + SM_PEB))[kv * 128 + c] = tsum; }
        }
    }
    SEAM(29);
    if (IN(30)) { pg8::EpiNsa E{(bf16*)(ws + NSA_Q), (bf16*)(ws + NSA_KC), (bf16*)(ws + NSA_VC), (bf16*)(ws + NSA_KS), (bf16*)(ws + NSA_VST), (bf16*)(ws + NSA_KW), (bf16*)(ws + NSA_VWT), (float*)(ws + SM_GATES), RS};
        GEMM_PHASE(pg8::EpiNsa, Hb, D, Wi, D, 2048, D, 0, E); }
    SEAM(30);
    if (IN(31)) nsa_compress_phase(F, (const bf16*)(ws + NSA_KC), (const bf16*)(ws + NSA_VC), (const bf16*)(ws + SM_W1K), (const bf16*)(ws + SM_W1V), (const bf16*)(ws + SM_W2K), (const bf16*)(ws + SM_W2V),
                                   (const float*)(ws + SM_PEB), (bf16*)(ws + SM_KCMP), (bf16*)(ws + SM_VCMPT));
    SEAM(31);
    if (IN(32)) nsa_attn_phase(F, (const bf16*)(ws + NSA_Q), (const bf16*)(ws + SM_KCMP), (const bf16*)(ws + SM_VCMPT), (const bf16*)(ws + NSA_KS), (const bf16*)(ws + NSA_VST), (const bf16*)(ws + NSA_KW), (const bf16*)(ws + NSA_VWT),
                               (const float*)(ws + SM_GATES), (bf16*)(ws + NSA_O));
    SEAM(32);
    if (IN(33)) { pg8::EpiStore<0> E{Yb, D, nullptr}; GEMM_PHASE(pg8::EpiStore<0>, ws + NSA_O, D, Wo, D, D, D, 0, E); }
    SEAM(33);
    if (IN(34)) norm_phase<1>(F, nullptr, Hb, Yb, in[2] + 3 * D, RS, nullptr);
    SEAM(34);
    MLP_PHASES(35, 3, Ylast)
    if (IN(37)) norm_phase<2>(F, nullptr, Hb, Ylast, in[4] + 3 * D, nullptr, xout);
#undef IN
#undef SEAM
}

#ifndef MK_PER_PHASE
#define MK_PER_PHASE 0
#endif
extern "C" void kernel_launch(void* const* d_in, const int* in_sizes, int n_in, void* d_out, int out_size, void* d_ws, size_t ws_size, hipStream_t stream) {
    static int grid = 0;
    if (grid == 0) {
        if (n_in != 32 || in_sizes[0] != M * D || out_size != M * D || ws_size < WS_END) { fprintf(stderr, "kernel_launch: unexpected shapes / workspace (n_in %d, ws %zu); nothing launched\n", n_in, ws_size); grid = -1; return; }
        int dev = 0, cus = 0, per_cu = 0;
        if (hipGetDevice(&dev) != hipSuccess || hipDeviceGetAttribute(&cus, hipDeviceAttributeMultiprocessorCount, dev) != hipSuccess) { grid = -1; return; }
        if (hipFuncSetAttribute((const void*)trunk_fwd, hipFuncAttributeMaxDynamicSharedMemorySize, LDS_BYTES) != hipSuccess) { fprintf(stderr, "kernel_launch: hipFuncSetAttribute failed\n"); grid = -1; return; }
        if (hipOccupancyMaxActiveBlocksPerMultiprocessor(&per_cu, (const void*)trunk_fwd, NWAVES * 64, LDS_BYTES) != hipSuccess || per_cu < 1)
            fprintf(stderr, "kernel_launch: note: occupancy query reports %d workgroups per CU\n", per_cu);
        (void)hipGetLastError();
        grid = cus;
    }
    if (grid < 0) return;
    if (hipMemsetAsync((char*)d_ws + WS_CTL, 0, CTL_ZERO_BYTES, stream) != hipSuccess) return;
    Args a{};
    for (int i = 0; i < 32; ++i) a.in[i] = (const float*)d_in[i];
    a.out = (float*)d_out; a.ws = (unsigned char*)d_ws;
#if MK_PER_PHASE
    for (int p = 0; p < N_PHASES; ++p) { a.ph_lo = p; a.ph_hi = p + 1; hipLaunchKernelGGL(trunk_fwd, dim3(grid), dim3(NWAVES * 64), LDS_BYTES, stream, a); }
#else
    a.ph_lo = 0; a.ph_hi = N_PHASES;
    hipLaunchKernelGGL(trunk_fwd, dim3(grid), dim3(NWAVES * 64), LDS_BYTES, stream, a);
#endif
#ifdef PROBE_PHASES
    { const int pp[] = {PROBE_PHASES}; a.dry = 1;
      for (int p : pp) { a.ph_lo = p; a.ph_hi = p + 1; hipLaunchKernelGGL(trunk_fwd, dim3(grid), dim3(NWAVES * 64), LDS_BYTES, stream, a); } }
#endif
}
```

```cpp
#include <hip/hip_runtime.h>
#include <cstdio>
#include <cstdint>
#include <cmath>

namespace pg8 {
#define PG8_LAS __attribute__((address_space(3)))
typedef unsigned short bf16_t;
typedef short bf16x8 __attribute__((ext_vector_type(8)));
typedef float f32x4 __attribute__((ext_vector_type(4)));
typedef unsigned u32x4 __attribute__((ext_vector_type(4)));
typedef unsigned u32x2 __attribute__((ext_vector_type(2)));
constexpr int BM = 256, BK = 64, HALF = 128, HTB = HALF * BK * 2  , STAGE_BYTES = 8 * HTB, NXCD = 8, WGM = 8;

__host__ __device__ __forceinline__ int lds_byte(int r, int c) { const int st = (r >> 4) * 2 + (c >> 5), rr = r & 15, cc = c & 31, ob = rr * 64 + cc * 2; return st * 1024 + (ob ^ (((ob >> 9) & 1) << 5)); }
__host__ __device__ __forceinline__ void stage_rc(int b, int& R, int& C) { const int st = b / 1024, sb = b % 1024, swz = sb ^ (((sb >> 9) & 1) << 5); R = (st >> 1) * 16 + swz / 64; C = (st & 1) * 32 + (swz % 64) / 2; }
__host__ __device__ __forceinline__ int perm32(int rho) { const int n = rho >> 4, i = rho & 15; return 8 * (i >> 2) + 4 * n + (i & 3); }

struct Unit { int pm, pn; };
struct Gemm { const bf16_t* A; const bf16_t* Bt; int M, N, K, lda, ldb; size_t a_pn_step; };

struct StaticOrder {
    int nM, nN, nwg, G, c;
    __host__ __device__ void init(int M, int N, int G_, int c_) { nM = M / BM; nN = N / BM; nwg = nM * nN; G = G_; c = c_; }
    __host__ __device__ bool next(int i, Unit& u) const {
        const long L = (long)i * G + c; if (L >= nwg) return false;
        int wgid = (int)L; { const int q = nwg / NXCD, r = nwg % NXCD, xcd = wgid % NXCD, off = wgid / NXCD; wgid = (xcd < r ? xcd * (q + 1) : r * (q + 1) + (xcd - r) * q) + off; }
        const int nig = WGM * nN, gid = wgid / nig, fm = gid * WGM, gsz = (nM - fm) < WGM ? (nM - fm) : WGM;
        u.pm = fm + ((wgid % nig) % gsz); u.pn = (wgid % nig) / gsz; return true;
    }
    __device__ __forceinline__ void a_ready(const Unit&) const {}
    __device__ __forceinline__ void done(const Unit&) const {}
};

__device__ __forceinline__ unsigned cvt_pk_bf16(float lo, float hi) { unsigned r; asm volatile("v_cvt_pk_bf16_f32 %0, %1, %2" : "=v"(r) : "v"(lo), "v"(hi)); return r; }
__device__ __forceinline__ u32x4 pack8(const f32x4 v0, const f32x4 v1) { u32x4 w; w.x = cvt_pk_bf16(v0[0], v0[1]); w.y = cvt_pk_bf16(v0[2], v0[3]); w.z = cvt_pk_bf16(v1[0], v1[1]); w.w = cvt_pk_bf16(v1[2], v1[3]); return w; }
__device__ __forceinline__ float bf_lo(unsigned w) { return __uint_as_float(w << 16); }
__device__ __forceinline__ float bf_hi(unsigned w) { return __uint_as_float(w & 0xffff0000u); }

template <int ACT> struct EpiStore {
    static constexpr bool PERM = true, AFTER_DRAIN = false;
    bf16_t* O; int ldc; const float* rs;
    __device__ __forceinline__ void operator()(const f32x4 (&acc)[2][2][4][2], const Unit& u, int wr, int wc, int fr, int fq) const {
        const int row0 = u.pm * BM + wr * 64 + fr, col0 = u.pn * BM + wc * 32 + 8 * fq;
#pragma unroll
        for (int ai = 0; ai < 2; ++ai)
#pragma unroll
            for (int m = 0; m < 4; ++m) { bf16_t* rowp = O + (size_t)(row0 + ai * HALF + m * 16) * ldc + col0;
                const float rsc = rs ? rs[row0 + ai * HALF + m * 16] : 1.f;
#pragma unroll
                for (int bj = 0; bj < 2; ++bj) { f32x4 v0 = acc[ai][bj][m][0] * rsc, v1 = acc[ai][bj][m][1] * rsc;
                    if (ACT == 1) {
#pragma unroll
                        for (int e = 0; e < 4; ++e) { const float a = fmaxf(v0[e], 0.f), b = fmaxf(v1[e], 0.f); v0[e] = a * a; v1[e] = b * b; } }
                    *(u32x4*)(rowp + bj * HALF) = pack8(v0, v1); } }
    }
};

struct EpiRet {
    static constexpr bool PERM = true, AFTER_DRAIN = false;
    bf16_t* O; int ldc; const float* rs;
    __device__ __forceinline__ void operator()(const f32x4 (&acc)[2][2][4][2], const Unit& u, int wr, int wc, int fr, int fq) const {
        const int row0 = u.pm * BM + wr * 64 + fr, col0 = u.pn * BM + wc * 32 + 8 * fq;
        const float lg = __log2f(1.f - exp2f(-5.f - (float)(u.pn & 3)));
        const float sgn = u.pn < 4 ? lg : -lg, mul = u.pn < 4 ? 1.f : 0.0625f;
        const bool scaled = u.pn < 8;
#pragma unroll
        for (int ai = 0; ai < 2; ++ai)
#pragma unroll
            for (int m = 0; m < 4; ++m) { const int row = row0 + ai * HALF + m * 16; bf16_t* rowp = O + (size_t)row * ldc + col0;
                const float sc = (scaled ? exp2f(sgn * (float)(row & 63)) * mul : 1.f) * rs[row];
#pragma unroll
                for (int bj = 0; bj < 2; ++bj) *(u32x4*)(rowp + bj * HALF) = pack8(acc[ai][bj][m][0] * sc, acc[ai][bj][m][1] * sc); }
    }
};

struct EpiGla {
    static constexpr bool PERM = true, AFTER_DRAIN = false;
    bf16_t* O; int ldc; const float* bgate; const float* rs;
    __device__ __forceinline__ void operator()(const f32x4 (&acc)[2][2][4][2], const Unit& u, int wr, int wc, int fr, int fq) const {
        const int row0 = u.pm * BM + wr * 64 + fr, col0 = u.pn * BM + wc * 32 + 8 * fq;
        const bool gate = u.pn >= 12;
        f32x4 bv[2][2];
#pragma unroll
        for (int bj = 0; bj < 2; ++bj)
#pragma unroll
            for (int n = 0; n < 2; ++n) bv[bj][n] = gate ? *(const f32x4*)(bgate + (col0 - 3072) + bj * HALF + 4 * n) : (f32x4){0.f, 0.f, 0.f, 0.f};
#pragma unroll
        for (int ai = 0; ai < 2; ++ai)
#pragma unroll
            for (int m = 0; m < 4; ++m) { bf16_t* rowp = O + (size_t)(row0 + ai * HALF + m * 16) * ldc + col0;
                const float rsc = rs[row0 + ai * HALF + m * 16];
#pragma unroll
                for (int bj = 0; bj < 2; ++bj) { f32x4 v0 = acc[ai][bj][m][0] * rsc, v1 = acc[ai][bj][m][1] * rsc;
                    if (gate) {
#pragma unroll
                        for (int e = 0; e < 4; ++e) {
                            const float z0 = v0[e] + bv[bj][0][e], z1 = v1[e] + bv[bj][1][e];
                            v0[e] = (fminf(z0, 0.f) - log1pf(__expf(-fabsf(z0)))) * 0.0625f;
                            v1[e] = (fminf(z1, 0.f) - log1pf(__expf(-fabsf(z1)))) * 0.0625f; } }
                    *(u32x4*)(rowp + bj * HALF) = pack8(v0, v1); } }
    }
};

struct EpiNsa {
    static constexpr bool PERM = true, AFTER_DRAIN = false;
    bf16_t* Q; bf16_t* KC; bf16_t* VC; bf16_t* KS; bf16_t* VST; bf16_t* KW; bf16_t* VWT; float* GATES; const float* rs;
    template <bool VTRANS> __device__ __forceinline__ void kv_store(const f32x4 (&acc)[2][2][4][2], bf16_t* Kt, bf16_t* Vt, int row0, int c8) const {
        const int g = c8 >> 6, d = c8 & 63;
#pragma unroll
        for (int ai = 0; ai < 2; ++ai)
#pragma unroll
            for (int m = 0; m < 4; ++m) {
                const int row = row0 + ai * HALF + m * 16, b = row >> 12, t = row & 4095;
                const size_t bg = (size_t)(b * 2 + g); const float rsc = rs[row];
                *(u32x4*)(Kt + (bg * 4096 + t) * 64 + d) = pack8(acc[ai][0][m][0] * rsc, acc[ai][0][m][1] * rsc);
                const u32x4 w = pack8(acc[ai][1][m][0] * rsc, acc[ai][1][m][1] * rsc);
                if (!VTRANS) *(u32x4*)(Vt + (bg * 4096 + t) * 64 + d) = w;
                else {
                    bf16_t* vp = Vt + (bg * 64 + d) * 4096 + t;
                    vp[0 * 4096] = (bf16_t)(w.x & 0xffffu); vp[1 * 4096] = (bf16_t)(w.x >> 16);
                    vp[2 * 4096] = (bf16_t)(w.y & 0xffffu); vp[3 * 4096] = (bf16_t)(w.y >> 16);
                    vp[4 * 4096] = (bf16_t)(w.z & 0xffffu); vp[5 * 4096] = (bf16_t)(w.z >> 16);
                    vp[6 * 4096] = (bf16_t)(w.w & 0xffffu); vp[7 * 4096] = (bf16_t)(w.w >> 16);
                }
            }
    }
    __device__ __forceinline__ void operator()(const f32x4 (&acc)[2][2][4][2], const Unit& u, int wr, int wc, int fr, int fq) const {
        const int row0 = u.pm * BM + wr * 64 + fr, c8 = wc * 32 + 8 * fq;
        if (u.pn < 4) {
#pragma unroll
            for (int ai = 0; ai < 2; ++ai)
#pragma unroll
                for (int m = 0; m < 4; ++m) { bf16_t* rowp = Q + (size_t)(row0 + ai * HALF + m * 16) * 1024 + u.pn * BM + c8; const float rsc = rs[row0 + ai * HALF + m * 16];
#pragma unroll
                    for (int bj = 0; bj < 2; ++bj) *(u32x4*)(rowp + bj * HALF) = pack8(acc[ai][bj][m][0] * rsc, acc[ai][bj][m][1] * rsc); }
        } else if (u.pn == 4) { kv_store<false>(acc, KC, VC, row0, c8);
        } else if (u.pn == 5) { kv_store<true>(acc, KS, VST, row0, c8);
        } else if (u.pn == 6) { kv_store<true>(acc, KW, VWT, row0, c8);
        } else {
            if (c8 < 48) {
#pragma unroll
                for (int ai = 0; ai < 2; ++ai)
#pragma unroll
                    for (int m = 0; m < 4; ++m) { float* gp = GATES + (size_t)(row0 + ai * HALF + m * 16) * 48 + c8; const float rsc = rs[row0 + ai * HALF + m * 16];
                        f32x4 v0 = acc[ai][0][m][0] * rsc, v1 = acc[ai][0][m][1] * rsc;
#pragma unroll
                        for (int e = 0; e < 4; ++e) { v0[e] = 1.f / (1.f + __expf(-v0[e])); v1[e] = 1.f / (1.f + __expf(-v1[e])); }
                        *(f32x4*)gp = v0; *(f32x4*)(gp + 4) = v1; }
            }
        }
    }
};

template <class Epi, class Sched, bool ALIGN_EPI = false, bool SP2 = false>
__device__ __forceinline__ void gemm_phase(PG8_LAS unsigned char* lds, const Gemm g, const Sched& S, const Epi& E) {
    const int tid = threadIdx.x, wid = __builtin_amdgcn_readfirstlane(tid >> 6), lane = tid & 63, wr = wid >> 2, wc = wid & 3, fr = lane & 15, fq = lane >> 4;
    const int K = g.K, nt = K / BK;
    unsigned voffA[2], voffB[2];
#pragma unroll
    for (int i = 0; i < 2; ++i) { int R, C; stage_rc(tid * 16 + i * 8192, R, C); const int Rb = Epi::PERM ? ((R & ~31) + perm32(R & 31)) : R;
        voffA[i] = (unsigned)(R * g.lda + C) * 2u; voffB[i] = (unsigned)(Rb * g.ldb + C) * 2u; }
    const size_t kstep = (size_t)(BK * 2);
    const size_t hstepA = (size_t)HALF * g.lda * 2, hstepB = (size_t)HALF * g.ldb * 2;
    const size_t tstepA = 2 * hstepA, tstepB = 2 * hstepB;
    const unsigned ldsw = (unsigned)wid * 1024u;
    const int aoff = lds_byte(wr * 64 + fr, fq * 8), boff = lds_byte(wc * 32 + fr, fq * 8);
#define PG8_SA(b, h) (((b) * 2 + (h)) * HTB)
#define PG8_SB(b, h) ((4 + (b) * 2 + (h)) * HTB)
#define PG8_STAGE(bufoff, gbase, voff) do { _Pragma("unroll") for (int _i = 0; _i < 2; ++_i) \
        __builtin_amdgcn_global_load_lds((const unsigned*)((const char*)(gbase) + (voff)[_i]), (PG8_LAS unsigned*)(lds + (bufoff) + ldsw + _i * 8192), 16, 0, 0); } while (0)
#define PG8_LDA(dst, b, h) do { _Pragma("unroll") for (int m = 0; m < 4; ++m) _Pragma("unroll") for (int k = 0; k < 2; ++k) dst[m][k] = *(const PG8_LAS bf16x8*)(lds + PG8_SA(b, h) + aoff + m * 2048 + k * 1024); } while (0)
#define PG8_LDB(dst, b, h) do { _Pragma("unroll") for (int n = 0; n < 2; ++n) _Pragma("unroll") for (int k = 0; k < 2; ++k) dst[n][k] = *(const PG8_LAS bf16x8*)(lds + PG8_SB(b, h) + boff + n * 2048 + k * 1024); } while (0)
#define PG8_MMA(ai, bj, At, Bt) do { __builtin_amdgcn_s_setprio(1); _Pragma("unroll") for (int m = 0; m < 4; ++m) _Pragma("unroll") for (int n = 0; n < 2; ++n) _Pragma("unroll") for (int k = 0; k < 2; ++k) \
        acc[ai][bj][m][n] = __builtin_amdgcn_mfma_f32_16x16x32_bf16(Bt[n][k], At[m][k], acc[ai][bj][m][n], 0, 0, 0); __builtin_amdgcn_s_setprio(0); } while (0)
#define PG8_WAIT_V(n) asm volatile("s_waitcnt vmcnt(" #n ")" ::: "memory")
#define PG8_WAIT_L(n) asm volatile("s_waitcnt lgkmcnt(" #n ")" ::: "memory")
#define PG8_BAR __builtin_amdgcn_s_barrier()
#define PG8_SCHED __builtin_amdgcn_sched_barrier(0)
    Unit cur, nxt; int ui = 0;
    if (!S.next(0, cur)) return;
    f32x4 acc[2][2][4][2];
#pragma unroll
    for (int a = 0; a < 2; ++a)
#pragma unroll
        for (int b = 0; b < 2; ++b)
#pragma unroll
            for (int m = 0; m < 4; ++m)
#pragma unroll
                for (int n = 0; n < 2; ++n) acc[a][b][m][n] = (f32x4){0.f, 0.f, 0.f, 0.f};
    bf16x8 At[4][2], B0[2][2], B1[2][2];
    const char* cA = (const char*)g.A + (size_t)cur.pm * tstepA + (size_t)cur.pn * g.a_pn_step; const char* cB = (const char*)g.Bt + (size_t)cur.pn * tstepB;
    S.a_ready(cur);
    if constexpr (SP2) {
        PG8_STAGE(PG8_SB(0, 0), cB, voffB); PG8_STAGE(PG8_SB(0, 1), cB + hstepB, voffB); PG8_STAGE(PG8_SA(0, 0), cA, voffA); PG8_STAGE(PG8_SA(0, 1), cA + hstepA, voffA);
        if (wr == 1) PG8_BAR;
        PG8_WAIT_V(2); PG8_BAR;
        PG8_STAGE(PG8_SB(1, 0), cB + kstep, voffB); PG8_STAGE(PG8_SA(1, 0), cA + kstep, voffA); PG8_STAGE(PG8_SB(1, 1), cB + hstepB + kstep, voffB);
        PG8_WAIT_V(6); PG8_BAR;
    } else {
        PG8_STAGE(PG8_SB(0, 0), cB, voffB); PG8_STAGE(PG8_SA(0, 0), cA, voffA); PG8_STAGE(PG8_SB(0, 1), cB + hstepB, voffB); PG8_STAGE(PG8_SA(0, 1), cA + hstepA, voffA);
        if (wr == 1) PG8_BAR;
        PG8_WAIT_V(4); PG8_BAR;
        PG8_STAGE(PG8_SB(1, 0), cB + kstep, voffB); PG8_STAGE(PG8_SA(1, 0), cA + kstep, voffA); PG8_STAGE(PG8_SB(1, 1), cB + hstepB + kstep, voffB);
        PG8_WAIT_V(6); PG8_BAR;
    }
    for (;;) {
        const bool has_next = S.next(ui + 1, nxt);
        const char* nA = has_next ? (const char*)g.A + (size_t)nxt.pm * tstepA + (size_t)nxt.pn * g.a_pn_step : cA; const char* nB = has_next ? (const char*)g.Bt + (size_t)nxt.pn * tstepB : cB;
        for (int t = 0; t < nt; t += 2) {
            const bool last = (t == nt - 2);
            const char* a1 = cA + (size_t)(t + 1) * kstep;
            const char* a2 = last ? nA : cA + (size_t)(t + 2) * kstep; const char* b2 = last ? nB : cB + (size_t)(t + 2) * kstep;
            const char* a3 = a2 + kstep; const char* b3 = b2 + kstep;
            if (last && has_next) S.a_ready(nxt);
            if constexpr (SP2) {
            PG8_LDB(B0, 0, 0); PG8_LDB(B1, 0, 1); PG8_SCHED; PG8_LDA(At, 0, 0); PG8_STAGE(PG8_SA(1, 1), a1 + hstepA, voffA);
            PG8_WAIT_V(8); PG8_WAIT_L(0); PG8_BAR; PG8_MMA(0, 0, At, B0); PG8_MMA(0, 1, At, B1); PG8_BAR; PG8_SCHED;
            PG8_LDA(At, 0, 1); PG8_STAGE(PG8_SB(0, 0), b2, voffB); PG8_STAGE(PG8_SB(0, 1), b2 + hstepB, voffB); PG8_STAGE(PG8_SA(0, 0), a2, voffA);
            PG8_WAIT_V(8); PG8_WAIT_L(0); PG8_BAR; PG8_MMA(1, 0, At, B0); PG8_MMA(1, 1, At, B1); PG8_BAR; PG8_SCHED;
            PG8_LDB(B0, 1, 0); PG8_LDB(B1, 1, 1); PG8_SCHED; PG8_LDA(At, 1, 0); PG8_STAGE(PG8_SA(0, 1), a2 + hstepA, voffA);
            PG8_WAIT_V(8); PG8_WAIT_L(0); PG8_BAR; PG8_MMA(0, 0, At, B0); PG8_MMA(0, 1, At, B1); PG8_BAR; PG8_SCHED;
            PG8_LDA(At, 1, 1); PG8_STAGE(PG8_SB(1, 0), b3, voffB); PG8_STAGE(PG8_SB(1, 1), b3 + hstepB, voffB); PG8_STAGE(PG8_SA(1, 0), a3, voffA);
            PG8_WAIT_V(8); PG8_WAIT_L(0); PG8_BAR; PG8_MMA(1, 0, At, B0); PG8_MMA(1, 1, At, B1); PG8_BAR; PG8_SCHED;
            } else {
            PG8_LDB(B0, 0, 0); PG8_SCHED; PG8_LDA(At, 0, 0); PG8_STAGE(PG8_SA(1, 1), a1 + hstepA, voffA);
            PG8_WAIT_L(8); PG8_BAR; PG8_WAIT_L(0); PG8_MMA(0, 0, At, B0); PG8_BAR; PG8_SCHED;
            PG8_LDB(B1, 0, 1); PG8_STAGE(PG8_SB(0, 0), b2, voffB);
            PG8_BAR; PG8_WAIT_L(0); PG8_MMA(0, 1, At, B1); PG8_BAR;
            PG8_LDA(At, 0, 1); PG8_STAGE(PG8_SA(0, 0), a2, voffA);
            PG8_BAR; PG8_WAIT_L(0); PG8_MMA(1, 0, At, B0); PG8_BAR; PG8_SCHED;
            PG8_STAGE(PG8_SB(0, 1), b2 + hstepB, voffB);
            PG8_WAIT_V(6); PG8_BAR; PG8_MMA(1, 1, At, B1); PG8_BAR;
            PG8_LDB(B0, 1, 0); PG8_SCHED; PG8_LDA(At, 1, 0); PG8_STAGE(PG8_SA(0, 1), a2 + hstepA, voffA);
            PG8_WAIT_L(8); PG8_BAR; PG8_WAIT_L(0); PG8_MMA(0, 0, At, B0); PG8_BAR; PG8_SCHED;
            PG8_LDB(B1, 1, 1); PG8_STAGE(PG8_SB(1, 0), b3, voffB);
            PG8_BAR; PG8_WAIT_L(0); PG8_MMA(0, 1, At, B1); PG8_BAR;
            PG8_LDA(At, 1, 1); PG8_STAGE(PG8_SA(1, 0), a3, voffA);
            PG8_BAR; PG8_WAIT_L(0); PG8_MMA(1, 0, At, B0); PG8_BAR; PG8_SCHED;
            PG8_STAGE(PG8_SB(1, 1), b3 + hstepB, voffB);
            PG8_WAIT_V(6); PG8_BAR; PG8_MMA(1, 1, At, B1); PG8_BAR;
            }
        }
        if constexpr (ALIGN_EPI) { if (wr == 0) PG8_BAR; }
        if constexpr (!Epi::AFTER_DRAIN) { E(acc, cur, wr, wc, fr, fq); S.done(cur); }
        if (!has_next) break;
#pragma unroll
        for (int a = 0; a < 2; ++a)
#pragma unroll
            for (int b = 0; b < 2; ++b)
#pragma unroll
                for (int m = 0; m < 4; ++m)
#pragma unroll
                    for (int n = 0; n < 2; ++n) acc[a][b][m][n] = (f32x4){0.f, 0.f, 0.f, 0.f};
        cur = nxt; cA = nA; cB = nB; ++ui;
        if constexpr (ALIGN_EPI) { if (wr == 1) PG8_BAR; }
    }
    PG8_WAIT_V(0);
    if constexpr (!ALIGN_EPI) { if (wr == 0) PG8_BAR; }
    PG8_BAR;
    if constexpr (Epi::AFTER_DRAIN) { E.fused(acc, cur, wr, wc, fr, fq, lds, wid, lane); S.done(cur); }
#undef PG8_SA
#undef PG8_SB
#undef PG8_STAGE
#undef PG8_LDA
#undef PG8_LDB
#undef PG8_MMA
#undef PG8_WAIT_V
#undef PG8_WAIT_L
#undef PG8_BAR
#undef PG8_SCHED
}
}

constexpr int BATCH = 8, SEQ = 4096, D = 1024, FF = 4096;
constexpr int M = BATCH * SEQ;
constexpr float NORM_EPS = 1e-6f;
constexpr int NWAVES = 8;
constexpr float LOG2E = 1.4426950408889634f;

constexpr size_t MiB = 1u << 20;
constexpr size_t WS_CTL = 0, CTL_ZERO_BYTES = 64 * 1024;
constexpr size_t WS_WIN = 1 * MiB, WS_WOUT = 13 * MiB, WS_WUP = 17 * MiB, WS_WDN = 25 * MiB;
constexpr size_t WS_H = 33 * MiB;
constexpr size_t WS_BIG = 97 * MiB;
constexpr size_t WS_SMALL = 481 * MiB;
constexpr size_t WS_END = 512 * MiB;
constexpr size_t SM_LRUW = WS_SMALL;
constexpr size_t SM_SCANP = WS_SMALL + 1 * MiB, SM_SCANE = WS_SMALL + 3 * MiB;
constexpr size_t SM_W1K = WS_SMALL + 5 * MiB, SM_W1V = SM_W1K + 512 * 1024;
constexpr size_t SM_W2K = WS_SMALL + 6 * MiB, SM_W2V = SM_W2K + 16 * 1024, SM_PEB = SM_W2V + 16 * 1024;
constexpr size_t SM_KCMP = WS_SMALL + 7 * MiB, SM_VCMPT = SM_KCMP + 512 * 1024;
constexpr size_t SM_GATES = WS_SMALL + 8 * MiB;
constexpr size_t SM_AT = WS_SMALL;
constexpr size_t SM_RS = WS_SMALL + 18 * MiB;
constexpr size_t SM_GLAW = WS_SMALL + 16 * MiB;
constexpr size_t LRU_XY = WS_BIG, LRU_XC = WS_BIG + 128 * MiB, LRU_GP = WS_BIG + 192 * MiB, LRU_HS = WS_BIG + 320 * MiB;
constexpr size_t NSA_Q = WS_BIG, NSA_KC = WS_BIG + 64 * MiB, NSA_VC = NSA_KC + 8 * MiB, NSA_KS = NSA_KC + 16 * MiB, NSA_VST = NSA_KC + 24 * MiB,
                 NSA_KW = NSA_KC + 32 * MiB, NSA_VWT = NSA_KC + 40 * MiB, NSA_O = WS_BIG + 128 * MiB;
constexpr int CW_BAR = 1024;

constexpr int RING_OFF = 0, SCR_BYTES = 143360;
constexpr int LDSCTL_OFF = SCR_BYTES;
constexpr int LDS_BYTES = 147456;

#define GAS __attribute__((address_space(1)))
#define LAS __attribute__((address_space(3)))
typedef unsigned short bf16;
typedef unsigned v4u __attribute__((ext_vector_type(4)));
typedef unsigned v2u __attribute__((ext_vector_type(2)));
typedef float f32x4 __attribute__((ext_vector_type(4)));
typedef float f32x2 __attribute__((ext_vector_type(2)));
typedef float f32x16 __attribute__((ext_vector_type(16)));
typedef short bf16x8 __attribute__((ext_vector_type(8)));
typedef short s16x4 __attribute__((ext_vector_type(4)));
#define MFMA32(a, b, c) __builtin_amdgcn_mfma_f32_32x32x16_bf16((a), (b), (c), 0, 0, 0)
__device__ __forceinline__ unsigned f2bf(float f) { unsigned u = __builtin_bit_cast(unsigned, f); return (u + 0x7fffu + ((u >> 16) & 1u)) >> 16; }
__device__ __forceinline__ unsigned pk2(float lo, float hi) { return f2bf(lo) | (f2bf(hi) << 16); }
__device__ __forceinline__ float bflo(unsigned w) { return __uint_as_float(w << 16); }
__device__ __forceinline__ float bfhi(unsigned w) { return __uint_as_float(w & 0xffff0000u); }
__device__ __forceinline__ float bf1(bf16 v) { return __uint_as_float((unsigned)v << 16); }
__device__ __forceinline__ float gelu_tanh(float x) { const float z = 0.7978845608028654f * (x + 0.044715f * x * x * x); const float t = 1.f - 2.f / (1.f + __expf(2.f * z)); return 0.5f * x * (1.f + t); }
__device__ __forceinline__ float silu(float x) { return x / (1.f + __expf(-x)); }

#define XB_TMO      128
#define XB_XCNT(j)  (256  + 64 * (j))
#define XB_XSUB(j)  (1280 + 64 * (j))
#define XB_XGEN(j)  (2304 + 64 * (j))
#define XB_TOP      3328
#define XB_TOPGEN   3392
#define XCD_BAR_WORDS 3456
#define XB_SPIN_CAP (1u << 18)
#define LAS __attribute__((address_space(3)))

__device__ __forceinline__ unsigned xb_ld(unsigned* p)              { return __hip_atomic_load(p, __ATOMIC_RELAXED, __HIP_MEMORY_SCOPE_AGENT); }
__device__ __forceinline__ unsigned xb_add(unsigned* p, unsigned v) { return __hip_atomic_fetch_add(p, v, __ATOMIC_RELAXED, __HIP_MEMORY_SCOPE_AGENT); }
__device__ __forceinline__ unsigned xb_xcc_id() { return (unsigned)__builtin_amdgcn_s_getreg((3 << 11) | 20) & 0xFu; }
#define XB_SPIN(cond, bar) do { unsigned _sp = 0; while (cond) { __builtin_amdgcn_s_sleep(1); \
    if ((++_sp & 255u) == 0u) { if (xb_ld(&(bar)[XB_TMO])) break; if (_sp > XB_SPIN_CAP) { atomicAdd(&(bar)[XB_TMO], 1u); break; } } } } while (0)

struct XcdBarrier {
    unsigned* bar; unsigned x;
    volatile LAS unsigned* st;
};

__device__ __forceinline__ XcdBarrier xcd_barrier_post(unsigned* bar, volatile LAS unsigned* st) {
    XcdBarrier b; b.bar = bar; b.x = xb_xcc_id(); b.st = st;
    if (threadIdx.x == 0) (void)xb_add(&bar[XB_XCNT(b.x)], 1u);
    return b;
}
__device__ __forceinline__ void xcd_barrier_complete(unsigned* bar, unsigned x, unsigned& nloc, unsigned& nx) {
    const unsigned G = gridDim.x * gridDim.y * gridDim.z;
    unsigned sum, cnt, mine, sp = 0u;
    for (;;) {
        sum = 0u; cnt = 0u; mine = 0u;
#pragma unroll
        for (unsigned j = 0; j < 16; ++j) { const unsigned c = xb_ld(&bar[XB_XCNT(j)]); sum += c; cnt += (c > 0u) ? 1u : 0u; mine = (j == x) ? c : mine; }
        if (sum == G) break;
        __builtin_amdgcn_s_sleep(1);
        if ((++sp & 255u) == 0u) { if (xb_ld(&bar[XB_TMO])) break; if (sp > XB_SPIN_CAP) { atomicAdd(&bar[XB_TMO], 1u); break; } }
    }
    nloc = mine > 0u ? mine : 1u; nx = cnt > 0u ? cnt : 1u;
}

__device__ __forceinline__ void xcd_barrier(const XcdBarrier& b) {
    asm volatile("s_waitcnt vmcnt(0)" ::: "memory");
    __syncthreads();
    if (threadIdx.x == 0) {
        unsigned* bar = b.bar;
        __builtin_amdgcn_s_waitcnt(0);
        unsigned nloc = b.st[0], nx = b.st[1];
        if (nloc == 0u) { xcd_barrier_complete(bar, b.x, nloc, nx); b.st[0] = nloc; b.st[1] = nx; }
        const unsigned old = xb_add(&bar[XB_XSUB(b.x)], 1u);
        const unsigned gen = old / nloc;
        if (old + 1u == (gen + 1u) * nloc) {
            __builtin_amdgcn_fence(__ATOMIC_RELEASE, "agent");
            asm volatile("s_waitcnt vmcnt(0)" ::: "memory");
            const unsigned og = xb_add(&bar[XB_TOP], 1u);
            const unsigned tg = og / nx;
            if (og + 1u == (tg + 1u) * nx) xb_add(&bar[XB_TOPGEN], 1u);
            else XB_SPIN(xb_ld(&bar[XB_TOPGEN]) == tg, bar);
            __builtin_amdgcn_fence(__ATOMIC_ACQUIRE, "agent");
            xb_add(&bar[XB_XGEN(b.x)], 1u);
            asm volatile("s_waitcnt vmcnt(0)" ::: "memory");
        } else {
            XB_SPIN(xb_ld(&bar[XB_XGEN(b.x)]) == gen, bar);
            __builtin_amdgcn_fence(__ATOMIC_ACQUIRE, "agent");
            asm volatile("s_waitcnt vmcnt(0)" ::: "memory");
        }
    }
    __syncthreads();
}

struct Frame {
    LAS unsigned char* lds;
    int tid, lane, wave;
    int vcu, G;
    unsigned char* ws;
    int dry;
};

__device__ __forceinline__ bool frame_refresh(Frame& F) { int tz = threadIdx.x; asm volatile("" : "+v"(tz)); F.tid = tz; F.lane = tz & 63; return true; }
__device__ __forceinline__ float wave_sum(float v) {
#pragma unroll
    for (int o = 1; o < 64; o <<= 1) v += __shfl_xor(v, o);
    return v;
}
__device__ __forceinline__ float grp16_sum(float v) {
#pragma unroll
    for (int o = 1; o < 16; o <<= 1) v += __shfl_xor(v, o);
    return v;
}

__device__ __forceinline__ void conv_w(Frame& F, int& base, const float* W, int K, int ldw, int n_src0, int ncols, int n_valid, bf16* WT, int ldk, int row_off, float scale, const float* gk = nullptr) {
    LAS float* scr = (LAS float*)(F.lds + F.wave * 8704);
    const int gw = F.vcu * NWAVES + F.wave, NGW = F.G * NWAVES, lane = F.lane;
    const int nblk = ncols / 32, items = (K / 64) * nblk;
    int start = (gw - base % NGW + NGW) % NGW; base += items;
    for (int it = start; it < items; it += NGW) {
        const int kb = it / nblk, nb = it % nblk, k0 = 64 * kb, n0 = 32 * nb;
        const int n4 = (lane & 7) * 4, nn = n_src0 + n0 + n4; const bool ok = nn < n_valid;
        f32x4 v[8];
#pragma unroll
        for (int i = 0; i < 8; ++i) { const int kk = (lane >> 3) + 8 * i; v[i] = ok ? *(const f32x4*)(W + (size_t)(k0 + kk) * ldw + nn) : (f32x4){0.f, 0.f, 0.f, 0.f}; }
#pragma unroll
        for (int i = 0; i < 8; ++i) { const int kk = (lane >> 3) + 8 * i; const float sc = gk ? scale * gk[k0 + kk] : scale;
            scr[kk * 33 + n4] = v[i].x * sc; scr[kk * 33 + n4 + 1] = v[i].y * sc; scr[kk * 33 + n4 + 2] = v[i].z * sc; scr[kk * 33 + n4 + 3] = v[i].w * sc; }
        asm volatile("s_waitcnt lgkmcnt(0)" ::: "memory");
        const int c = lane & 7;
#pragma unroll
        for (int j = 0; j < 4; ++j) { const int n = (lane >> 3) + 8 * j; const LAS float* sp = scr + (8 * c) * 33 + n;
            v4u o; o.x = pk2(sp[0 * 33], sp[1 * 33]); o.y = pk2(sp[2 * 33], sp[3 * 33]); o.z = pk2(sp[4 * 33], sp[5 * 33]); o.w = pk2(sp[6 * 33], sp[7 * 33]);
            *(v4u*)(WT + (size_t)(row_off + n0 + n) * ldk + k0 + 8 * c) = o; }
        asm volatile("s_waitcnt lgkmcnt(0)" ::: "memory");
    }
}

template <int MODE  >
__device__ __forceinline__ void norm_phase(Frame& F, const float* xin, bf16* X, const bf16* Y, const float* gpost, float* RS, float* outf) {
    const int gw = F.vcu * NWAVES + F.wave, NGW = F.G * NWAVES, lane = F.lane;
    if (F.dry) { X = (bf16*)(F.ws + WS_BIG + (MODE == 1 ? 0 : 128 * MiB)); RS = (float*)(F.ws + WS_BIG + 256 * MiB); outf = (float*)(F.ws + WS_BIG); }
    const bf16* Xr = (MODE == 1 && F.dry) ? (const bf16*)(F.ws + WS_H) : X;
    for (int m = gw; m < M; m += NGW) {
        float v[16];
        if (MODE == 0) {
#pragma unroll
            for (int j = 0; j < 2; ++j) { const f32x4 a = *(const f32x4*)(xin + (size_t)m * D + lane * 8 + 512 * j), b2 = *(const f32x4*)(xin + (size_t)m * D + lane * 8 + 512 * j + 4);
                v[8 * j] = a.x; v[8 * j + 1] = a.y; v[8 * j + 2] = a.z; v[8 * j + 3] = a.w; v[8 * j + 4] = b2.x; v[8 * j + 5] = b2.y; v[8 * j + 6] = b2.z; v[8 * j + 7] = b2.w; }
        } else {
            v4u xw[2], yw[2];
#pragma unroll
            for (int j = 0; j < 2; ++j) { xw[j] = *(const v4u*)(Xr + (size_t)m * D + lane * 8 + 512 * j); yw[j] = *(const v4u*)(Y + (size_t)m * D + lane * 8 + 512 * j); }
            float y[16], ss = 0.f;
#pragma unroll
            for (int j = 0; j < 2; ++j) { y[8 * j] = bflo(yw[j].x); y[8 * j + 1] = bfhi(yw[j].x); y[8 * j + 2] = bflo(yw[j].y); y[8 * j + 3] = bfhi(yw[j].y); y[8 * j + 4] = bflo(yw[j].z); y[8 * j + 5] = bfhi(yw[j].z); y[8 * j + 6] = bflo(yw[j].w); y[8 * j + 7] = bfhi(yw[j].w);
                v[8 * j] = bflo(xw[j].x); v[8 * j + 1] = bfhi(xw[j].x); v[8 * j + 2] = bflo(xw[j].y); v[8 * j + 3] = bfhi(xw[j].y); v[8 * j + 4] = bflo(xw[j].z); v[8 * j + 5] = bfhi(xw[j].z); v[8 * j + 6] = bflo(xw[j].w); v[8 * j + 7] = bfhi(xw[j].w); }
#pragma unroll
            for (int e = 0; e < 16; ++e) ss += y[e] * y[e];
            const float rstd = rsqrtf(wave_sum(ss) * (1.f / D) + NORM_EPS);
#pragma unroll
            for (int j = 0; j < 2; ++j) { const f32x4 g0 = *(const f32x4*)(gpost + lane * 8 + 512 * j), g1 = *(const f32x4*)(gpost + lane * 8 + 512 * j + 4);
                v[8 * j] += y[8 * j] * rstd * g0.x; v[8 * j + 1] += y[8 * j + 1] * rstd * g0.y; v[8 * j + 2] += y[8 * j + 2] * rstd * g0.z; v[8 * j + 3] += y[8 * j + 3] * rstd * g0.w;
                v[8 * j + 4] += y[8 * j + 4] * rstd * g1.x; v[8 * j + 5] += y[8 * j + 5] * rstd * g1.y; v[8 * j + 6] += y[8 * j + 6] * rstd * g1.z; v[8 * j + 7] += y[8 * j + 7] * rstd * g1.w; }
        }
        if (MODE == 2) {
#pragma unroll
            for (int j = 0; j < 2; ++j) { float* op = outf + (size_t)m * D + lane * 8 + 512 * j;
                *(f32x4*)op = (f32x4){v[8 * j], v[8 * j + 1], v[8 * j + 2], v[8 * j + 3]}; *(f32x4*)(op + 4) = (f32x4){v[8 * j + 4], v[8 * j + 5], v[8 * j + 6], v[8 * j + 7]}; }
        } else {
            float s2 = 0.f;
#pragma unroll
            for (int e = 0; e < 16; ++e) s2 += v[e] * v[e];
            s2 = wave_sum(s2);
#pragma unroll
            for (int j = 0; j < 2; ++j) { v4u o; o.x = pk2(v[8 * j], v[8 * j + 1]); o.y = pk2(v[8 * j + 2], v[8 * j + 3]); o.z = pk2(v[8 * j + 4], v[8 * j + 5]); o.w = pk2(v[8 * j + 6], v[8 * j + 7]);
                *(v4u*)(X + (size_t)m * D + lane * 8 + 512 * j) = o; }
            if (lane == 0) RS[m] = rsqrtf(s2 * (1.f / D) + NORM_EPS);
        }
    }
}

template <int DK, int DV, int CS, bool ISGLA>
__device__ __forceinline__ void recur_phase(Frame& F, bf16* base, int ld, int qoff, int koff, int voff, int laoff, float kscale) {
    constexpr int NS = DV / CS, NDG = 512 / CS, DPT = DK / NDG, TB = 16, NT = ISGLA ? 3 : 2, NB = SEQ / TB;
    constexpr int STG = NT * TB * DK, VST = TB * CS, RED = NDG * TB * CS;
    static_assert((2 * STG + 2 * VST + 2 * RED) * 4 <= SCR_BYTES, "recurrent phase LDS");
    LAS float* stage = (LAS float*)F.lds; LAS float* vst = stage + 2 * STG; LAS float* red = vst + 2 * VST;
    const int tid = F.tid, c = tid % CS, dg = tid / CS;
    constexpr int QCH = TB * DK / 8, VCH = TB * CS / 8;
    const bool ldq = tid < QCH, ldv = tid < VCH;
    const int qt_ = tid / (DK / 8), qd = (tid % (DK / 8)) * 8;
    const int vt_ = tid / (CS / 8), vc_ = (tid % (CS / 8)) * 8;
    for (int it = F.vcu; it < 32 * NS; it += F.G) {
        const int bh = it / NS, sl = it % NS, b = bh >> 2, h = bh & 3;
        bf16* rowbase = base + (size_t)b * SEQ * ld;
        const bf16* qp = rowbase + qoff + h * DK; const bf16* kp = rowbase + koff + h * DK; const bf16* lap = rowbase + laoff + h * DK;
        bf16* vp = rowbase + voff + h * DV + sl * CS;
        const float gamma = 1.f - exp2f(-5.f - (float)h);
        f32x2 S[DPT / 2];
#pragma unroll
        for (int i = 0; i < DPT / 2; ++i) S[i] = (f32x2){0.f, 0.f};
        v4u rq = {0, 0, 0, 0}, rk = {0, 0, 0, 0}, rl = {0, 0, 0, 0}, rv = {0, 0, 0, 0};
#define RC_GLOAD(n_) do { \
            if (ldq) { const size_t o_ = (size_t)((n_) * TB + qt_) * ld + qd; rq = *(const v4u*)(qp + o_); rk = *(const v4u*)(kp + o_); if (ISGLA) rl = *(const v4u*)(lap + o_); } \
            if (ldv) { rv = *(const v4u*)(vp + (size_t)((n_) * TB + vt_) * ld + vc_); } } while (0)
#define RC_SWRITE(buf_) do { \
            LAS float* st_ = stage + (buf_) * STG; \
            if (ldq) { \
                LAS float* q_ = st_ + qt_ * DK + qd; LAS float* k_ = st_ + TB * DK + qt_ * DK + qd; \
                *(LAS f32x4*)q_ = (f32x4){bflo(rq.x), bfhi(rq.x), bflo(rq.y), bfhi(rq.y)}; *(LAS f32x4*)(q_ + 4) = (f32x4){bflo(rq.z), bfhi(rq.z), bflo(rq.w), bfhi(rq.w)}; \
                *(LAS f32x4*)k_ = (f32x4){bflo(rk.x), bfhi(rk.x), bflo(rk.y), bfhi(rk.y)} * kscale; *(LAS f32x4*)(k_ + 4) = (f32x4){bflo(rk.z), bfhi(rk.z), bflo(rk.w), bfhi(rk.w)} * kscale; \
                if (ISGLA) { LAS float* a_ = st_ + 2 * TB * DK + qt_ * DK + qd; \
                    *(LAS f32x4*)a_ = (f32x4){__expf(bflo(rl.x)), __expf(bfhi(rl.x)), __expf(bflo(rl.y)), __expf(bfhi(rl.y))}; \
                    *(LAS f32x4*)(a_ + 4) = (f32x4){__expf(bflo(rl.z)), __expf(bfhi(rl.z)), __expf(bflo(rl.w)), __expf(bfhi(rl.w))}; } \
            } \
            if (ldv) { LAS float* v_ = vst + (buf_) * VST + vt_ * CS + vc_; \
                *(LAS f32x4*)v_ = (f32x4){bflo(rv.x), bfhi(rv.x), bflo(rv.y), bfhi(rv.y)}; *(LAS f32x4*)(v_ + 4) = (f32x4){bflo(rv.z), bfhi(rv.z), bflo(rv.w), bfhi(rv.w)}; } } while (0)
        __syncthreads();
        RC_GLOAD(0); RC_SWRITE(0);
        __syncthreads();
        for (int n = 0; n < NB; ++n) {
            const int cur = n & 1;
            if (n + 1 < NB) RC_GLOAD(n + 1);
            const LAS float* qs = stage + cur * STG + dg * DPT; const LAS float* ks = qs + TB * DK; const LAS float* as = qs + 2 * TB * DK;
            const LAS float* vs = vst + cur * VST + c;
            LAS float* rd = red + cur * RED + dg * TB * CS + c;
#pragma unroll
            for (int t = 0; t < TB; ++t) {
                const float vv = vs[t * CS];
                f32x2 acc = {0.f, 0.f};
#pragma unroll
                for (int i = 0; i < DPT; i += 4) {
                    const f32x4 k4 = *(const LAS f32x4*)(ks + t * DK + i), q4 = *(const LAS f32x4*)(qs + t * DK + i);
                    f32x2 d0, d1;
                    if (ISGLA) { const f32x4 a4 = *(const LAS f32x4*)(as + t * DK + i); d0 = (f32x2){a4.x, a4.y}; d1 = (f32x2){a4.z, a4.w}; } else { d0 = (f32x2){gamma, gamma}; d1 = d0; }
                    S[i / 2] = S[i / 2] * d0 + (f32x2){k4.x, k4.y} * vv; acc += (f32x2){q4.x, q4.y} * S[i / 2];
                    S[i / 2 + 1] = S[i / 2 + 1] * d1 + (f32x2){k4.z, k4.w} * vv; acc += (f32x2){q4.z, q4.w} * S[i / 2 + 1];
                }
                rd[t * CS] = acc.x + acc.y;
            }
            if (n + 1 < NB) RC_SWRITE(cur ^ 1);
            __syncthreads();
#pragma unroll
            for (int rep = 0; rep < (TB * CS + 511) / 512; ++rep) {
                const int idx = tid + rep * 512;
                if (idx < TB * CS) {
                    const LAS float* rr = red + cur * RED + idx; float s = 0.f;
#pragma unroll
                    for (int g = 0; g < NDG; ++g) s += rr[g * TB * CS];
                    const int t = idx / CS, cc = idx % CS;
                    if (!F.dry) vp[(size_t)(n * TB + t) * ld + cc] = (bf16)f2bf(s);
                }
            }
        }
    }
    __syncthreads();
}

template <int DK>
__device__ __forceinline__ void chunk_a_phase(Frame& F, const bf16* base, int ld, int qoff, int koff, bf16* AT) {
    const int tid = F.tid, w = F.wave, grp = w / 3, wt = w % 3;
    if (w >= 6) return;
    const int r = tid & 31, hh = (tid >> 5) & 1;
    for (int it = F.vcu * 2 + grp; it < 32 * 64; it += F.G * 2) {
        const int bh = it >> 6, c = it & 63, b = bh >> 2, h = bh & 3;
        const int jt = wt >> 1, itl = (wt + 1) >> 1;
        const bf16* kp = base + ((size_t)b * SEQ + 64 * c + 32 * jt + r) * ld + koff + h * DK + 8 * hh;
        const bf16* qp = base + ((size_t)b * SEQ + 64 * c + 32 * itl + r) * ld + qoff + h * DK + 8 * hh;
        f32x16 a0 = {}, a1 = {};
#pragma unroll
        for (int s = 0; s < DK / 16; s += 2) { a0 = MFMA32(*(const bf16x8*)(kp + 16 * s), *(const bf16x8*)(qp + 16 * s), a0); a1 = MFMA32(*(const bf16x8*)(kp + 16 * s + 16), *(const bf16x8*)(qp + 16 * s + 16), a1); }
        const int lim = (jt == itl) ? r - 4 * hh : 1000;
        bf16* ap = AT + (size_t)it * 4096 + (32 * itl + r) * 64 + 32 * jt + 4 * hh;
#pragma unroll
        for (int a4 = 0; a4 < 4; ++a4) { float e[4];
#pragma unroll
            for (int x = 0; x < 4; ++x) e[x] = (8 * a4 + x <= lim) ? a0[4 * a4 + x] + a1[4 * a4 + x] : 0.f;
            v2u o; o.x = pk2(e[0], e[1]); o.y = pk2(e[2], e[3]); *(v2u*)(ap + 8 * a4) = o; }
    }
}
template <int DK, int DV, bool ISGLA>
__device__ __forceinline__ void chunk_phase(Frame& F, bf16* base, int ld, int qoff, int koff, int voff, const bf16* AT, const float* Wdec) {
    constexpr int C = 64, NC = SEQ / C, NS = DV / 64, NDT = DK / 32, NDTW = NDT / 4, QP = DK + 8, VP = 72, AP = 72, NQ = (C * DK / 8) / 512;
    static_assert((2 * C * QP + C * VP + C * AP) * 2 + DK * 4 + 6 * 2048 * 4 <= SCR_BYTES, "chunk phase LDS");
    LAS bf16* QL = (LAS bf16*)F.lds; LAS bf16* KL = QL + C * QP; LAS bf16* VL = KL + C * QP; LAS bf16* AL = VL + C * VP; LAS float* WL = (LAS float*)(AL + C * AP); LAS float* RED = WL + DK;
    const int tid = F.tid, w = F.wave, et = w & 1, dq = w >> 1;
    for (int it = F.vcu; it < 32 * NS; it += F.G) {
        const int bh = it / NS, sl = it % NS, b = bh >> 2, h = bh & 3;
        bf16* rowbase = base + (size_t)b * SEQ * ld;
        const bf16* qp = rowbase + qoff + h * DK; const bf16* kp = rowbase + koff + h * DK; bf16* vp = rowbase + voff + h * DV + sl * 64;
        const bf16* atp = AT + (size_t)bh * NC * 4096; const float* wdp = Wdec + ((size_t)b * NC * 4 + h) * DK;
        const float wsc = exp2f(64.f * log2f(1.f - exp2f(-5.f - (float)h)));
        f32x16 S[NDTW];
#pragma unroll
        for (int d = 0; d < NDTW; ++d) S[d] = (f32x16){};
        v4u pq[NQ], pk[NQ], pv, pa; f32x4 pw = {0.f, 0.f, 0.f, 0.f};
#define CH_PREFETCH(c_) do { int tz = tid; asm volatile("" : "+v"(tz)); \
            _Pragma("unroll") for (int u = 0; u < NQ; ++u) { const int idx = tz + 512 * u, row = idx / (DK / 8), c8 = (idx % (DK / 8)) * 8; const size_t go = (size_t)(C * (c_) + row) * ld + c8; pq[u] = *(const v4u*)(qp + go); pk[u] = *(const v4u*)(kp + go); } \
            pv = *(const v4u*)(vp + (size_t)(C * (c_) + (tz >> 3)) * ld + (tz & 7) * 8); pa = *(const v4u*)(atp + (size_t)(c_) * 4096 + tz * 8); \
            if (ISGLA && tz < DK / 4) pw = *(const f32x4*)(wdp + (size_t)(c_) * 4 * DK + 4 * tz); } while (0)
        __syncthreads();
        CH_PREFETCH(0);
        for (int c = 0; c < NC; ++c) {
            {
                int tz = tid; asm volatile("" : "+v"(tz));
#pragma unroll
                for (int u = 0; u < NQ; ++u) { const int idx = tz + 512 * u, row = idx / (DK / 8), c8 = (idx % (DK / 8)) * 8; *(LAS v4u*)(QL + row * QP + c8) = pq[u]; *(LAS v4u*)(KL + row * QP + c8) = pk[u]; }
                *(LAS v4u*)(VL + (tz >> 3) * VP + (tz & 7) * 8) = pv; *(LAS v4u*)(AL + (tz >> 3) * AP + (tz & 7) * 8) = pa;
                if (ISGLA && tz < DK / 4) *(LAS f32x4*)(WL + 4 * tz) = pw;
            }
            if (c + 1 < NC) CH_PREFETCH(c + 1);
            __syncthreads();
            {
                int tz = tid; asm volatile("" : "+v"(tz)); const int r = tz & 31, hh = (tz >> 5) & 1;
                const int trow = 8 * hh + ((tz & 15) >> 2), tcol = 16 * ((tz >> 4) & 1) + 4 * (tz & 3);
                bf16x8 vf[4];
#pragma unroll
                for (int ks = 0; ks < 4; ++ks) { const LAS bf16* p = VL + (16 * ks + trow) * VP + 32 * et + tcol;
                    const s16x4 lo = __builtin_bit_cast(s16x4, __builtin_amdgcn_ds_read_tr16_b64_v4i16((LAS s16x4*)p)), hi = __builtin_bit_cast(s16x4, __builtin_amdgcn_ds_read_tr16_b64_v4i16((LAS s16x4*)(p + 4 * VP)));
                    vf[ks] = (bf16x8){lo[0], lo[1], lo[2], lo[3], hi[0], hi[1], hi[2], hi[3]}; }
                f32x16 O[2]; O[0] = (f32x16){}; O[1] = (f32x16){};
#pragma unroll
                for (int dl = 0; dl < NDTW; ++dl)
#pragma unroll
                    for (int s2 = 0; s2 < 2; ++s2) {
                        v4u sw; sw.x = pg8::cvt_pk_bf16(S[dl][8 * s2 + 0], S[dl][8 * s2 + 1]); sw.y = pg8::cvt_pk_bf16(S[dl][8 * s2 + 2], S[dl][8 * s2 + 3]);
                        sw.z = pg8::cvt_pk_bf16(S[dl][8 * s2 + 4], S[dl][8 * s2 + 5]); sw.w = pg8::cvt_pk_bf16(S[dl][8 * s2 + 6], S[dl][8 * s2 + 7]);
                        const bf16x8 sf = __builtin_bit_cast(bf16x8, sw);
#pragma unroll
                        for (int itl = 0; itl < 2; ++itl) { const LAS bf16* qq = QL + (32 * itl + r) * QP + 32 * (dq * NDTW + dl) + 16 * s2 + 4 * hh;
                            const v2u lo = *(const LAS v2u*)qq, hi = *(const LAS v2u*)(qq + 8);
                            O[itl] = MFMA32(sf, __builtin_bit_cast(bf16x8, (v4u){lo.x, lo.y, hi.x, hi.y}), O[itl]); }
                    }
                if (dq == 0) {
#pragma unroll
                    for (int itl = 0; itl < 2; ++itl)
#pragma unroll
                        for (int ks = 0; ks < 2 * itl + 2; ++ks) { const bf16x8 af = *(const LAS bf16x8*)(AL + (32 * itl + r) * AP + 16 * ks + 8 * hh); O[itl] = MFMA32(vf[ks], af, O[itl]); }
                } else {
                    LAS float* rp = RED + (et * 3 + dq - 1) * 2048 + (tz & 63);
#pragma unroll
                    for (int itl = 0; itl < 2; ++itl)
#pragma unroll
                        for (int q = 0; q < 16; ++q) rp[(itl * 16 + q) * 64] = O[itl][q];
                }
#pragma unroll
                for (int dl = 0; dl < NDTW; ++dl) {
#pragma unroll
                    for (int ks = 0; ks < 4; ++ks) { const LAS bf16* p = KL + (16 * ks + trow) * QP + 32 * (dq * NDTW + dl) + tcol;
                        const s16x4 lo = __builtin_bit_cast(s16x4, __builtin_amdgcn_ds_read_tr16_b64_v4i16((LAS s16x4*)p)), hi = __builtin_bit_cast(s16x4, __builtin_amdgcn_ds_read_tr16_b64_v4i16((LAS s16x4*)(p + 4 * QP)));
                        S[dl] = MFMA32(((bf16x8){lo[0], lo[1], lo[2], lo[3], hi[0], hi[1], hi[2], hi[3]}), vf[ks], S[dl]); }
                    if (ISGLA) {
#pragma unroll
                        for (int a4 = 0; a4 < 4; ++a4) { const f32x4 w4 = *(const LAS f32x4*)(WL + 32 * (dq * NDTW + dl) + 8 * a4 + 4 * hh);
#pragma unroll
                            for (int x = 0; x < 4; ++x) S[dl][4 * a4 + x] *= w4[x]; }
                    } else S[dl] *= wsc;
                }
                __syncthreads();
                if (dq == 0) {
                    const LAS float* rp = RED + (et * 3) * 2048 + (tz & 63);
#pragma unroll
                    for (int itl = 0; itl < 2; ++itl) {
#pragma unroll
                        for (int q = 0; q < 16; ++q) O[itl][q] += (rp[(itl * 16 + q) * 64] + rp[2048 + (itl * 16 + q) * 64]) + rp[4096 + (itl * 16 + q) * 64];
                        if (!F.dry) { bf16* op = vp + (size_t)(C * c + 32 * itl + r) * ld + 32 * et + 4 * hh;
#pragma unroll
                            for (int a4 = 0; a4 < 4; ++a4) { v2u o; o.x = pk2(O[itl][4 * a4], O[itl][4 * a4 + 1]); o.y = pk2(O[itl][4 * a4 + 2], O[itl][4 * a4 + 3]); *(v2u*)(op + 8 * a4) = o; } }
                    }
                }
            }
        }
    }
    __syncthreads();
#undef CH_PREFETCH
}
__device__ __forceinline__ void gla_prep_phase(Frame& F, bf16* base, int ld, float* Wdec) {
    const int tid = F.tid;
    for (int it = F.vcu; it < BATCH * 64; it += F.G) {
        bf16* p = base + (size_t)it * 64 * ld + tid;
        float bsum = 0.f;
#pragma unroll 8
        for (int t = 0; t < 64; ++t) {
            bf16* rp = p + (size_t)t * ld;
            bsum += bf1(rp[3072]);
            const float eb = __expf(bsum);
            const float q = bf1(rp[0]) * eb, k = bf1(rp[512]) / eb;
            if (!F.dry) { rp[0] = (bf16)f2bf(q); rp[512] = (bf16)f2bf(k); }
        }
        Wdec[(size_t)it * 512 + tid] = __expf(bsum);
    }
}

template <int DV, bool CENTER>
__device__ __forceinline__ void hn_phase(Frame& F, bf16* base, int ld, int ooff, int goff, const float* gn) {
    constexpr int NJ = DV / 128;
    const int gw = F.vcu * NWAVES + F.wave, NGW = F.G * NWAVES, lane = F.lane, hq = lane >> 4, li = lane & 15;
    for (int m = gw; m < M; m += NGW) {
        bf16* op = base + (size_t)m * ld + ooff + hq * DV + li * 8; const bf16* gp = base + (size_t)m * ld + goff + hq * DV + li * 8;
        float o[NJ][8]; v4u gw4[NJ]; float s = 0.f;
#pragma unroll
        for (int j = 0; j < NJ; ++j) { const v4u w = *(const v4u*)(op + 128 * j); gw4[j] = *(const v4u*)(gp + 128 * j);
            o[j][0] = bflo(w.x); o[j][1] = bfhi(w.x); o[j][2] = bflo(w.y); o[j][3] = bfhi(w.y); o[j][4] = bflo(w.z); o[j][5] = bfhi(w.z); o[j][6] = bflo(w.w); o[j][7] = bfhi(w.w);
#pragma unroll
            for (int e = 0; e < 8; ++e) s += o[j][e]; }
        float mean = 0.f;
        if (CENTER) mean = grp16_sum(s) * (1.f / DV);
        float s2 = 0.f;
#pragma unroll
        for (int j = 0; j < NJ; ++j)
#pragma unroll
            for (int e = 0; e < 8; ++e) { o[j][e] -= mean; s2 += o[j][e] * o[j][e]; }
        const float rstd = rsqrtf(grp16_sum(s2) * (1.f / DV) + NORM_EPS);
#pragma unroll
        for (int j = 0; j < NJ; ++j) {
            const float* gnp = gn + hq * DV + li * 8 + 128 * j; const f32x4 g0 = *(const f32x4*)gnp, g1 = *(const f32x4*)(gnp + 4);
            const float gg[8] = {bflo(gw4[j].x), bfhi(gw4[j].x), bflo(gw4[j].y), bfhi(gw4[j].y), bflo(gw4[j].z), bfhi(gw4[j].z), bflo(gw4[j].w), bfhi(gw4[j].w)};
            float r[8];
#pragma unroll
            for (int e = 0; e < 8; ++e) r[e] = o[j][e] * rstd * (e < 4 ? g0[e & 3] : g1[e & 3]) * silu(gg[e]);
            v4u w; w.x = pk2(r[0], r[1]); w.y = pk2(r[2], r[3]); w.z = pk2(r[4], r[5]); w.w = pk2(r[6], r[7]);
            if (!F.dry) *(v4u*)(op + 128 * j) = w;
        }
    }
}

__device__ __forceinline__ void lru_conv_phase(Frame& F, const bf16* XY, bf16* XC, const float* cw, const float* cb) {
    const int gw = F.vcu * NWAVES + F.wave, NGW = F.G * NWAVES, lane = F.lane;
    for (int m = gw; m < M; m += NGW) {
        const int t = m & (SEQ - 1);
#pragma unroll
        for (int j = 0; j < 2; ++j) {
            const int ch = lane * 8 + 512 * j;
            float acc[8];
            { const f32x4 b0 = *(const f32x4*)(cb + ch), b1 = *(const f32x4*)(cb + ch + 4);
              acc[0] = b0.x; acc[1] = b0.y; acc[2] = b0.z; acc[3] = b0.w; acc[4] = b1.x; acc[5] = b1.y; acc[6] = b1.z; acc[7] = b1.w; }
#pragma unroll
            for (int tap = 0; tap < 4; ++tap) {
                if (t - 3 + tap >= 0) {
                    const v4u w = *(const v4u*)(XY + (size_t)(m - 3 + tap) * 2048 + ch);
                    const f32x4 c0 = *(const f32x4*)(cw + tap * 1024 + ch), c1 = *(const f32x4*)(cw + tap * 1024 + ch + 4);
                    acc[0] += bflo(w.x) * c0.x; acc[1] += bfhi(w.x) * c0.y; acc[2] += bflo(w.y) * c0.z; acc[3] += bfhi(w.y) * c0.w;
                    acc[4] += bflo(w.z) * c1.x; acc[5] += bfhi(w.z) * c1.y; acc[6] += bflo(w.w) * c1.z; acc[7] += bfhi(w.w) * c1.w;
                }
            }
            v4u o; o.x = pk2(acc[0], acc[1]); o.y = pk2(acc[2], acc[3]); o.z = pk2(acc[4], acc[5]); o.w = pk2(acc[6], acc[7]);
            *(v4u*)(XC + (size_t)m * 1024 + ch) = o;
        }
    }
}
template <int PASS>
__device__ __forceinline__ void lru_scan_phase(Frame& F, const bf16* GP, const bf16* XC, const bf16* XY, float* SP, float* SE, bf16* HS, const float* b_a, const float* b_x, const float* lam) {
    const int tid = F.tid, ch = 2 * tid, gcol = (ch >> 7) * 256 + (ch & 127);
    const float ba0 = b_a[ch], ba1 = b_a[ch + 1], bx0 = b_x[ch], bx1 = b_x[ch + 1];
    const float lm0 = lam[ch], lm1 = lam[ch + 1];
    const float sp0 = -8.f * (fmaxf(-lm0, 0.f) + log1pf(__expf(-fabsf(lm0)))), sp1 = -8.f * (fmaxf(-lm1, 0.f) + log1pf(__expf(-fabsf(lm1))));
    for (int it = F.vcu; it < BATCH * 64; it += F.G) {
        const int b = it >> 6, ci = it & 63; const size_t m0 = (size_t)b * SEQ + ci * 64;
        float h0 = 0.f, h1 = 0.f, s0 = 0.f, s1 = 0.f;
        if (PASS == 1) {
            for (int j = 0; j < ci; ++j) { const f32x2 p = *(const f32x2*)(SP + (size_t)(b * 64 + j) * 1024 + ch), e = *(const f32x2*)(SE + (size_t)(b * 64 + j) * 1024 + ch);
                h0 = p.x * h0 + e.x; h1 = p.y * h1 + e.y; }
        }
#pragma unroll 8
        for (int t = 0; t < 64; ++t) {
            const unsigned pa = *(const unsigned*)(GP + (m0 + t) * 2048 + gcol), px = *(const unsigned*)(GP + (m0 + t) * 2048 + gcol + 128), xc = *(const unsigned*)(XC + (m0 + t) * 1024 + ch);
            const float l0 = sp0 / (1.f + __expf(-(bflo(pa) + ba0))), l1 = sp1 / (1.f + __expf(-(bfhi(pa) + ba1)));
            const float a0 = __expf(l0), a1 = __expf(l1);
            const float u0 = sqrtf(fmaxf(1.f - a0 * a0, 0.f)) * bflo(xc) / (1.f + __expf(-(bflo(px) + bx0))), u1 = sqrtf(fmaxf(1.f - a1 * a1, 0.f)) * bfhi(xc) / (1.f + __expf(-(bfhi(px) + bx1)));
            h0 = a0 * h0 + u0; h1 = a1 * h1 + u1;
            if (PASS == 0) { s0 += l0; s1 += l1; }
            else { const unsigned y = *(const unsigned*)(XY + (m0 + t) * 2048 + 1024 + ch);
                *(unsigned*)(HS + (m0 + t) * 1024 + ch) = pk2(h0 * gelu_tanh(bflo(y)), h1 * gelu_tanh(bfhi(y))); }
        }
        if (PASS == 0) { *(f32x2*)(SP + (size_t)it * 1024 + ch) = (f32x2){__expf(s0), __expf(s1)}; *(f32x2*)(SE + (size_t)it * 1024 + ch) = (f32x2){h0, h1}; }
    }
}

__device__ __forceinline__ void nsa_compress_phase(Frame& F, const bf16* KC, const bf16* VC, const bf16* W1K, const bf16* W1V, const bf16* W2K, const bf16* W2V, const float* PEB, bf16* KCMP, bf16* VCMPT) {
    LAS float* part = (LAS float*)F.lds;
    LAS bf16* hid = (LAS bf16*)(F.lds + 32768);
    const int tid = F.tid, lane = F.lane, w = F.wave, r = lane & 31, hh = lane >> 5;
    for (int it = F.vcu; it < 256; it += F.G) {
        const int kv = it >> 7, bg = (it >> 3) & 15, ntile = it & 7;
        const bf16* A = (kv ? VC : KC) + (size_t)bg * SEQ * 64 + (size_t)(32 * ntile) * 1024;
        const bf16* W1 = kv ? W1V : W1K; const bf16* W2 = kv ? W2V : W2K; const float* bias = PEB + kv * 128;
        const int ct = w & 3, kh = w >> 2;
        f32x16 acc = {};
        const bf16* ap = A + (size_t)r * 1024 + 1024 * kh + 8 * hh; const bf16* bp = W1 + (size_t)(32 * ct + r) * 2048 + 1024 * kh + 8 * hh;
#pragma unroll 8
        for (int s = 0; s < 64; ++s) { const bf16x8 a = *(const bf16x8*)(ap + 16 * s), bb = *(const bf16x8*)(bp + 16 * s); acc = MFMA32(a, bb, acc); }
        __syncthreads();
#pragma unroll
        for (int q = 0; q < 16; ++q) { const int row = (q & 3) + 8 * (q >> 2) + 4 * hh; part[kh * 4096 + row * 128 + 32 * ct + r] = acc[q]; }
        __syncthreads();
        { const int row = tid >> 4, col = (tid & 15) * 8; unsigned pk[4];
#pragma unroll
          for (int e = 0; e < 8; e += 2) { const float a0 = part[row * 128 + col + e] + part[4096 + row * 128 + col + e] + bias[col + e];
              const float a1 = part[row * 128 + col + e + 1] + part[4096 + row * 128 + col + e + 1] + bias[col + e + 1];
              pk[e >> 1] = pk2(gelu_tanh(a0), gelu_tanh(a1)); }
          *(LAS v4u*)(hid + row * 136 + col) = (v4u){pk[0], pk[1], pk[2], pk[3]}; }
        __syncthreads();
        if (w < 2) {
            f32x16 a2 = {};
#pragma unroll
            for (int s = 0; s < 8; ++s) { const bf16x8 a = *(const LAS bf16x8*)(hid + r * 136 + 16 * s + 8 * hh), bb = *(const bf16x8*)(W2 + (size_t)(32 * w + r) * 128 + 16 * s + 8 * hh); a2 = MFMA32(a, bb, a2); }
            const int d = 32 * w + r;
            if (kv == 0) {
#pragma unroll
                for (int q = 0; q < 16; ++q) { const int n = 32 * ntile + (q & 3) + 8 * (q >> 2) + 4 * hh; KCMP[((size_t)bg * 256 + n) * 64 + d] = (bf16)(n == 255 ? 0u : f2bf(a2[q])); }
            } else {
#pragma unroll
                for (int q4 = 0; q4 < 4; ++q4) { const int n = 32 * ntile + 8 * q4 + 4 * hh; float v[4];
#pragma unroll
                    for (int e = 0; e < 4; ++e) v[e] = (n + e == 255) ? 0.f : a2[4 * q4 + e];
                    v2u o; o.x = pk2(v[0], v[1]); o.y = pk2(v[2], v[3]); *(v2u*)(VCMPT + ((size_t)bg * 64 + d) * 256 + n) = o; }
            }
        }
    }
    __syncthreads();
}

constexpr int KP = 72;
__device__ __forceinline__ void qk_tile(const LAS bf16* KT, const bf16x8 (&Qf)[4], f32x16& S0, f32x16& S1, int r, int hh) {
    S0 = (f32x16){}; S1 = (f32x16){};
#pragma unroll
    for (int s = 0; s < 4; ++s) {
        const bf16x8 a0 = *(const LAS bf16x8*)(KT + r * KP + 16 * s + 8 * hh), a1 = *(const LAS bf16x8*)(KT + (32 + r) * KP + 16 * s + 8 * hh);
        S0 = MFMA32(a0, Qf[s], S0); S1 = MFMA32(a1, Qf[s], S1);
    }
}
__device__ __forceinline__ void attn_tile(const LAS bf16* KT, const LAS bf16* VT, const bf16x8 (&Qf)[4], f32x16 (&O)[2], float& mrun, float& lrun,
                                          float biasl, float bstep, int limhi, int limlo, int r, int hh) {
    f32x16 S0, S1; qk_tile(KT, Qf, S0, S1, r, hh);
    float mx = -INFINITY;
#pragma unroll
    for (int q = 0; q < 16; ++q) { const int c = (q & 3) + 8 * (q >> 2);
        S0[q] = (c <= limhi && c > limlo) ? S0[q] + __builtin_fmaf(bstep, (float)c, biasl) : -INFINITY;
        S1[q] = (c + 32 <= limhi && c + 32 > limlo) ? S1[q] + __builtin_fmaf(bstep, (float)(c + 32), biasl) : -INFINITY;
        mx = fmaxf(mx, fmaxf(S0[q], S1[q])); }
    mx = fmaxf(mx, __shfl_xor(mx, 32));
    const float mnew = fmaxf(mrun, mx), alpha = __builtin_amdgcn_exp2f(mrun - mnew);
    float rs = 0.f;
#pragma unroll
    for (int q = 0; q < 16; ++q) { S0[q] = __builtin_amdgcn_exp2f(S0[q] - mnew); S1[q] = __builtin_amdgcn_exp2f(S1[q] - mnew); rs += S0[q] + S1[q]; }
    rs += __shfl_xor(rs, 32);
    lrun = lrun * alpha + rs; mrun = mnew;
#pragma unroll
    for (int dt = 0; dt < 2; ++dt)
#pragma unroll
        for (int q = 0; q < 16; ++q) O[dt][q] *= alpha;
    bf16x8 Pf[2][2];
#pragma unroll
    for (int s = 0; s < 2; ++s) {
        v4u w0, w1;
        w0.x = pg8::cvt_pk_bf16(S0[8 * s + 0], S0[8 * s + 1]); w0.y = pg8::cvt_pk_bf16(S0[8 * s + 2], S0[8 * s + 3]); w0.z = pg8::cvt_pk_bf16(S0[8 * s + 4], S0[8 * s + 5]); w0.w = pg8::cvt_pk_bf16(S0[8 * s + 6], S0[8 * s + 7]);
        w1.x = pg8::cvt_pk_bf16(S1[8 * s + 0], S1[8 * s + 1]); w1.y = pg8::cvt_pk_bf16(S1[8 * s + 2], S1[8 * s + 3]); w1.z = pg8::cvt_pk_bf16(S1[8 * s + 4], S1[8 * s + 5]); w1.w = pg8::cvt_pk_bf16(S1[8 * s + 6], S1[8 * s + 7]);
        Pf[0][s] = __builtin_bit_cast(bf16x8, w0); Pf[1][s] = __builtin_bit_cast(bf16x8, w1);
    }
#pragma unroll
    for (int dt = 0; dt < 2; ++dt)
#pragma unroll
        for (int kt = 0; kt < 2; ++kt)
#pragma unroll
            for (int s = 0; s < 2; ++s) {
                const LAS bf16* vp = VT + (32 * dt + r) * KP + 32 * kt + 16 * s + 4 * hh;
                const v2u lo = *(const LAS v2u*)vp, hi = *(const LAS v2u*)(vp + 8);
                const bf16x8 a = __builtin_bit_cast(bf16x8, (v4u){lo.x, lo.y, hi.x, hi.y});
                O[dt] = MFMA32(a, Pf[kt][s], O[dt]);
            }
}
__device__ __forceinline__ void imp_tile(const LAS bf16* KT, const bf16x8 (&Qf)[4], float mfin, float linv, float biasl, float bstep, int limhi, int n0t, LAS unsigned* IMP, int r, int hh) {
    f32x16 S0, S1; qk_tile(KT, Qf, S0, S1, r, hh);
#pragma unroll
    for (int q = 0; q < 16; ++q) { const int c = (q & 3) + 8 * (q >> 2);
        S0[q] = (c <= limhi) ? __builtin_amdgcn_exp2f(S0[q] + __builtin_fmaf(bstep, (float)c, biasl) - mfin) * linv : 0.f;
        S1[q] = (c + 32 <= limhi) ? __builtin_amdgcn_exp2f(S1[q] + __builtin_fmaf(bstep, (float)(c + 32), biasl) - mfin) * linv : 0.f; }
    LAS unsigned* row = IMP + r * 65;
#pragma unroll
    for (int kt = 0; kt < 2; ++kt)
#pragma unroll
        for (int a = 0; a < 4; ++a) {
            const float e0 = kt ? S1[4 * a] : S0[4 * a], e1 = kt ? S1[4 * a + 1] : S0[4 * a + 1], e2 = kt ? S1[4 * a + 2] : S0[4 * a + 2], e3 = kt ? S1[4 * a + 3] : S0[4 * a + 3];
            const int j = (n0t + 32 * kt + 8 * a + 4 * hh) >> 2;
            const unsigned gq = (unsigned)((e0 + e1 + e2 + e3) * 8388608.f + 0.5f), lq = (unsigned)(e3 * 8388608.f + 0.5f);
            if (gq) __hip_atomic_fetch_add((unsigned*)(row + j), gq, __ATOMIC_RELAXED, __HIP_MEMORY_SCOPE_WORKGROUP);
            if (lq && j + 1 < 64) __hip_atomic_fetch_add((unsigned*)(row + j + 1), lq, __ATOMIC_RELAXED, __HIP_MEMORY_SCOPE_WORKGROUP);
        }
}
#define TZ_LANE int tz = tid; asm volatile("" : "+v"(tz)); const int r = tz & 31, hh = (tz >> 5) & 1;
#define NT_LOAD(ksrc_, vsrc_, vstride_, withv_) do { int tq_ = tid; asm volatile("" : "+v"(tq_)); const int row_ = tq_ >> 3, ch_ = (tq_ & 7) * 8; \
        tk = *(const v4u*)((ksrc_) + row_ * 64 + ch_); if (withv_) tv = *(const v4u*)((vsrc_) + (size_t)row_ * (vstride_) + ch_); } while (0)
#define NT_STORE(buf_, withv_) do { int tq_ = tid; asm volatile("" : "+v"(tq_)); const int row_ = tq_ >> 3, ch_ = (tq_ & 7) * 8; \
        *(LAS v4u*)(KT + (buf_) * (128 * KP) + row_ * KP + ch_) = tk; if (withv_) *(LAS v4u*)(VT + (buf_) * (128 * KP) + row_ * KP + ch_) = tv; } while (0)
__device__ __forceinline__ void nsa_attn_phase(Frame& F, const bf16* Q, const bf16* KCMP, const bf16* VCMPT, const bf16* KS, const bf16* VST, const bf16* KW, const bf16* VWT, const float* GATES, bf16* OB) {
    LAS bf16* KT = (LAS bf16*)F.lds; LAS bf16* VT = KT + 64 * KP;
    LAS unsigned* IMP = (LAS unsigned*)(F.lds + 4 * 64 * KP * 2);
    LAS unsigned char* SELB = (LAS unsigned char*)(IMP + 32 * 65);
    const int tid = F.tid, w = F.wave;
    for (int it = F.vcu; it < 2048; it += F.G) {
        const int k8 = it >> 8, v = it & 255, slot = k8 >> 1, half = k8 & 1, bg = v >> 4, rr = v & 15;
        const int i = slot == 0 ? rr : (slot == 1 ? 31 - rr : (slot == 2 ? 32 + rr : 63 - rr));
        const int b = bg >> 1, g = bg & 1, h = g * 8 + w, t0 = 64 * i, q0 = 32 * half;
        const float slope2 = exp2f(-0.5f * (float)(h + 1)) * LOG2E;
        bf16x8 Qf[4]; float gate[3];
        { TZ_LANE
          const size_t row = (size_t)b * SEQ + t0 + q0 + r;
#pragma unroll
          for (int s = 0; s < 4; ++s) Qf[s] = *(const bf16x8*)(Q + row * 1024 + h * 64 + 16 * s + 8 * hh);
#pragma unroll
          for (int br = 0; br < 3; ++br) gate[br] = GATES[row * 48 + br * 16 + h]; }
        f32x16 O[2]; O[0] = (f32x16){}; O[1] = (f32x16){};
        unsigned OUTP[2][8];
#define OUT_ACC(sc_, first_) do { _Pragma("unroll") for (int dt_ = 0; dt_ < 2; ++dt_) { _Pragma("unroll") for (int e_ = 0; e_ < 8; ++e_) { const unsigned w_ = (first_) ? 0u : OUTP[dt_][e_]; \
            OUTP[dt_][e_] = pk2(bflo(w_) + O[dt_][2 * e_] * (sc_), bfhi(w_) + O[dt_][2 * e_ + 1] * (sc_)); } O[dt_] = (f32x16){}; } } while (0)
        float mrun = -1e30f, lrun = 0.f;
        v4u tk = {0, 0, 0, 0}, tv = {0, 0, 0, 0};
        const int ncmp = (4 * i + 3) < 255 ? (4 * i + 3) : 255, ntile = (ncmp + 63) >> 6;
        const bf16* kcb = KCMP + (size_t)bg * 256 * 64; const bf16* vcb = VCMPT + (size_t)bg * 64 * 256;
        __syncthreads();
        for (int idx = tid; idx < 32 * 65; idx += 512) IMP[idx] = 0u;
        NT_LOAD(kcb, vcb, 256, true); NT_STORE(0, true);
        __syncthreads();
        for (int tl = 0; tl < ntile; ++tl) {
            if (tl + 1 < ntile) NT_LOAD(kcb + (size_t)(tl + 1) * 64 * 64, vcb + (tl + 1) * 64, 256, true);
            { TZ_LANE
              const int n0t = 64 * tl, a1 = ((t0 + q0 + r - 31) >> 4) - n0t - 4 * hh, a2 = 254 - n0t - 4 * hh;
              attn_tile(KT + (tl & 1) * (128 * KP), VT + (tl & 1) * (128 * KP), Qf, O, mrun, lrun, slope2 * (float)(16 * n0t + 31 - t0) + slope2 * 64.f * (float)hh, slope2 * 16.f, a1 < a2 ? a1 : a2, -1000, r, hh); }
            if (tl + 1 < ntile) NT_STORE((tl + 1) & 1, true);
            __syncthreads();
        }
        const float mfin = mrun, linv = 1.f / fmaxf(lrun, 1e-30f);
        OUT_ACC(linv * gate[0], true);
        mrun = -1e30f; lrun = 0.f;
        NT_LOAD(kcb, vcb, 256, false); NT_STORE(0, false);
        __syncthreads();
        for (int tl = 0; tl < ntile; ++tl) {
            if (tl + 1 < ntile) NT_LOAD(kcb + (size_t)(tl + 1) * 64 * 64, vcb, 256, false);
            { TZ_LANE
              const int n0t = 64 * tl, a1 = ((t0 + q0 + r - 31) >> 4) - n0t - 4 * hh, a2 = 254 - n0t - 4 * hh;
              imp_tile(KT + (tl & 1) * (128 * KP), Qf, mfin, linv, slope2 * (float)(16 * n0t + 31 - t0) + slope2 * 64.f * (float)hh, slope2 * 16.f, a1 < a2 ? a1 : a2, n0t, IMP, r, hh); }
            if (tl + 1 < ntile) NT_STORE((tl + 1) & 1, false);
            __syncthreads();
        }
        const bf16* kwb = KW + (size_t)bg * SEQ * 64; const bf16* vwb = VWT + (size_t)bg * 64 * SEQ;
        const bf16* ksb = KS + (size_t)bg * SEQ * 64; const bf16* vsb = VST + (size_t)bg * 64 * SEQ;
        {
            const int q = (tid >> 3) & 31, oct = tid & 7;
            unsigned mykey[8];
#pragma unroll
            for (int jj = 0; jj < 8; ++jj) { const int j = oct * 8 + jj; unsigned vv = IMP[q * 65 + j]; vv = vv > 0x3fffffeu ? 0x3fffffeu : vv;
                const bool forced = (j == 0) || (j == i) || (j == i - 1);
                mykey[jj] = (j <= i) ? (((forced ? 0x3ffffffu : vv) << 6) | (unsigned)(63 - j)) : 0u; }
            __syncthreads();
            if (tid < 256) {
#pragma unroll
                for (int jj = 0; jj < 8; ++jj) IMP[q * 65 + oct * 8 + jj] = mykey[jj]; }
            __syncthreads();
            unsigned rank[8] = {0, 0, 0, 0, 0, 0, 0, 0};
            for (int j2 = 0; j2 < 64; ++j2) { const unsigned kk = IMP[q * 65 + j2];
#pragma unroll
                for (int jj = 0; jj < 8; ++jj) rank[jj] += (kk > mykey[jj]) ? 1u : 0u; }
            unsigned byte = 0;
#pragma unroll
            for (int jj = 0; jj < 8; ++jj) byte |= ((oct * 8 + jj <= i) && rank[jj] < 16u) ? (1u << jj) : 0u;
            if (tid < 256) SELB[q * 8 + oct] = (unsigned char)byte;
        }
        __syncthreads();
        unsigned long long selm, uni;
        { TZ_LANE
          selm = *(const LAS unsigned long long*)(SELB + 8 * r);
          unsigned ulo = (unsigned)selm, uhi = (unsigned)(selm >> 32);
#pragma unroll
          for (int o = 1; o < 32; o <<= 1) { ulo |= __shfl_xor(ulo, o); uhi |= __shfl_xor(uhi, o); }
          uni = ((unsigned long long)(unsigned)__builtin_amdgcn_readfirstlane(uhi) << 32) | (unsigned)__builtin_amdgcn_readfirstlane(ulo); }
        {
            unsigned long long rem = uni;
            int j = __builtin_ctzll(rem); rem &= rem - 1;
            NT_LOAD(ksb + (size_t)j * 64 * 64, vsb + j * 64, SEQ, true); NT_STORE(0, true);
            __syncthreads();
            for (int n = 0;; ++n) {
                const bool more = rem != 0ull; const int jn = more ? __builtin_ctzll(rem) : 0; rem &= rem - 1;
                if (more) NT_LOAD(ksb + (size_t)jn * 64 * 64, vsb + jn * 64, SEQ, true);
                { TZ_LANE
                  const int lh = ((selm >> j) & 1ull) ? (j == i ? q0 + r - 4 * hh : 1000) : -1000;
                  attn_tile(KT + (n & 1) * (128 * KP), VT + (n & 1) * (128 * KP), Qf, O, mrun, lrun, slope2 * (float)(64 * j - t0) + slope2 * 4.f * (float)hh, slope2, lh, -1000, r, hh); }
                if (more) NT_STORE((n + 1) & 1, true);
                __syncthreads();
                if (!more) break;
                j = jn;
            }
        }
        OUT_ACC(gate[1] / fmaxf(lrun, 1e-30f), false);
        mrun = -1e30f; lrun = 0.f;
        {
            const int j0 = i > 8 ? i - 8 : 0;
            NT_LOAD(kwb + (size_t)j0 * 64 * 64, vwb + j0 * 64, SEQ, true); NT_STORE(0, true);
            __syncthreads();
            for (int j = j0; j <= i; ++j) {
                if (j < i) NT_LOAD(kwb + (size_t)(j + 1) * 64 * 64, vwb + (j + 1) * 64, SEQ, true);
                { TZ_LANE
                  const int lh = (j == i) ? q0 + r - 4 * hh : 1000, ll = (j == i - 8) ? q0 + r - 4 * hh : -1000;
                  attn_tile(KT + ((j - j0) & 1) * (128 * KP), VT + ((j - j0) & 1) * (128 * KP), Qf, O, mrun, lrun, slope2 * (float)(64 * j - t0) + slope2 * 4.f * (float)hh, slope2, lh, ll, r, hh); }
                if (j < i) NT_STORE((j - j0 + 1) & 1, true);
                __syncthreads();
            }
        }
        OUT_ACC(gate[2] / fmaxf(lrun, 1e-30f), false);
        { TZ_LANE
          bf16* op = OB + ((size_t)b * SEQ + t0 + q0 + r) * 1024 + h * 64;
#pragma unroll
          for (int dt = 0; dt < 2; ++dt)
#pragma unroll
              for (int q4 = 0; q4 < 4; ++q4) { v2u o; o.x = OUTP[dt][2 * q4]; o.y = OUTP[dt][2 * q4 + 1]; *(v2u*)(op + 32 * dt + 8 * q4 + 4 * hh) = o; } }
    }
    __syncthreads();
#undef OUT_ACC
}

struct Args { const float* in[32]; float* out; unsigned char* ws; int ph_lo, ph_hi, dry, pad; };
constexpr int N_PHASES = 38;

__global__ void __launch_bounds__(NWAVES * 64, 2) trunk_fwd(Args args) {
    extern __shared__ __attribute__((aligned(16))) unsigned char lds[];
    Frame F;
    F.lds = (LAS unsigned char*)lds;
    F.tid = threadIdx.x; F.lane = F.tid & 63; F.wave = __builtin_amdgcn_readfirstlane(F.tid >> 6);
    F.G = gridDim.x; { const int bx = blockIdx.x; F.vcu = (F.G % 8 == 0) ? (bx % 8) * (F.G / 8) + bx / 8 : bx; }
    F.ws = args.ws; F.dry = args.dry;
    unsigned char* ws = args.ws;
    volatile LAS unsigned* MISC = (volatile LAS unsigned*)(F.lds + LDSCTL_OFF);
    for (int u = F.tid; u < (LDS_BYTES - LDSCTL_OFF) / 4; u += NWAVES * 64) ((LAS unsigned*)(F.lds + LDSCTL_OFF))[u] = 0u;
    __syncthreads();
    XcdBarrier bar = xcd_barrier_post((unsigned*)(ws + WS_CTL) + CW_BAR, MISC + 8);

    const int lo = args.ph_lo, hi = args.ph_hi;
#ifndef PHMASK
#define PHMASK 0xFFFFFFFFFFFFFFFFull
#endif
#define INR(k) ((((PHMASK) >> (k)) & 1ull) && lo <= (k) && (k) < hi)
#define IN(k) (INR(k) && frame_refresh(F))
#define SEAM(k) do { if (INR(k) && INR((k) + 1)) xcd_barrier(bar); } while (0)
    const float* const* in = args.in;
    float* xout = args.out;
    bf16* Hb = (bf16*)(ws + WS_H); bf16* BIG = (bf16*)(ws + WS_BIG);
    bf16* Yb = (bf16*)args.out; bf16* Ylast = (bf16*)(ws + WS_BIG + 256 * MiB); float* RS = (float*)(ws + SM_RS);
    bf16* Wi = (bf16*)(ws + WS_WIN); bf16* Wo = (bf16*)(ws + WS_WOUT); bf16* Wu = (bf16*)(ws + WS_WUP); bf16* Wd = (bf16*)(ws + WS_WDN);
    LAS unsigned char* ring = F.lds + RING_OFF;

#define CONV_MLP(L, base) do { conv_w(F, base, in[5] + (size_t)(L) * D * FF, D, FF, 0, FF, FF, Wu, D, 0, 1.f, in[3] + (L) * D); conv_w(F, base, in[6] + (size_t)(L) * FF * D, FF, D, 0, D, D, Wd, FF, 0, 1.f); } while (0)
#define GEMM_PHASE(EPI, Aptr, LDA, Bptr, LDB, NN, KK, APN, E) do { pg8::Gemm g{(const pg8::bf16_t*)(Aptr), (const pg8::bf16_t*)(Bptr), M, (NN), (KK), (LDA), (LDB), (size_t)(APN)}; \
        pg8::StaticOrder S; S.init(M, (NN), F.G, (int)blockIdx.x); pg8::gemm_phase<EPI, pg8::StaticOrder, true, true>(ring, g, S, E); } while (0)
#define MLP_PHASES(P0, L, YDST) \
    if (IN(P0)) { pg8::EpiStore<1> E{BIG, FF, RS}; GEMM_PHASE(pg8::EpiStore<1>, Hb, D, Wu, D, FF, D, 0, E); } SEAM(P0); \
    if (IN((P0) + 1)) { pg8::EpiStore<0> E{YDST, D, nullptr}; GEMM_PHASE(pg8::EpiStore<0>, BIG, FF, Wd, FF, D, FF, 0, E); } SEAM((P0) + 1);

    if (IN(0)) {
        int base = 0;
        conv_w(F, base, in[7], D, 6144, 0, 6144, 6144, Wi, D, 0, 1.f, in[1]);
        conv_w(F, base, in[9], 2048, D, 0, D, D, Wo, 2048, 0, 1.f);
        CONV_MLP(0, base);
        norm_phase<0>(F, in[0], Hb, nullptr, nullptr, RS, nullptr);
    }
    SEAM(0);
    if (IN(1)) { pg8::EpiRet E{BIG, 6144, RS}; GEMM_PHASE(pg8::EpiRet, Hb, D, Wi, D, 6144, D, 0, E); }
    SEAM(1);
    if (IN(2)) chunk_a_phase<256>(F, BIG, 6144, 0, 1024, (bf16*)(ws + SM_AT));
    SEAM(2);
    if (IN(3)) chunk_phase<256, 512, false>(F, BIG, 6144, 0, 1024, 2048, (const bf16*)(ws + SM_AT), nullptr);
    SEAM(3);
    if (IN(4)) hn_phase<512, true>(F, BIG, 6144, 2048, 4096, in[8]);
    SEAM(4);
    if (IN(5)) { pg8::EpiStore<0> E{Yb, D, nullptr}; GEMM_PHASE(pg8::EpiStore<0>, BIG + 2048, 6144, Wo, 2048, D, 2048, 0, E); }
    SEAM(5);
    if (IN(6)) norm_phase<1>(F, nullptr, Hb, Yb, in[2], RS, nullptr);
    SEAM(6);
    MLP_PHASES(7, 0, Yb)
    if (IN(9)) {
        norm_phase<1>(F, nullptr, Hb, Yb, in[4], RS, nullptr);
        int base = 0;
        conv_w(F, base, in[10], D, 3088, 0, 512, 3088, Wi, D, 0, 0.08838834764831845f, in[1] + D);
        conv_w(F, base, in[10], D, 3088, 512, 2560, 3088, Wi, D, 512, 1.f, in[1] + D);
        {
            const int gw = F.vcu * NWAVES + F.wave, NGW = F.G * NWAVES;
            for (int itx = gw; itx < 16 * 64; itx += NGW) {
                const int kb = itx >> 6, cb = itx & 63, k = kb * 64 + F.lane;
                const float gk = in[1][D + k];
                float wv[16];
#pragma unroll
                for (int r4 = 0; r4 < 4; ++r4) { const f32x4 t4 = *(const f32x4*)(in[10] + (size_t)k * 3088 + 3072 + 4 * r4); wv[4 * r4] = t4.x * gk; wv[4 * r4 + 1] = t4.y * gk; wv[4 * r4 + 2] = t4.z * gk; wv[4 * r4 + 3] = t4.w * gk; }
#pragma unroll
                for (int c = cb * 8; c < cb * 8 + 8; ++c) { float sacc = 0.f;
#pragma unroll
                    for (int r = 0; r < 16; ++r) sacc += wv[r] * in[11][r * 512 + c];
                    Wi[(size_t)(3072 + c) * D + k] = (bf16)f2bf(sacc); }
            }
        }
        conv_w(F, base, in[14], D, D, 0, D, D, Wo, D, 0, 1.f);
        CONV_MLP(1, base);
    }
    SEAM(9);
    if (IN(10)) { pg8::EpiGla E{BIG, 3584, in[12], RS}; GEMM_PHASE(pg8::EpiGla, Hb, D, Wi, D, 3584, D, 0, E); }
    SEAM(10);
    if (IN(11)) gla_prep_phase(F, BIG, 3584, (float*)(ws + SM_GLAW));
    SEAM(11);
    if (IN(12)) chunk_a_phase<128>(F, BIG, 3584, 0, 512, (bf16*)(ws + SM_AT));
    SEAM(12);
    if (IN(13)) chunk_phase<128, 256, true>(F, BIG, 3584, 0, 512, 1024, (const bf16*)(ws + SM_AT), (const float*)(ws + SM_GLAW));
    SEAM(13);
    if (IN(14)) hn_phase<256, false>(F, BIG, 3584, 1024, 2048, in[13]);
    SEAM(14);
    if (IN(15)) { pg8::EpiStore<0> E{Yb, D, nullptr}; GEMM_PHASE(pg8::EpiStore<0>, BIG + 1024, 3584, Wo, D, D, D, 0, E); }
    SEAM(15);
    if (IN(16)) norm_phase<1>(F, nullptr, Hb, Yb, in[2] + D, RS, nullptr);
    SEAM(16);
    MLP_PHASES(17, 1, Yb)
    if (IN(19)) {
        norm_phase<1>(F, nullptr, Hb, Yb, in[4] + D, RS, nullptr);
        int base = 0;
        conv_w(F, base, in[15], D, 2048, 0, 2048, 2048, Wi, D, 0, 1.f, in[1] + 2 * D);
        conv_w(F, base, in[23], D, D, 0, D, D, Wo, D, 0, 1.f);
        bf16* LW = (bf16*)(ws + SM_LRUW);
        for (int n = 0; n < 8; ++n) { conv_w(F, base, in[18] + n * 16384, 128, 128, 0, 128, 128, LW + n * 32768, 128, 0, 1.f); conv_w(F, base, in[20] + n * 16384, 128, 128, 0, 128, 128, LW + n * 32768, 128, 128, 1.f); }
        CONV_MLP(2, base);
    }
    SEAM(19);
    if (IN(20)) { pg8::EpiStore<0> E{(bf16*)(ws + LRU_XY), 2048, RS}; GEMM_PHASE(pg8::EpiStore<0>, Hb, D, Wi, D, 2048, D, 0, E); }
    SEAM(20);
    if (IN(21)) lru_conv_phase(F, (const bf16*)(ws + LRU_XY), (bf16*)(ws + LRU_XC), in[16], in[17]);
    SEAM(21);
    if (IN(22)) { pg8::EpiStore<0> E{(bf16*)(ws + LRU_GP), 2048, nullptr}; GEMM_PHASE(pg8::EpiStore<0>, ws + LRU_XC, D, ws + SM_LRUW, 128, 2048, 128, 256, E); }
    SEAM(22);
    if (IN(23)) lru_scan_phase<0>(F, (const bf16*)(ws + LRU_GP), (const bf16*)(ws + LRU_XC), (const bf16*)(ws + LRU_XY), (float*)(ws + SM_SCANP), (float*)(ws + SM_SCANE), (bf16*)(ws + LRU_HS), in[19], in[21], in[22]);
    SEAM(23);
    if (IN(24)) lru_scan_phase<1>(F, (const bf16*)(ws + LRU_GP), (const bf16*)(ws + LRU_XC), (const bf16*)(ws + LRU_XY), (float*)(ws + SM_SCANP), (float*)(ws + SM_SCANE), (bf16*)(ws + LRU_HS), in[19], in[21], in[22]);
    SEAM(24);
    if (IN(25)) { pg8::EpiStore<0> E{Yb, D, nullptr}; GEMM_PHASE(pg8::EpiStore<0>, ws + LRU_HS, D, Wo, D, D, D, 0, E); }
    SEAM(25);
    if (IN(26)) norm_phase<1>(F, nullptr, Hb, Yb, in[2] + 2 * D, RS, nullptr);
    SEAM(26);
    MLP_PHASES(27, 2, Yb)
    if (IN(29)) {
        norm_phase<1>(F, nullptr, Hb, Yb, in[4] + 2 * D, RS, nullptr);
        int base = 0;
        conv_w(F, base, in[24], D, 1840, 0, 1024, 1840, Wi, D, 0, 0.125f * LOG2E, in[1] + 3 * D);
        conv_w(F, base, in[24], D, 1840, 1024, 1024, 1840, Wi, D, 1024, 1.f, in[1] + 3 * D);
        conv_w(F, base, in[31], D, D, 0, D, D, Wo, D, 0, 1.f);
        conv_w(F, base, in[26], 2048, 128, 0, 128, 128, (bf16*)(ws + SM_W1K), 2048, 0, 1.f);
        conv_w(F, base, in[29], 2048, 128, 0, 128, 128, (bf16*)(ws + SM_W1V), 2048, 0, 1.f);
        conv_w(F, base, in[27], 128, 64, 0, 64, 64, (bf16*)(ws + SM_W2K), 128, 0, 1.f);
        conv_w(F, base, in[30], 128, 64, 0, 64, 64, (bf16*)(ws + SM_W2V), 128, 0, 1.f);
        CONV_MLP(3, base);
        for (int itx = F.vcu; itx < 4; itx += F.G) {
            const int kv = itx >> 1, c = (itx & 1) * 64 + F.lane;
            const float* pe = kv ? in[28] : in[25]; const float* w1 = kv ? in[29] : in[26];
            float s = 0.f;
            for (int i2 = F.wave * 256; i2 < F.wave * 256 + 256; ++i2) s += pe[i2] * w1[(size_t)i2 * 128 + c];
            LAS float* red = (LAS float*)(F.lds + 8 * 8704);
            __syncthreads();
            red[F.wave * 64 + F.lane] = s;
            __syncthreads();
            if (F.wave == 0) { float tsum = 0.f;
#pragma unroll
                for (int w2 = 0; w2 < 8; ++w2) tsum += red[w2 * 64 + F.lane];
                ((float*)(ws + SM_PEB))[kv * 128 + c] = tsum; }
        }
    }
    SEAM(29);
    if (IN(30)) { pg8::EpiNsa E{(bf16*)(ws + NSA_Q), (bf16*)(ws + NSA_KC), (bf16*)(ws + NSA_VC), (bf16*)(ws + NSA_KS), (bf16*)(ws + NSA_VST), (bf16*)(ws + NSA_KW), (bf16*)(ws + NSA_VWT), (float*)(ws + SM_GATES), RS};
        GEMM_PHASE(pg8::EpiNsa, Hb, D, Wi, D, 2048, D, 0, E); }
    SEAM(30);
    if (IN(31)) nsa_compress_phase(F, (const bf16*)(ws + NSA_KC), (const bf16*)(ws + NSA_VC), (const bf16*)(ws + SM_W1K), (const bf16*)(ws + SM_W1V), (const bf16*)(ws + SM_W2K), (const bf16*)(ws + SM_W2V),
                                   (const float*)(ws + SM_PEB), (bf16*)(ws + SM_KCMP), (bf16*)(ws + SM_VCMPT));
    SEAM(31);
    if (IN(32)) nsa_attn_phase(F, (const bf16*)(ws + NSA_Q), (const bf16*)(ws + SM_KCMP), (const bf16*)(ws + SM_VCMPT), (const bf16*)(ws + NSA_KS), (const bf16*)(ws + NSA_VST), (const bf16*)(ws + NSA_KW), (const bf16*)(ws + NSA_VWT),
                               (const float*)(ws + SM_GATES), (bf16*)(ws + NSA_O));
    SEAM(32);
    if (IN(33)) { pg8::EpiStore<0> E{Yb, D, nullptr}; GEMM_PHASE(pg8::EpiStore<0>, ws + NSA_O, D, Wo, D, D, D, 0, E); }
    SEAM(33);
    if (IN(34)) norm_phase<1>(F, nullptr, Hb, Yb, in[2] + 3 * D, RS, nullptr);
    SEAM(34);
    MLP_PHASES(35, 3, Ylast)
    if (IN(37)) norm_phase<2>(F, nullptr, Hb, Ylast, in[4] + 3 * D, nullptr, xout);
#undef IN
#undef SEAM
}

#ifndef MK_PER_PHASE
#define MK_PER_PHASE 0
#endif
extern "C" void kernel_launch(void* const* d_in, const int* in_sizes, int n_in, void* d_out, int out_size, void* d_ws, size_t ws_size, hipStream_t stream) {
    static int grid = 0;
    if (grid == 0) {
        if (n_in != 32 || in_sizes[0] != M * D || out_size != M * D || ws_size < WS_END) { fprintf(stderr, "kernel_launch: unexpected shapes / workspace (n_in %d, ws %zu); nothing launched\n", n_in, ws_size); grid = -1; return; }
        int dev = 0, cus = 0, per_cu = 0;
        if (hipGetDevice(&dev) != hipSuccess || hipDeviceGetAttribute(&cus, hipDeviceAttributeMultiprocessorCount, dev) != hipSuccess) { grid = -1; return; }
        if (hipFuncSetAttribute((const void*)trunk_fwd, hipFuncAttributeMaxDynamicSharedMemorySize, LDS_BYTES) != hipSuccess) { fprintf(stderr, "kernel_launch: hipFuncSetAttribute failed\n"); grid = -1; return; }
        if (hipOccupancyMaxActiveBlocksPerMultiprocessor(&per_cu, (const void*)trunk_fwd, NWAVES * 64, LDS_BYTES) != hipSuccess || per_cu < 1)
            fprintf(stderr, "kernel_launch: note: occupancy query reports %d workgroups per CU\n", per_cu);
        (void)hipGetLastError();
        grid = cus;
    }
    if (grid < 0) return;
    if (hipMemsetAsync((char*)d_ws + WS_CTL, 0, CTL_ZERO_BYTES, stream) != hipSuccess) return;
    Args a{};
    for (int i = 0; i < 32; ++i) a.in[i] = (const float*)d_in[i];
    a.out = (float*)d_out; a.ws = (unsigned char*)d_ws;
#if MK_PER_PHASE
    for (int p = 0; p < N_PHASES; ++p) { a.ph_lo = p; a.ph_hi = p + 1; hipLaunchKernelGGL(trunk_fwd, dim3(grid), dim3(NWAVES * 64), LDS_BYTES, stream, a); }
#else
    a.ph_lo = 0; a.ph_hi = N_PHASES;
    hipLaunchKernelGGL(trunk_fwd, dim3(grid), dim3(NWAVES * 64), LDS_BYTES, stream, a);
#endif
#ifdef PROBE_PHASES
    { const int pp[] = {PROBE_PHASES}; a.dry = 1;
      for (int p : pp) { a.ph_lo = p; a.ph_hi = p + 1; hipLaunchKernelGGL(trunk_fwd, dim3(grid), dim3(NWAVES * 64), LDS_BYTES, stream, a); } }
#endif
}
```
